# Optimizing an MI355X kernel written in HIP

```python
import jax
import jax.numpy as jnp
from jax import lax
import numpy as np

D_MODEL = 1024
BATCH = 4
SEQ = 4096
DEPTH = 1
DEC_BATCH = 32
DEC_SEQ = 8
PAST_LEN = 16384
PAGE_SIZE = 128

PLE_DIM = 256
RET_HEADS = 4
RET_DK = 128
RET_DV = 128
RET_WIDTH = RET_HEADS * RET_DV
RET_CHUNK = 128
NSA_HEADS = 8
NSA_KV_HEADS = 2
NSA_GROUP = NSA_HEADS // NSA_KV_HEADS
NSA_HD = 64
NSA_WIDTH = NSA_HEADS * NSA_HD
KV_WIDTH = NSA_KV_HEADS * NSA_HD
CMP_BLOCK = 32
SLC_BLOCK = 64
TOP_N = 16
WINDOW = 512
Q_BLOCK = 128
MIX_WIDTH = RET_WIDTH + NSA_WIDTH
SPLIT_SIZES = (RET_HEADS * RET_DK, RET_HEADS * RET_DK, RET_WIDTH, RET_WIDTH, NSA_WIDTH, KV_WIDTH, KV_WIDTH, KV_WIDTH, KV_WIDTH, KV_WIDTH, KV_WIDTH, 3 * NSA_HEADS, NSA_WIDTH)
PROJ_WIDTH = sum(SPLIT_SIZES)
ROPE_THETA = 10000.0
RMS_EPS = 1e-6
GN_EPS = 1e-5
NEG_INF = -1e9
FORCED_SCORE = 1e4
ATTN_SCALE = NSA_HD ** -0.5

kernel_name = 'hybrid_retention_nsa_decode_step'

F32 = jnp.float32


def rmsnorm(x, g):
    xf = x.astype(F32)
    y = xf * lax.rsqrt(jnp.mean(xf * xf, axis=-1, keepdims=True) + RMS_EPS)
    return (y * g.astype(F32)).astype(x.dtype)


def rope(x, pos):
    half = x.shape[-1] // 2
    inv = ROPE_THETA ** (-jnp.arange(half, dtype=F32) / half)
    ang = pos.astype(F32)[:, None] * inv[None, :]
    cos = jnp.cos(ang)[:, None, :]
    sin = jnp.sin(ang)[:, None, :]
    xf = x.astype(F32)
    x1, x2 = xf[..., :half], xf[..., half:]
    return jnp.concatenate([x1 * cos - x2 * sin, x2 * cos + x1 * sin], axis=-1).astype(x.dtype)


def in_proj(x, norm_g, w_in):
    B, T = x.shape[:2]
    h = rmsnorm(x, norm_g)
    points = [int(v) for v in np.cumsum(SPLIT_SIZES)[:-1]]
    rq, rk, rv, rg, nq, ck, cv, sk, sv, wk, wv, ngl, ng = jnp.split(h @ w_in, points, axis=-1)
    r = lambda a, H, D: a.reshape(B, T, H, D)
    return (r(rq, RET_HEADS, RET_DK), r(rk, RET_HEADS, RET_DK), r(rv, RET_HEADS, RET_DV), rg,
            r(nq, NSA_HEADS, NSA_HD), r(ck, NSA_KV_HEADS, NSA_HD), r(cv, NSA_KV_HEADS, NSA_HD),
            r(sk, NSA_KV_HEADS, NSA_HD), r(sv, NSA_KV_HEADS, NSA_HD),
            r(wk, NSA_KV_HEADS, NSA_HD), r(wv, NSA_KV_HEADS, NSA_HD), ngl, ng)


def retention_chunk(state, q, k, v):
    C = q.shape[1]
    log_g = jnp.log(1.0 - 2.0 ** (-5.0 - jnp.arange(RET_HEADS, dtype=F32)))
    i = jnp.arange(C, dtype=F32)
    diff = i[:, None] - i[None, :]
    causal = diff >= 0
    dmask = jnp.where(causal[None], jnp.exp(jnp.where(causal, diff, 0.0)[None] * log_g[:, None, None]), 0.0)
    s = jnp.einsum('bihd,bjhd->bhij', q, k) * dmask[None]
    intra = jnp.einsum('bhij,bjhe->bihe', s, v)
    q_decay = jnp.exp((i[:, None] + 1.0) * log_g[None, :])
    cross = jnp.einsum('bihd,bhde->bihe', q * q_decay[None, :, :, None], state)
    k_decay = jnp.exp((C - 1.0 - i)[:, None] * log_g[None, :])
    new_state = jnp.exp(C * log_g)[None, :, None, None] * state + jnp.einsum('bjhd,bjhe->bhde', k * k_decay[None, :, :, None], v)
    return new_state, intra + cross


def retention_mix(rq, rk, rv, pos, state):
    B, T = rq.shape[:2]
    q = rope(rq, pos).astype(F32)
    k = rope(rk, pos).astype(F32) * (RET_DK ** -0.5)
    v = rv.astype(F32)
    C = RET_CHUNK if T % RET_CHUNK == 0 else T
    nC = T // C
    to_chunks = lambda a: a.reshape(B, nC, C, *a.shape[2:]).swapaxes(0, 1)
    final, o = lax.scan(lambda st, xs: retention_chunk(st, *xs), state.astype(F32), (to_chunks(q), to_chunks(k), to_chunks(v)))
    return final, o.swapaxes(0, 1).reshape(B, T, RET_HEADS, RET_DV)


def retention_out(o, gate, gn_g, gn_b):
    B, T = o.shape[:2]
    mu = jnp.mean(o, axis=-1, keepdims=True)
    var = jnp.mean(jnp.square(o - mu), axis=-1, keepdims=True)
    on = ((o - mu) * lax.rsqrt(var + GN_EPS)).reshape(B, T, RET_WIDTH)
    return (on * gn_g.astype(F32) + gn_b.astype(F32)) * jax.nn.silu(gate.astype(F32))


def compress(rows, pe, w1, w2):
    B, L = rows.shape[:2]
    nc = L // CMP_BLOCK
    blk = rows[:, :nc * CMP_BLOCK].reshape(B, nc, CMP_BLOCK, NSA_KV_HEADS, NSA_HD).astype(F32) + pe.astype(F32)
    hid = jax.nn.gelu(jnp.einsum('bcjkd,kjde->bcke', blk, w1))
    return jnp.einsum('bcke,kef->bckf', hid, w2)


def cmp_attend(q, qpos, kc, vc):
    nc = kc.shape[1]
    cend = (jnp.arange(nc) + 1) * CMP_BLOCK - 1
    mask = (cend[None, :] <= qpos[:, None])[None, :, None, None, :]
    s = jnp.einsum('btkgd,bckd->btkgc', q, kc).astype(F32) * ATTN_SCALE
    p = jax.nn.softmax(jnp.where(mask, s, NEG_INF), axis=-1) * mask.astype(F32)
    return jnp.einsum('btkgc,bckd->btkgd', p, vc.astype(F32)), p


def select_blocks(p_cmp, qpos, L):
    nslc = -(-L // SLC_BLOCK)
    ratio = SLC_BLOCK // CMP_BLOCK
    imp = p_cmp.sum(axis=3)
    imp = jnp.pad(imp, ((0, 0), (0, 0), (0, 0), (0, nslc * ratio - imp.shape[-1])))
    imp = imp.reshape(*imp.shape[:-1], nslc, ratio).sum(axis=-1)
    b = jnp.arange(nslc)
    valid = (b[None, :] * SLC_BLOCK <= qpos[:, None])[None, :, None, :]
    forced = ((b[None, :] == 0) | (b[None, :] == (qpos // SLC_BLOCK)[:, None]))[None, :, None, :]
    score = jnp.where(forced, FORCED_SCORE, jnp.where(valid, imp, NEG_INF))
    _, idx = lax.top_k(score, min(TOP_N, nslc))
    return idx


def slc_attend(q, qpos, k_full, v_full, idx):
    B, L = k_full.shape[:2]
    T = q.shape[1]
    nslc = -(-L // SLC_BLOCK)
    padw = ((0, 0), (0, nslc * SLC_BLOCK - L), (0, 0), (0, 0))
    to_blocks = lambda a: jnp.pad(a, padw).reshape(B, nslc, SLC_BLOCK, NSA_KV_HEADS, NSA_HD).transpose(0, 3, 1, 2, 4)
    kb, vb = to_blocks(k_full), to_blocks(v_full)
    qb = Q_BLOCK if T % Q_BLOCK == 0 else T
    nqb = T // qb
    bi = jnp.arange(B)[:, None, None, None]
    hi = jnp.arange(NSA_KV_HEADS)[None, None, :, None]

    def block(args):
        qi, pi, ii = args
        n = ii.shape[-1]
        ks = kb[bi, hi, ii].reshape(B, qb, NSA_KV_HEADS, n * SLC_BLOCK, NSA_HD)
        vs = vb[bi, hi, ii].reshape(B, qb, NSA_KV_HEADS, n * SLC_BLOCK, NSA_HD)
        kpos = (ii[..., None] * SLC_BLOCK + jnp.arange(SLC_BLOCK)).reshape(B, qb, NSA_KV_HEADS, n * SLC_BLOCK)
        mask = (kpos <= pi[None, :, None, None])[:, :, :, None, :]
        s = jnp.einsum('bqkgd,bqknd->bqkgn', qi, ks).astype(F32) * ATTN_SCALE
        p = jax.nn.softmax(jnp.where(mask, s, NEG_INF), axis=-1)
        return jnp.einsum('bqkgn,bqknd->bqkgd', p, vs.astype(F32))

    qs = q.reshape(B, nqb, qb, NSA_KV_HEADS, NSA_GROUP, NSA_HD).swapaxes(0, 1)
    ps = qpos.reshape(nqb, qb)
    iss = idx.reshape(B, nqb, qb, NSA_KV_HEADS, idx.shape[-1]).swapaxes(0, 1)
    out = lax.map(block, (qs, ps, iss))
    return out.swapaxes(0, 1).reshape(B, T, NSA_KV_HEADS, NSA_GROUP, NSA_HD)


def win_attend(q, qpos, k, v, kpos):
    dist = qpos[:, :, None] - kpos[:, None, :]
    mask = ((dist >= 0) & (dist <= WINDOW) & (kpos[:, None, :] >= 0))[None, :, :, None, None, :]
    s = jnp.einsum('bnqkgd,bnmkd->bnqkgm', q, k).astype(F32) * ATTN_SCALE
    p = jax.nn.softmax(jnp.where(mask, s, NEG_INF), axis=-1)
    return jnp.einsum('bnqkgm,bnmkd->bnqkgd', p, v.astype(F32))


def window_prompt(q_rot, wk_r, wv, pos):
    B, S = q_rot.shape[:2]
    qb = Q_BLOCK if S % Q_BLOCK == 0 else S
    nb = S // qb
    idx = (jnp.arange(nb) * qb)[:, None] + jnp.arange(WINDOW + qb)[None, :]
    padw = ((0, 0), (WINDOW, 0), (0, 0), (0, 0))
    kblk = jnp.pad(wk_r, padw)[:, idx]
    vblk = jnp.pad(wv, padw)[:, idx]
    qg = q_rot.reshape(B, nb, qb, NSA_KV_HEADS, NSA_GROUP, NSA_HD)
    o = win_attend(qg, pos.reshape(nb, qb), kblk, vblk, idx - WINDOW)
    return o.reshape(B, S, NSA_KV_HEADS, NSA_GROUP, NSA_HD)


def nsa_combine(q, q_rot, qpos, ck_full, cv_full, sk_full, sv_full, o_win, gate_logits, gate,
                pe_k, w1_k, w2_k, pe_v, w1_v, w2_v):
    B, T = q.shape[:2]
    L = ck_full.shape[1]
    kc = compress(ck_full, pe_k, w1_k, w2_k)
    vc = compress(cv_full, pe_v, w1_v, w2_v)
    o_cmp, p_cmp = cmp_attend(q.reshape(B, T, NSA_KV_HEADS, NSA_GROUP, NSA_HD), qpos, kc, vc)
    idx = select_blocks(p_cmp, qpos, L)
    o_slc = slc_attend(q_rot.reshape(B, T, NSA_KV_HEADS, NSA_GROUP, NSA_HD), qpos, sk_full, sv_full, idx)
    g = jax.nn.sigmoid(gate_logits.astype(F32)).reshape(B, T, 3, NSA_KV_HEADS, NSA_GROUP, 1)
    o = g[:, :, 0] * o_cmp + g[:, :, 1] * o_slc + g[:, :, 2] * o_win
    return o.reshape(B, T, NSA_WIDTH) * jax.nn.silu(gate.astype(F32))


def mix_prompt(x, norm_g, w_in, gn_g, gn_b, pe_k, w1_k, w2_k, pe_v, w1_v, w2_v):
    B, S = x.shape[:2]
    pos = jnp.arange(S)
    rq, rk, rv, rg, nq, ck, cv, sk, sv, wk, wv, ngl, ng = in_proj(x, norm_g, w_in)
    ret_state, o_ret = retention_mix(rq, rk, rv, pos, jnp.zeros((B, RET_HEADS, RET_DK, RET_DV), F32))
    y_ret = retention_out(o_ret, rg, gn_g, gn_b)
    q_rot, sk_r, wk_r = rope(nq, pos), rope(sk, pos), rope(wk, pos)
    o_win = window_prompt(q_rot, wk_r, wv, pos)
    y_nsa = nsa_combine(nq, q_rot, pos, ck, cv, sk_r, sv, o_win, ngl, ng, pe_k, w1_k, w2_k, pe_v, w1_v, w2_v)
    y = jnp.concatenate([y_ret, y_nsa], axis=-1).astype(x.dtype)
    wb = min(WINDOW, S)
    return y, (ret_state, ck, cv, sk_r, sv, wk_r[:, S - wb:], wv[:, S - wb:])


def mix_sample(x, c_ck, c_cv, c_sk, c_sv, win_k, win_v, ret_state, page_table,
               norm_g, w_in, gn_g, gn_b, pe_k, w1_k, w2_k, pe_v, w1_v, w2_v):
    DB, T = x.shape[:2]
    P = page_table.shape[1] * PAGE_SIZE
    pos = P + jnp.arange(T)
    rq, rk, rv, rg, nq, ck, cv, sk, sv, wk, wv, ngl, ng = in_proj(x, norm_g, w_in)
    ret_new, o_ret = retention_mix(rq, rk, rv, pos, ret_state)
    y_ret = retention_out(o_ret, rg, gn_g, gn_b)
    q_rot, sk_r, wk_r = rope(nq, pos), rope(sk, pos), rope(wk, pos)
    past = lambda c: c[page_table].reshape(DB, P, NSA_KV_HEADS, NSA_HD)
    ck_full = jnp.concatenate([past(c_ck), ck], axis=1)
    cv_full = jnp.concatenate([past(c_cv), cv], axis=1)
    sk_full = jnp.concatenate([past(c_sk), sk_r], axis=1)
    sv_full = jnp.concatenate([past(c_sv), sv], axis=1)
    wb = win_k.shape[1]
    kw = jnp.concatenate([win_k, wk_r], axis=1)
    vw = jnp.concatenate([win_v, wv], axis=1)
    kpos = (P - wb + jnp.arange(wb + T))[None, :]
    o_win = win_attend(q_rot.reshape(DB, 1, T, NSA_KV_HEADS, NSA_GROUP, NSA_HD), pos[None, :], kw[:, None], vw[:, None], kpos)
    o_win = o_win.reshape(DB, T, NSA_KV_HEADS, NSA_GROUP, NSA_HD)
    y_nsa = nsa_combine(nq, q_rot, pos, ck_full, cv_full, sk_full, sv_full, o_win, ngl, ng, pe_k, w1_k, w2_k, pe_v, w1_v, w2_v)
    y = jnp.concatenate([y_ret, y_nsa], axis=-1).astype(x.dtype)
    return y, (ret_new, ck, cv, sk_r, sv, kw[:, T:], vw[:, T:])


def finish(x, y_mix, w_out, p_l, norm_ple, w_ple_gate, w_ple):
    x = x + y_mix @ w_out
    gate = jax.nn.sigmoid((rmsnorm(x, norm_ple) @ w_ple_gate).astype(F32))
    return (x.astype(F32) + gate * (p_l @ w_ple).astype(F32)).astype(x.dtype)


def setup_inputs(seed: int = 0) -> dict:
    key = jax.random.key(seed)
    ks = jax.random.split(key, 32)
    nrm = lambda k, shape, s: s * jax.random.normal(k, shape, F32)
    n_pages = PAST_LEN // PAGE_SIZE
    used = DEC_BATCH * n_pages
    n_pool = used + max(1, used // 4)
    kvsh = (DEPTH, n_pool, PAGE_SIZE, NSA_KV_HEADS, NSA_HD)
    wb = min(WINDOW, PAST_LEN)
    page_table = jax.random.permutation(ks[9], n_pool)[:used].reshape(DEC_BATCH, n_pages).astype(jnp.int32)
    return {
        'x_prompt': nrm(ks[0], (BATCH, SEQ, D_MODEL), 1.0),
        'x_sample': nrm(ks[1], (DEC_BATCH, DEC_SEQ, D_MODEL), 1.0),
        'cache_cmp_k': nrm(ks[2], kvsh, 1.0),
        'cache_cmp_v': nrm(ks[3], kvsh, 1.0),
        'cache_slc_k': nrm(ks[4], kvsh, 1.0),
        'cache_slc_v': nrm(ks[5], kvsh, 1.0),
        'state_win_k': nrm(ks[6], (DEPTH, DEC_BATCH, wb, NSA_KV_HEADS, NSA_HD), 1.0),
        'state_win_v': nrm(ks[7], (DEPTH, DEC_BATCH, wb, NSA_KV_HEADS, NSA_HD), 1.0),
        'state_ret': nrm(ks[8], (DEPTH, DEC_BATCH, RET_HEADS, RET_DK, RET_DV), 0.5),
        'page_table': page_table,
        'p_prompt': nrm(ks[10], (DEPTH, BATCH, SEQ, PLE_DIM), 1.0),
        'p_sample': nrm(ks[11], (DEPTH, DEC_BATCH, DEC_SEQ, PLE_DIM), 1.0),
        'norm_mix': 1.0 + nrm(ks[12], (DEPTH, D_MODEL), 0.02),
        'w_in': nrm(ks[13], (DEPTH, D_MODEL, PROJ_WIDTH), D_MODEL ** -0.5),
        'ret_gn_g': 1.0 + nrm(ks[14], (DEPTH, RET_WIDTH), 0.02),
        'ret_gn_b': nrm(ks[15], (DEPTH, RET_WIDTH), 0.02),
        'cmp_pe_k': nrm(ks[16], (DEPTH, CMP_BLOCK, NSA_KV_HEADS, NSA_HD), 0.5),
        'cmp_w1_k': nrm(ks[17], (DEPTH, NSA_KV_HEADS, CMP_BLOCK, NSA_HD, NSA_HD), (CMP_BLOCK * NSA_HD) ** -0.5),
        'cmp_w2_k': nrm(ks[18], (DEPTH, NSA_KV_HEADS, NSA_HD, NSA_HD), NSA_HD ** -0.5),
        'cmp_pe_v': nrm(ks[19], (DEPTH, CMP_BLOCK, NSA_KV_HEADS, NSA_HD), 0.5),
        'cmp_w1_v': nrm(ks[20], (DEPTH, NSA_KV_HEADS, CMP_BLOCK, NSA_HD, NSA_HD), (CMP_BLOCK * NSA_HD) ** -0.5),
        'cmp_w2_v': nrm(ks[21], (DEPTH, NSA_KV_HEADS, NSA_HD, NSA_HD), NSA_HD ** -0.5),
        'w_out': nrm(ks[22], (DEPTH, MIX_WIDTH, D_MODEL), MIX_WIDTH ** -0.5),
        'norm_ple': 1.0 + nrm(ks[23], (DEPTH, D_MODEL), 0.02),
        'w_ple_gate': nrm(ks[24], (DEPTH, D_MODEL, D_MODEL), D_MODEL ** -0.5),
        'w_ple': nrm(ks[25], (DEPTH, PLE_DIM, D_MODEL), PLE_DIM ** -0.5),
        'norm_f': 1.0 + nrm(ks[26], (D_MODEL,), 0.02),
    }


def reference(x_prompt, x_sample, cache_cmp_k, cache_cmp_v, cache_slc_k, cache_slc_v, state_win_k, state_win_v,
              state_ret, page_table, p_prompt, p_sample, norm_mix, w_in, ret_gn_g, ret_gn_b,
              cmp_pe_k, cmp_w1_k, cmp_w2_k, cmp_pe_v, cmp_w1_v, cmp_w2_v, w_out, norm_ple, w_ple_gate, w_ple, norm_f):
    xp, xs = x_prompt, x_sample
    st_p, st_s = [], []
    for l in range(DEPTH):
        cw = (cmp_pe_k[l], cmp_w1_k[l], cmp_w2_k[l], cmp_pe_v[l], cmp_w1_v[l], cmp_w2_v[l])
        yp, sp = mix_prompt(xp, norm_mix[l], w_in[l], ret_gn_g[l], ret_gn_b[l], *cw)
        ys, ss = mix_sample(xs, cache_cmp_k[l], cache_cmp_v[l], cache_slc_k[l], cache_slc_v[l],
                            state_win_k[l], state_win_v[l], state_ret[l], page_table,
                            norm_mix[l], w_in[l], ret_gn_g[l], ret_gn_b[l], *cw)
        xp = finish(xp, yp, w_out[l], p_prompt[l], norm_ple[l], w_ple_gate[l], w_ple[l])
        xs = finish(xs, ys, w_out[l], p_sample[l], norm_ple[l], w_ple_gate[l], w_ple[l])
        st_p.append(sp)
        st_s.append(ss)
    ret_p, cmp_k_p, cmp_v_p, slc_k_p, slc_v_p, win_k_p, win_v_p = [jnp.stack(a) for a in zip(*st_p)]
    ret_s, cmp_k_s, cmp_v_s, slc_k_s, slc_v_s, win_k_s, win_v_s = [jnp.stack(a) for a in zip(*st_s)]
    y_prompt = rmsnorm(xp, norm_f)
    y_sample = rmsnorm(xs, norm_f)
    return (y_prompt, y_sample, ret_p, cmp_k_p, cmp_v_p, slc_k_p, slc_v_p, win_k_p, win_v_p,
            ret_s, cmp_k_s, cmp_v_s, slc_k_s, slc_v_s, win_k_s, win_v_s)
```

```cpp
#include <hip/hip_runtime.h>
#include <cstdio>
#include <cstdint>
namespace pg8 {
#define PG8_LAS __attribute__((address_space(3)))
typedef unsigned short bf16_t;
typedef short bf16x8 __attribute__((ext_vector_type(8)));
typedef float f32x4 __attribute__((ext_vector_type(4)));
typedef unsigned u32x4 __attribute__((ext_vector_type(4)));
constexpr int BM = 256, BK = 64, HALF = 128, HTB = HALF * BK * 2  , STAGE_BYTES = 8 * HTB, NXCD = 8, WGM = 8;

__host__ __device__ __forceinline__ int lds_byte(int r, int c) { const int st = (r >> 4) * 2 + (c >> 5), rr = r & 15, cc = c & 31, ob = rr * 64 + cc * 2; return st * 1024 + (ob ^ (((ob >> 9) & 1) << 5)); }
__host__ __device__ __forceinline__ void stage_rc(int b, int& R, int& C) { const int st = b / 1024, sb = b % 1024, swz = sb ^ (((sb >> 9) & 1) << 5); R = (st >> 1) * 16 + swz / 64; C = (st & 1) * 32 + (swz % 64) / 2; }
__host__ __device__ __forceinline__ int perm32(int rho) { const int n = rho >> 4, i = rho & 15; return 8 * (i >> 2) + 4 * n + (i & 3); }

struct Unit { int pm, pn; };
struct Gemm { const bf16_t* A; const bf16_t* Bt; int M, N, K; };

struct StaticOrder {
    int nM, nN, nwg, G, c;
    __host__ __device__ void init(int M, int N, int G_, int c_) { nM = M / BM; nN = N / BM; nwg = nM * nN; G = G_; c = c_; }
    __host__ __device__ bool next(int i, Unit& u) const {
        const long L = (long)i * G + c; if (L >= nwg) return false;
        int wgid = (int)L; { const int q = nwg / NXCD, r = nwg % NXCD, xcd = wgid % NXCD, off = wgid / NXCD; wgid = (xcd < r ? xcd * (q + 1) : r * (q + 1) + (xcd - r) * q) + off; }
        const int nig = WGM * nN, gid = wgid / nig, fm = gid * WGM, gsz = (nM - fm) < WGM ? (nM - fm) : WGM;
        u.pm = fm + ((wgid % nig) % gsz); u.pn = (wgid % nig) / gsz; return true;
    }
    __device__ __forceinline__ void a_ready(const Unit&) const {}
    __device__ __forceinline__ void done(const Unit&) const {}
};
template <class Epi, class Sched, bool ALIGN_EPI = false, bool SP2 = false>
__device__ __forceinline__ void gemm_phase(PG8_LAS unsigned char* lds, const Gemm g, const Sched& S, const Epi& E) {
    const int tid = threadIdx.x, wid = __builtin_amdgcn_readfirstlane(tid >> 6), lane = tid & 63, wr = wid >> 2, wc = wid & 3, fr = lane & 15, fq = lane >> 4;
    const int K = g.K, nt = K / BK;
    unsigned voffA[2], voffB[2];
#pragma unroll
    for (int i = 0; i < 2; ++i) { int R, C; stage_rc(tid * 16 + i * 8192, R, C); const int Rb = Epi::PERM ? ((R & ~31) + perm32(R & 31)) : R;
        voffA[i] = (unsigned)(R * K + C) * 2u; voffB[i] = (unsigned)(Rb * K + C) * 2u; }
    const size_t kstep = (size_t)(BK * 2);
    const size_t hstep = (size_t)HALF * K * 2;
    const size_t tstep = 2 * hstep;
    const unsigned ldsw = (unsigned)wid * 1024u;
    const int aoff = lds_byte(wr * 64 + fr, fq * 8), boff = lds_byte(wc * 32 + fr, fq * 8);
#define PG8_SA(b, h) (((b) * 2 + (h)) * HTB)
#define PG8_SB(b, h) ((4 + (b) * 2 + (h)) * HTB)
#define PG8_STAGE(bufoff, gbase, voff) do { _Pragma("unroll") for (int _i = 0; _i < 2; ++_i) \
        __builtin_amdgcn_global_load_lds((const unsigned*)((const char*)(gbase) + (voff)[_i]), (PG8_LAS unsigned*)(lds + (bufoff) + ldsw + _i * 8192), 16, 0, 0); } while (0)
#define PG8_LDA(dst, b, h) do { _Pragma("unroll") for (int m = 0; m < 4; ++m) _Pragma("unroll") for (int k = 0; k < 2; ++k) dst[m][k] = *(const PG8_LAS bf16x8*)(lds + PG8_SA(b, h) + aoff + m * 2048 + k * 1024); } while (0)
#define PG8_LDB(dst, b, h) do { _Pragma("unroll") for (int n = 0; n < 2; ++n) _Pragma("unroll") for (int k = 0; k < 2; ++k) dst[n][k] = *(const PG8_LAS bf16x8*)(lds + PG8_SB(b, h) + boff + n * 2048 + k * 1024); } while (0)
#define PG8_MMA(ai, bj, At, Bt) do { __builtin_amdgcn_s_setprio(1); _Pragma("unroll") for (int m = 0; m < 4; ++m) _Pragma("unroll") for (int n = 0; n < 2; ++n) _Pragma("unroll") for (int k = 0; k < 2; ++k) \
        acc[ai][bj][m][n] = __builtin_amdgcn_mfma_f32_16x16x32_bf16(Bt[n][k], At[m][k], acc[ai][bj][m][n], 0, 0, 0); __builtin_amdgcn_s_setprio(0); } while (0)
#define PG8_WAIT_V(n) asm volatile("s_waitcnt vmcnt(" #n ")" ::: "memory")
#define PG8_WAIT_L(n) asm volatile("s_waitcnt lgkmcnt(" #n ")" ::: "memory")
#define PG8_BAR __builtin_amdgcn_s_barrier()
#define PG8_SCHED __builtin_amdgcn_sched_barrier(0)
    Unit cur, nxt; int ui = 0;
    if (!S.next(0, cur)) return;
    f32x4 acc[2][2][4][2];
#pragma unroll
    for (int a = 0; a < 2; ++a)
#pragma unroll
        for (int b = 0; b < 2; ++b)
#pragma unroll
            for (int m = 0; m < 4; ++m)
#pragma unroll
                for (int n = 0; n < 2; ++n) acc[a][b][m][n] = (f32x4){0.f, 0.f, 0.f, 0.f};
    bf16x8 At[4][2], B0[2][2], B1[2][2];
    const char* cA = (const char*)g.A + (size_t)cur.pm * tstep; const char* cB = (const char*)g.Bt + (size_t)cur.pn * tstep;
    S.a_ready(cur);
    if constexpr (SP2) {
        PG8_STAGE(PG8_SB(0, 0), cB, voffB); PG8_STAGE(PG8_SB(0, 1), cB + hstep, voffB); PG8_STAGE(PG8_SA(0, 0), cA, voffA); PG8_STAGE(PG8_SA(0, 1), cA + hstep, voffA);
        if (wr == 1) PG8_BAR;
        PG8_WAIT_V(2); PG8_BAR;
        PG8_STAGE(PG8_SB(1, 0), cB + kstep, voffB); PG8_STAGE(PG8_SA(1, 0), cA + kstep, voffA); PG8_STAGE(PG8_SB(1, 1), cB + hstep + kstep, voffB);
        PG8_WAIT_V(6); PG8_BAR;
    } else {
        PG8_STAGE(PG8_SB(0, 0), cB, voffB); PG8_STAGE(PG8_SA(0, 0), cA, voffA); PG8_STAGE(PG8_SB(0, 1), cB + hstep, voffB); PG8_STAGE(PG8_SA(0, 1), cA + hstep, voffA);
        if (wr == 1) PG8_BAR;
        PG8_WAIT_V(4); PG8_BAR;
        PG8_STAGE(PG8_SB(1, 0), cB + kstep, voffB); PG8_STAGE(PG8_SA(1, 0), cA + kstep, voffA); PG8_STAGE(PG8_SB(1, 1), cB + hstep + kstep, voffB);
        PG8_WAIT_V(6); PG8_BAR;
    }
    for (;;) {
        const bool has_next = S.next(ui + 1, nxt);
        const char* nA = has_next ? (const char*)g.A + (size_t)nxt.pm * tstep : cA; const char* nB = has_next ? (const char*)g.Bt + (size_t)nxt.pn * tstep : cB;
        for (int t = 0; t < nt; t += 2) {
            const bool last = (t == nt - 2);
            const char* a1 = cA + (size_t)(t + 1) * kstep;
            const char* a2 = last ? nA : cA + (size_t)(t + 2) * kstep; const char* b2 = last ? nB : cB + (size_t)(t + 2) * kstep;
            const char* a3 = a2 + kstep; const char* b3 = b2 + kstep;
            if (last && has_next) S.a_ready(nxt);
            if constexpr (SP2) {
            PG8_LDB(B0, 0, 0); PG8_LDB(B1, 0, 1); PG8_SCHED; PG8_LDA(At, 0, 0); PG8_STAGE(PG8_SA(1, 1), a1 + hstep, voffA);
            PG8_WAIT_V(8); PG8_WAIT_L(0); PG8_BAR; PG8_MMA(0, 0, At, B0); PG8_MMA(0, 1, At, B1); PG8_BAR; PG8_SCHED;
            PG8_LDA(At, 0, 1); PG8_STAGE(PG8_SB(0, 0), b2, voffB); PG8_STAGE(PG8_SB(0, 1), b2 + hstep, voffB); PG8_STAGE(PG8_SA(0, 0), a2, voffA);
            PG8_WAIT_V(8); PG8_WAIT_L(0); PG8_BAR; PG8_MMA(1, 0, At, B0); PG8_MMA(1, 1, At, B1); PG8_BAR; PG8_SCHED;
            PG8_LDB(B0, 1, 0); PG8_LDB(B1, 1, 1); PG8_SCHED; PG8_LDA(At, 1, 0); PG8_STAGE(PG8_SA(0, 1), a2 + hstep, voffA);
            PG8_WAIT_V(8); PG8_WAIT_L(0); PG8_BAR; PG8_MMA(0, 0, At, B0); PG8_MMA(0, 1, At, B1); PG8_BAR; PG8_SCHED;
            PG8_LDA(At, 1, 1); PG8_STAGE(PG8_SB(1, 0), b3, voffB); PG8_STAGE(PG8_SB(1, 1), b3 + hstep, voffB); PG8_STAGE(PG8_SA(1, 0), a3, voffA);
            PG8_WAIT_V(8); PG8_WAIT_L(0); PG8_BAR; PG8_MMA(1, 0, At, B0); PG8_MMA(1, 1, At, B1); PG8_BAR; PG8_SCHED;
            } else {
            PG8_LDB(B0, 0, 0); PG8_SCHED; PG8_LDA(At, 0, 0); PG8_STAGE(PG8_SA(1, 1), a1 + hstep, voffA);
            PG8_WAIT_L(8); PG8_BAR; PG8_WAIT_L(0); PG8_MMA(0, 0, At, B0); PG8_BAR; PG8_SCHED;
            PG8_LDB(B1, 0, 1); PG8_STAGE(PG8_SB(0, 0), b2, voffB);
            PG8_BAR; PG8_WAIT_L(0); PG8_MMA(0, 1, At, B1); PG8_BAR;
            PG8_LDA(At, 0, 1); PG8_STAGE(PG8_SA(0, 0), a2, voffA);
            PG8_BAR; PG8_WAIT_L(0); PG8_MMA(1, 0, At, B0); PG8_BAR; PG8_SCHED;
            PG8_STAGE(PG8_SB(0, 1), b2 + hstep, voffB);
            PG8_WAIT_V(6); PG8_BAR; PG8_MMA(1, 1, At, B1); PG8_BAR;
            PG8_LDB(B0, 1, 0); PG8_SCHED; PG8_LDA(At, 1, 0); PG8_STAGE(PG8_SA(0, 1), a2 + hstep, voffA);
            PG8_WAIT_L(8); PG8_BAR; PG8_WAIT_L(0); PG8_MMA(0, 0, At, B0); PG8_BAR; PG8_SCHED;
            PG8_LDB(B1, 1, 1); PG8_STAGE(PG8_SB(1, 0), b3, voffB);
            PG8_BAR; PG8_WAIT_L(0); PG8_MMA(0, 1, At, B1); PG8_BAR;
            PG8_LDA(At, 1, 1); PG8_STAGE(PG8_SA(1, 0), a3, voffA);
            PG8_BAR; PG8_WAIT_L(0); PG8_MMA(1, 0, At, B0); PG8_BAR; PG8_SCHED;
            PG8_STAGE(PG8_SB(1, 1), b3 + hstep, voffB);
            PG8_WAIT_V(6); PG8_BAR; PG8_MMA(1, 1, At, B1); PG8_BAR;
            }
        }
        if constexpr (ALIGN_EPI) { if (wr == 0) PG8_BAR; }
        if constexpr (!Epi::AFTER_DRAIN) { E(acc, cur, wr, wc, fr, fq); S.done(cur); }
        if (!has_next) break;
#pragma unroll
        for (int a = 0; a < 2; ++a)
#pragma unroll
            for (int b = 0; b < 2; ++b)
#pragma unroll
                for (int m = 0; m < 4; ++m)
#pragma unroll
                    for (int n = 0; n < 2; ++n) acc[a][b][m][n] = (f32x4){0.f, 0.f, 0.f, 0.f};
        cur = nxt; cA = nA; cB = nB; ++ui;
        if constexpr (ALIGN_EPI) { if (wr == 1) PG8_BAR; }
    }
    PG8_WAIT_V(0);
    if constexpr (!ALIGN_EPI) { if (wr == 0) PG8_BAR; }
    PG8_BAR;
    if constexpr (Epi::AFTER_DRAIN) { E.fused(acc, cur, wr, wc, fr, fq, lds, wid, lane); S.done(cur); }
#undef PG8_SA
#undef PG8_SB
#undef PG8_STAGE
#undef PG8_LDA
#undef PG8_LDB
#undef PG8_MMA
#undef PG8_WAIT_V
#undef PG8_WAIT_L
#undef PG8_BAR
#undef PG8_SCHED
}
}

#define GAS __attribute__((address_space(1)))
#define LAS __attribute__((address_space(3)))
typedef unsigned short bf16;
typedef short bf16x8 __attribute__((ext_vector_type(8)));
typedef short s16x4 __attribute__((ext_vector_type(4)));
typedef float f32x2 __attribute__((ext_vector_type(2)));
typedef float f32x4 __attribute__((ext_vector_type(4)));
typedef float f32x16 __attribute__((ext_vector_type(16)));
typedef unsigned u32x2 __attribute__((ext_vector_type(2)));
typedef unsigned u32x4 __attribute__((ext_vector_type(4)));
typedef __bf16 bf16x2_t __attribute__((ext_vector_type(2)));

constexpr int NP = 16384, ND = 256, NTOK = NP + ND;
constexpr int SEQ = 4096, NBATCH = 4, DBATCH = 32, DSEQ = 8, PAST = 16384;
constexpr int DM = 1024, NPR = 3840, PROJW = 3864;
constexpr int NPOS = SEQ + DSEQ;
constexpr float C2 = 0.125f * 1.4426950408889634f;
constexpr float RMS_EPS = 1e-6f, GN_EPS = 1e-5f;
constexpr float NEGBIG = -1e30f, MINIT = -1e4f;

constexpr size_t O_Y = 0;
constexpr size_t O_RETP = (size_t)NTOK * 1024;
constexpr size_t O_CMPK_P = O_RETP + 4 * 4 * 128 * 128;
constexpr size_t O_CMPV_P = O_CMPK_P + (size_t)NP * 128;
constexpr size_t O_SLCK_P = O_CMPV_P + (size_t)NP * 128;
constexpr size_t O_SLCV_P = O_SLCK_P + (size_t)NP * 128;
constexpr size_t O_WINK_P = O_SLCV_P + (size_t)NP * 128;
constexpr size_t O_WINV_P = O_WINK_P + 4 * 512 * 128;
constexpr size_t O_RETS = O_WINV_P + 4 * 512 * 128;
constexpr size_t O_CMPK_S = O_RETS + (size_t)32 * 4 * 128 * 128;
constexpr size_t O_CMPV_S = O_CMPK_S + ND * 128;
constexpr size_t O_SLCK_S = O_CMPV_S + ND * 128;
constexpr size_t O_SLCV_S = O_SLCK_S + ND * 128;
constexpr size_t O_WINK_S = O_SLCV_S + ND * 128;
constexpr size_t O_WINV_S = O_WINK_S + (size_t)32 * 512 * 128;
constexpr size_t O_END = O_WINV_S + (size_t)32 * 512 * 128;
static_assert(O_END == 32636928, "output size");

enum { I_XP = 0, I_XS, I_CCK, I_CCV, I_CSK, I_CSV, I_SWK, I_SWV, I_SRET, I_PT, I_PP, I_PS, I_NMIX, I_WIN, I_GNG, I_GNB, I_PEK, I_W1K, I_W2K, I_PEV, I_W1V, I_W2V, I_WOUT, I_NPLE, I_WG, I_WPLE, I_NF, N_IN };

constexpr size_t MiB = 1u << 20;
constexpr size_t WS_CTL = 0, CTL_ZERO_BYTES = 1 * MiB;
constexpr size_t WS_COSR = 1 * MiB;
constexpr size_t WS_SINR = WS_COSR + (size_t)NPOS * 64 * 4;
constexpr size_t WS_COSN = WS_SINR + (size_t)NPOS * 64 * 4;
constexpr size_t WS_SINN = WS_COSN + (size_t)NPOS * 32 * 4;
constexpr size_t WS_CBIAS = 5 * MiB;
constexpr size_t WS_W2T = WS_CBIAS + 65536;
constexpr size_t WS_W1T = 6 * MiB;
constexpr size_t WS_WINT = 8 * MiB;
constexpr size_t WS_WNGLT = 16 * MiB;
constexpr size_t WS_WOUTT = 17 * MiB;
constexpr size_t WS_WGT = 19 * MiB;
constexpr size_t WS_WPLET = 21 * MiB;
constexpr size_t WS_H = 24 * MiB;
constexpr size_t WS_PB = 57 * MiB;
constexpr size_t WS_QR = 66 * MiB, WS_KR = 83 * MiB, WS_VR = 100 * MiB, WS_RG = 117 * MiB, WS_QN = 134 * MiB, WS_QROT = 151 * MiB, WS_NG = 168 * MiB;
constexpr size_t WS_KS = 185 * MiB, WS_VS = 190 * MiB, WS_KW = 195 * MiB, WS_VW = 200 * MiB;
constexpr size_t WS_GL = 205 * MiB;
constexpr size_t WS_KCP = 208 * MiB, WS_VCP = WS_KCP + 131072;
constexpr size_t WS_KCS = 209 * MiB, WS_VCS = 217 * MiB;
constexpr size_t WS_KVT = 225 * MiB;
constexpr size_t WS_ST = 257 * MiB;
constexpr size_t WS_YMIX = 273 * MiB;
constexpr size_t WS_X1 = 306 * MiB;
constexpr size_t WS_X1B = 371 * MiB;
constexpr size_t WS_PPO = 404 * MiB;
constexpr size_t WS_SS1 = 469 * MiB;
constexpr size_t WS_SS2 = 471 * MiB;
constexpr size_t WS_END = 473 * MiB;
constexpr int CW_BAR = 4096;

constexpr int LDS_BYTES = 147456;
constexpr int MISC_OFF = LDS_BYTES - 256;

struct Args { const void* in[N_IN]; float* out; unsigned char* ws; int ph_lo, ph_hi; };

__device__ __forceinline__ unsigned f2bf(float f) { unsigned u = __builtin_bit_cast(unsigned, f); return (u + 0x7fffu + ((u >> 16) & 1u)) >> 16; }
__device__ __forceinline__ unsigned pk2(float lo, float hi) { f32x2 v = {lo, hi}; bf16x2_t b = __builtin_convertvector(v, bf16x2_t); return __builtin_bit_cast(unsigned, b); }
__device__ __forceinline__ float bflo(unsigned u) { return __builtin_bit_cast(float, u << 16); }
__device__ __forceinline__ float bfhi(unsigned u) { return __builtin_bit_cast(float, u & 0xffff0000u); }
__device__ __forceinline__ float bf2f(bf16 h) { return __builtin_bit_cast(float, (unsigned)h << 16); }
__device__ __forceinline__ u32x4 pack8(const float* v) { u32x4 w; w.x = pk2(v[0], v[1]); w.y = pk2(v[2], v[3]); w.z = pk2(v[4], v[5]); w.w = pk2(v[6], v[7]); return w; }
__device__ __forceinline__ float wave_sum(float v) {
#pragma unroll
    for (int o = 1; o < 64; o <<= 1) v += __shfl_xor(v, o);
    return v;
}
__device__ __forceinline__ float wave_max(float v) {
#pragma unroll
    for (int o = 1; o < 64; o <<= 1) v = fmaxf(v, __shfl_xor(v, o));
    return v;
}
__device__ __forceinline__ void swap32(float& a, float& b) { asm volatile("s_nop 1\n\tv_permlane32_swap_b32 %0, %1\n\ts_nop 1" : "+v"(a), "+v"(b)); }
__device__ __forceinline__ float xor32_sum(float x) { float a = x, b = x; swap32(a, b); return a + b; }
__device__ __forceinline__ float xor32_max(float x) { float a = x, b = x; swap32(a, b); return fmaxf(a, b); }
__device__ __forceinline__ float sigmoidf_(float x) { return 1.f / (1.f + __expf(-x)); }
__device__ __forceinline__ float siluf_(float x) { return x / (1.f + __expf(-x)); }
__device__ __forceinline__ float gelu_tanh(float x) { const float u = 0.7978845608028654f * (x + 0.044715f * x * x * x); const float e = __expf(2.f * u); const float t = 1.f - 2.f / (e + 1.f); return 0.5f * x * (1.f + t); }
__device__ __forceinline__ int crow(int r, int hi) { return (r & 3) + 8 * (r >> 2) + 4 * hi; }
#define LDS_WAIT() asm volatile("s_waitcnt lgkmcnt(0)" ::: "memory")
#define MFMA32(a, b, c) __builtin_amdgcn_mfma_f32_32x32x16_bf16((a), (b), (c), 0, 0, 0)
typedef short v4i16_t __attribute__((ext_vector_type(4)));
__device__ __forceinline__ s16x4 ds_tr(LAS const unsigned char* p) { return __builtin_bit_cast(s16x4, __builtin_amdgcn_ds_read_tr16_b64_v4i16((LAS v4i16_t*)p)); }
__device__ __forceinline__ bf16x8 cat8(s16x4 a, s16x4 b) { return (bf16x8){a[0], a[1], a[2], a[3], b[0], b[1], b[2], b[3]}; }
__device__ __forceinline__ bf16x8 pack_frag(const f32x16& p, int base) {
    u32x4 w; w.x = pk2(p[base + 0], p[base + 1]); w.y = pk2(p[base + 2], p[base + 3]); w.z = pk2(p[base + 4], p[base + 5]); w.w = pk2(p[base + 6], p[base + 7]);
    return __builtin_bit_cast(bf16x8, w);
}
__device__ __forceinline__ float log2g(int h) { return h == 0 ? -0.04580368961312479f : h == 1 ? -0.02272007650008353f : h == 2 ? -0.011315313227834146f : -0.005646563141142063f; }

__device__ __forceinline__ void sincos_d(double a, double& s, double& c) {
    const double q = __builtin_rint(a * 0.63661977236758134308);
    double y = __builtin_fma(-q, 1.57079632679489655800e+00, a); y = __builtin_fma(-q, 6.12323399573676603587e-17, y);
    const int quad = ((int)q) & 3; const double y2 = y * y;
    double sp = -1.0 / 1307674368000.0; sp = sp * y2 + 1.0 / 6227020800.0; sp = sp * y2 - 1.0 / 39916800.0; sp = sp * y2 + 1.0 / 362880.0; sp = sp * y2 - 1.0 / 5040.0; sp = sp * y2 + 1.0 / 120.0; sp = sp * y2 - 1.0 / 6.0; sp = sp * y2 + 1.0; sp *= y;
    double cp = 1.0 / 20922789888000.0; cp = cp * y2 - 1.0 / 87178291200.0; cp = cp * y2 + 1.0 / 479001600.0; cp = cp * y2 - 1.0 / 3628800.0; cp = cp * y2 + 1.0 / 40320.0; cp = cp * y2 - 1.0 / 720.0; cp = cp * y2 + 1.0 / 24.0; cp = cp * y2 - 0.5; cp = cp * y2 + 1.0;
    s = (quad == 0) ? sp : (quad == 1) ? cp : (quad == 2) ? -sp : -cp;
    c = (quad == 0) ? cp : (quad == 1) ? -sp : (quad == 2) ? -cp : sp;
}
__device__ __forceinline__ double ipow_d(double r, int n) { double acc = 1.0;
#pragma unroll
    for (int b = 0; b < 6; ++b) { if (n & (1 << b)) acc *= r; r *= r; } return acc; }

__device__ __forceinline__ int orig_base32(int g32) {
    const int tile = g32 >> 3, gi = g32 & 7, bj = gi >> 2, wq = gi & 3;
    if (tile < 2)  return (2 * tile + (wq >> 1)) * 128 + (wq & 1) * 32 + 64 * bj;
    if (tile < 4)  return 512 + (2 * (tile - 2) + (wq >> 1)) * 128 + (wq & 1) * 32 + 64 * bj;
    if (tile < 6)  return 1024 + (tile - 4) * 256 + gi * 32;
    if (tile < 8)  return 1536 + (tile - 6) * 256 + gi * 32;
    if (tile < 10) return 2048 + (4 * (tile - 8) + wq) * 64 + 32 * bj;
    if (tile == 10) return 2560 + gi * 32;
    if (tile == 11) return ((wq >> 1) ? 3072 : 2816) + (wq & 1) * 64 + 32 * bj;
    if (tile == 12) return (bj ? 3200 : 2944) + wq * 32;
    return 3352 + (tile - 13) * 256 + gi * 32;
}
#define XB_TMO      128
#define XB_XCNT(j)  (256  + 64 * (j))
#define XB_XSUB(j)  (1280 + 64 * (j))
#define XB_XGEN(j)  (2304 + 64 * (j))
#define XB_TOP      3328
#define XB_TOPGEN   3392
#define XCD_BAR_WORDS 3456
#define XB_SPIN_CAP (1u << 18)
#define LAS __attribute__((address_space(3)))

__device__ __forceinline__ unsigned xb_ld(unsigned* p)              { return __hip_atomic_load(p, __ATOMIC_RELAXED, __HIP_MEMORY_SCOPE_AGENT); }
__device__ __forceinline__ unsigned xb_add(unsigned* p, unsigned v) { return __hip_atomic_fetch_add(p, v, __ATOMIC_RELAXED, __HIP_MEMORY_SCOPE_AGENT); }
__device__ __forceinline__ unsigned xb_xcc_id() { return (unsigned)__builtin_amdgcn_s_getreg((3 << 11) | 20) & 0xFu; }
#define XB_SPIN(cond, bar) do { unsigned _sp = 0; while (cond) { __builtin_amdgcn_s_sleep(1); \
    if ((++_sp & 255u) == 0u) { if (xb_ld(&(bar)[XB_TMO])) break; if (_sp > XB_SPIN_CAP) { atomicAdd(&(bar)[XB_TMO], 1u); break; } } } } while (0)

struct XcdBarrier {
    unsigned* bar; unsigned x;
    volatile LAS unsigned* st;
};

__device__ __forceinline__ XcdBarrier xcd_barrier_post(unsigned* bar, volatile LAS unsigned* st) {
    XcdBarrier b; b.bar = bar; b.x = xb_xcc_id(); b.st = st;
    if (threadIdx.x == 0) (void)xb_add(&bar[XB_XCNT(b.x)], 1u);
    return b;
}
__device__ __forceinline__ void xcd_barrier_complete(unsigned* bar, unsigned x, unsigned& nloc, unsigned& nx) {
    const unsigned G = gridDim.x * gridDim.y * gridDim.z;
    unsigned sum, cnt, mine, sp = 0u;
    for (;;) {
        sum = 0u; cnt = 0u; mine = 0u;
#pragma unroll
        for (unsigned j = 0; j < 16; ++j) { const unsigned c = xb_ld(&bar[XB_XCNT(j)]); sum += c; cnt += (c > 0u) ? 1u : 0u; mine = (j == x) ? c : mine; }
        if (sum == G) break;
        __builtin_amdgcn_s_sleep(1);
        if ((++sp & 255u) == 0u) { if (xb_ld(&bar[XB_TMO])) break; if (sp > XB_SPIN_CAP) { atomicAdd(&bar[XB_TMO], 1u); break; } }
    }
    nloc = mine > 0u ? mine : 1u; nx = cnt > 0u ? cnt : 1u;
}

__device__ __forceinline__ void xcd_barrier(const XcdBarrier& b) {
    asm volatile("s_waitcnt vmcnt(0)" ::: "memory");
    __syncthreads();
    if (threadIdx.x == 0) {
        unsigned* bar = b.bar;
        __builtin_amdgcn_s_waitcnt(0);
        unsigned nloc = b.st[0], nx = b.st[1];
        if (nloc == 0u) { xcd_barrier_complete(bar, b.x, nloc, nx); b.st[0] = nloc; b.st[1] = nx; }
        const unsigned old = xb_add(&bar[XB_XSUB(b.x)], 1u);
        const unsigned gen = old / nloc;
        if (old + 1u == (gen + 1u) * nloc) {
            __builtin_amdgcn_fence(__ATOMIC_RELEASE, "agent");
            asm volatile("s_waitcnt vmcnt(0)" ::: "memory");
            const unsigned og = xb_add(&bar[XB_TOP], 1u);
            const unsigned tg = og / nx;
            if (og + 1u == (tg + 1u) * nx) xb_add(&bar[XB_TOPGEN], 1u);
            else XB_SPIN(xb_ld(&bar[XB_TOPGEN]) == tg, bar);
            __builtin_amdgcn_fence(__ATOMIC_ACQUIRE, "agent");
            xb_add(&bar[XB_XGEN(b.x)], 1u);
            asm volatile("s_waitcnt vmcnt(0)" ::: "memory");
        } else {
            XB_SPIN(xb_ld(&bar[XB_XGEN(b.x)]) == gen, bar);
            __builtin_amdgcn_fence(__ATOMIC_ACQUIRE, "agent");
            asm volatile("s_waitcnt vmcnt(0)" ::: "memory");
        }
    }
    __syncthreads();
}

__device__ __forceinline__ void transpose_item(const float* W, int ldw, int k0, int n0, int nvalid, const float* kscale, bf16* WT, int ldt, int drow0, LAS float* scr, int lane) {
#pragma unroll 8
    for (int i = 0; i < 32; ++i) { const int kk = 2 * i + (lane >> 5), c = lane & 31; float v = (c < nvalid) ? W[(size_t)(k0 + kk) * ldw + n0 + c] : 0.f; if (kscale) v *= kscale[k0 + kk]; scr[kk * 33 + c] = v; }
    LDS_WAIT(); asm volatile("" ::: "memory");
    const int c8 = lane & 7;
#pragma unroll
    for (int j = 0; j < 4; ++j) { const int n = (lane >> 3) + 8 * j; const LAS float* s = scr + (8 * c8) * 33 + n;
        u32x4 o; o.x = pk2(s[0 * 33], s[1 * 33]); o.y = pk2(s[2 * 33], s[3 * 33]); o.z = pk2(s[4 * 33], s[5 * 33]); o.w = pk2(s[6 * 33], s[7 * 33]);
        *(u32x4*)(WT + (size_t)(drow0 + n) * ldt + k0 + 8 * c8) = o; }
    LDS_WAIT(); asm volatile("" ::: "memory");
}

__device__ __forceinline__ void phase0(const Args& A, LAS unsigned char* lds, int tid, int lane, int wave) {
    unsigned char* ws = A.ws;
    const int gw = blockIdx.x * 8 + wave, NGW = gridDim.x * 8;
    const int gt = blockIdx.x * 512 + tid, NGT = gridDim.x * 512;
    LAS float* scr = (LAS float*)(lds + wave * 16384);
    constexpr int I_IN = 16 * 120, I_NGL = 16, I_OUT = 16 * 32, I_G = 16 * 32, I_PLE = 4 * 32, I_W1 = 4 * 64, I_W2 = 4 * 2;
    constexpr int NITEMS = I_IN + I_NGL + I_OUT + I_G + I_PLE + I_W1 + I_W2;
    for (int it = gw; it < NITEMS; it += NGW) {
        int r = it;
        if (r < I_IN) { const int kb = r / 120, g32 = r % 120; transpose_item((const float*)A.in[I_WIN], PROJW, 64 * kb, orig_base32(g32), 32, nullptr, (bf16*)(ws + WS_WINT), 1024, 32 * g32, scr, lane); continue; } r -= I_IN;
        if (r < I_NGL) { transpose_item((const float*)A.in[I_WIN], PROJW, 64 * r, 3328, 24, nullptr, (bf16*)(ws + WS_WNGLT), 1024, 0, scr, lane); continue; } r -= I_NGL;
        if (r < I_OUT) { const int kb = r / 32, nb = r % 32; transpose_item((const float*)A.in[I_WOUT], 1024, 64 * kb, 32 * nb, 32, nullptr, (bf16*)(ws + WS_WOUTT), 1024, 32 * nb, scr, lane); continue; } r -= I_OUT;
        if (r < I_G) { const int kb = r / 32, nb = r % 32; transpose_item((const float*)A.in[I_WG], 1024, 64 * kb, 32 * nb, 32, (const float*)A.in[I_NPLE], (bf16*)(ws + WS_WGT), 1024, 32 * nb, scr, lane); continue; } r -= I_G;
        if (r < I_PLE) { const int kb = r / 32, nb = r % 32; transpose_item((const float*)A.in[I_WPLE], 1024, 64 * kb, 32 * nb, 32, nullptr, (bf16*)(ws + WS_WPLET), 256, 32 * nb, scr, lane); continue; } r -= I_PLE;
        if (r < I_W1) { const int m = r >> 6, q = r & 63, kb = q >> 1, nb = q & 1;
            const float* W = (const float*)A.in[(m >> 1) ? I_W1V : I_W1K] + (size_t)(m & 1) * 2048 * 64;
            transpose_item(W, 64, 64 * kb, 32 * nb, 32, nullptr, (bf16*)(ws + WS_W1T) + (size_t)m * 64 * 2048, 2048, 32 * nb, scr, lane); continue; } r -= I_W1;
        { const int m = r >> 1, nb = r & 1;
            const float* W = (const float*)A.in[(m >> 1) ? I_W2V : I_W2K] + (size_t)(m & 1) * 64 * 64;
            transpose_item(W, 64, 0, 32 * nb, 32, nullptr, (bf16*)(ws + WS_W2T) + (size_t)m * 64 * 64, 64, 32 * nb, scr, lane); }
    }
    {
        const f32x4* gm = (const f32x4*)A.in[I_NMIX];
        f32x4 g[4];
#pragma unroll
        for (int j = 0; j < 4; ++j) g[j] = gm[64 * j + lane];
        for (int m = gw; m < NTOK; m += NGW) {
            const float* xrow = (m < NP) ? (const float*)A.in[I_XP] + (size_t)m * DM : (const float*)A.in[I_XS] + (size_t)(m - NP) * DM;
            const f32x4* xr = (const f32x4*)xrow + lane;
            f32x4 v[4]; float s = 0.f;
#pragma unroll
            for (int j = 0; j < 4; ++j) { v[j] = xr[64 * j]; s += (v[j].x * v[j].x + v[j].y * v[j].y) + (v[j].z * v[j].z + v[j].w * v[j].w); }
            const float rstd = 1.f / sqrtf(wave_sum(s) * (1.f / DM) + RMS_EPS);
            u32x2* o8 = (u32x2*)((bf16*)(ws + WS_H) + (size_t)m * DM) + lane;
#pragma unroll
            for (int j = 0; j < 4; ++j) { u32x2 o; o.x = pk2(v[j].x * rstd * g[j].x, v[j].y * rstd * g[j].y); o.y = pk2(v[j].z * rstd * g[j].z, v[j].w * rstd * g[j].w); o8[64 * j] = o; }
        }
    }
    for (int i = gt; i < NTOK * 64; i += NGT) {
        const int row = i >> 6, c4 = i & 63;
        const f32x4 v = (row < NP) ? ((const f32x4*)A.in[I_PP])[(size_t)row * 64 + c4] : ((const f32x4*)A.in[I_PS])[(size_t)(row - NP) * 64 + c4];
        u32x2 o; o.x = pk2(v.x, v.y); o.y = pk2(v.z, v.w);
        ((u32x2*)(ws + WS_PB))[i] = o;
    }
    for (int i = gt; i < NPOS * 96; i += NGT) {
        const int pi = i / 96, k = i % 96;
        const double pos = (pi < SEQ) ? (double)pi : (double)(PAST + pi - SEQ);
        double s, c;
        if (k < 64) { sincos_d(pos * ipow_d(0.86596432336006535235, k), s, c); ((float*)(ws + WS_COSR))[pi * 64 + k] = (float)c; ((float*)(ws + WS_SINR))[pi * 64 + k] = (float)s; }
        else { const int kk = k - 64; sincos_d(pos * ipow_d(0.74989420933245582730, kk), s, c); ((float*)(ws + WS_COSN))[pi * 32 + kk] = (float)c; ((float*)(ws + WS_SINN))[pi * 32 + kk] = (float)s; }
    }
    for (int it = gw; it < 4 * 32; it += NGW) {
        const int m = it >> 5, part = it & 31, kv = m >> 1, kvh = m & 1;
        const float* pe = (const float*)A.in[kv ? I_PEV : I_PEK];
        const float* w1 = (const float*)A.in[kv ? I_W1V : I_W1K] + (size_t)kvh * 2048 * 64;
        float acc = 0.f;
        for (int q = 0; q < 64; ++q) { const int jd = part * 64 + q, j = jd >> 6, d = jd & 63; acc += pe[(j * 2 + kvh) * 64 + d] * w1[(size_t)jd * 64 + lane]; }
        ((float*)(ws + WS_CBIAS))[(m * 32 + part) * 64 + lane] = acc;
    }
    for (int i = gt; i < 2 * 32 * 504 * 32; i += NGT) {
        const int kv = i / (32 * 504 * 32), r = i % (32 * 504 * 32), b = r / (504 * 32), q = r % (504 * 32);
        const f32x4 v = ((const f32x4*)A.in[kv ? I_SWV : I_SWK])[(size_t)b * 512 * 32 + 8 * 32 + q];
        ((f32x4*)(A.out + (kv ? O_WINV_S : O_WINK_S)))[(size_t)b * 512 * 32 + q] = v;
    }
}

struct EpiInProj {
    static constexpr bool PERM = true, AFTER_DRAIN = false;
    unsigned char* ws; float* out;
    __device__ __forceinline__ void operator()(const pg8::f32x4 (&acc)[2][2][4][2], const pg8::Unit& u, int wr, int wc, int fr, int fq) const {
        const int pn = u.pn;
        asm volatile("" : "+v"(fr), "+v"(fq));
        const int lc = wc * 32 + 8 * fq;
#pragma unroll
        for (int ai = 0; ai < 2; ++ai)
#pragma unroll
            for (int m = 0; m < 4; ++m) {
                const int row = u.pm * 256 + ai * 128 + wr * 64 + m * 16 + fr;
                const bool dec = row >= NP;
                const int pidx = dec ? (SEQ + ((row - NP) & 7)) : (row & (SEQ - 1));
                float v0[8], v1[8];
#pragma unroll
                for (int e = 0; e < 4; ++e) { v0[e] = acc[ai][0][m][0][e]; v0[4 + e] = acc[ai][0][m][1][e]; v1[e] = acc[ai][1][m][0][e]; v1[4 + e] = acc[ai][1][m][1][e]; }
                if (pn < 4) {
                    const int t2 = pn & 1, head = 2 * t2 + (wc >> 1), dlo = (wc & 1) * 32 + 8 * fq;
                    const float* cs = (const float*)(ws + WS_COSR) + pidx * 64 + dlo; const float* sn = (const float*)(ws + WS_SINR) + pidx * 64 + dlo;
                    const f32x4 c0 = *(const f32x4*)cs, c1 = *(const f32x4*)(cs + 4), s0 = *(const f32x4*)sn, s1 = *(const f32x4*)(sn + 4);
                    const float sc = (pn >= 2) ? 0.08838834764831845f : 1.f;
                    float o0[8], o1[8];
#pragma unroll
                    for (int e = 0; e < 8; ++e) { const float c = e < 4 ? c0[e & 3] : c1[e & 3], s = e < 4 ? s0[e & 3] : s1[e & 3]; o0[e] = (v0[e] * c - v1[e] * s) * sc; o1[e] = (v1[e] * c + v0[e] * s) * sc; }
                    bf16* dst = (bf16*)(ws + (pn >= 2 ? WS_KR : WS_QR)) + (size_t)row * 512 + head * 128 + dlo;
                    *(u32x4*)dst = pack8(o0); *(u32x4*)(dst + 64) = pack8(o1);
                } else if (pn < 8) {
                    const int cb = ((pn - 4) & 1) * 256 + lc;
                    if (pn >= 6) {
#pragma unroll
                        for (int e = 0; e < 8; ++e) { v0[e] = siluf_(v0[e]); v1[e] = siluf_(v1[e]); } }
                    bf16* dst = (bf16*)(ws + (pn >= 6 ? WS_RG : WS_VR)) + (size_t)row * 512 + cb;
                    *(u32x4*)dst = pack8(v0); *(u32x4*)(dst + 128) = pack8(v1);
                } else if (pn < 10) {
                    const int head = 4 * (pn - 8) + wc, dlo = 8 * fq;
                    const float* cs = (const float*)(ws + WS_COSN) + pidx * 32 + dlo; const float* sn = (const float*)(ws + WS_SINN) + pidx * 32 + dlo;
                    const f32x4 c0 = *(const f32x4*)cs, c1 = *(const f32x4*)(cs + 4), s0 = *(const f32x4*)sn, s1 = *(const f32x4*)(sn + 4);
                    float o0[8], o1[8], r0[8], r1[8];
#pragma unroll
                    for (int e = 0; e < 8; ++e) { const float c = e < 4 ? c0[e & 3] : c1[e & 3], s = e < 4 ? s0[e & 3] : s1[e & 3]; o0[e] = (v0[e] * c - v1[e] * s) * C2; o1[e] = (v1[e] * c + v0[e] * s) * C2; r0[e] = v0[e] * C2; r1[e] = v1[e] * C2; }
                    bf16* dq = (bf16*)(ws + WS_QN) + (size_t)row * 512 + head * 64 + dlo; bf16* dr = (bf16*)(ws + WS_QROT) + (size_t)row * 512 + head * 64 + dlo;
                    *(u32x4*)dq = pack8(r0); *(u32x4*)(dq + 32) = pack8(r1); *(u32x4*)dr = pack8(o0); *(u32x4*)(dr + 32) = pack8(o1);
                } else if (pn == 10) {
                    float* dk = out + (dec ? O_CMPK_S + (size_t)(row - NP) * 128 : O_CMPK_P + (size_t)row * 128) + lc;
                    float* dv = out + (dec ? O_CMPV_S + (size_t)(row - NP) * 128 : O_CMPV_P + (size_t)row * 128) + lc;
                    *(f32x4*)dk = (f32x4){v0[0], v0[1], v0[2], v0[3]}; *(f32x4*)(dk + 4) = (f32x4){v0[4], v0[5], v0[6], v0[7]};
                    *(f32x4*)dv = (f32x4){v1[0], v1[1], v1[2], v1[3]}; *(f32x4*)(dv + 4) = (f32x4){v1[4], v1[5], v1[6], v1[7]};
                } else if (pn == 11) {
                    const int which = wc >> 1, kvh = wc & 1, dlo = 8 * fq, col = kvh * 64 + dlo;
                    const float* cs = (const float*)(ws + WS_COSN) + pidx * 32 + dlo; const float* sn = (const float*)(ws + WS_SINN) + pidx * 32 + dlo;
                    const f32x4 c0 = *(const f32x4*)cs, c1 = *(const f32x4*)(cs + 4), s0 = *(const f32x4*)sn, s1 = *(const f32x4*)(sn + 4);
                    float o0[8], o1[8];
#pragma unroll
                    for (int e = 0; e < 8; ++e) { const float c = e < 4 ? c0[e & 3] : c1[e & 3], s = e < 4 ? s0[e & 3] : s1[e & 3]; o0[e] = v0[e] * c - v1[e] * s; o1[e] = v1[e] * c + v0[e] * s; }
                    bf16* db = (bf16*)(ws + (which ? WS_KW : WS_KS)) + (size_t)row * 128 + col;
                    *(u32x4*)db = pack8(o0); *(u32x4*)(db + 32) = pack8(o1);
                    float* df = nullptr;
                    if (which == 0) df = out + (dec ? O_SLCK_S + (size_t)(row - NP) * 128 : O_SLCK_P + (size_t)row * 128) + col;
                    else if (dec) { const int b = (row - NP) >> 3, tt = (row - NP) & 7; df = out + O_WINK_S + ((size_t)b * 512 + 504 + tt) * 128 + col; }
                    else { const int b = row >> 12, t = row & 4095; if (t >= SEQ - 512) df = out + O_WINK_P + ((size_t)b * 512 + (t - (SEQ - 512))) * 128 + col; }
                    if (df) { *(f32x4*)df = (f32x4){o0[0], o0[1], o0[2], o0[3]}; *(f32x4*)(df + 4) = (f32x4){o0[4], o0[5], o0[6], o0[7]};
                              *(f32x4*)(df + 32) = (f32x4){o1[0], o1[1], o1[2], o1[3]}; *(f32x4*)(df + 36) = (f32x4){o1[4], o1[5], o1[6], o1[7]}; }
                } else if (pn == 12) {
                    bf16* ds = (bf16*)(ws + WS_VS) + (size_t)row * 128 + lc; bf16* dw = (bf16*)(ws + WS_VW) + (size_t)row * 128 + lc;
                    *(u32x4*)ds = pack8(v0); *(u32x4*)dw = pack8(v1);
                    float* fs = out + (dec ? O_SLCV_S + (size_t)(row - NP) * 128 : O_SLCV_P + (size_t)row * 128) + lc;
                    *(f32x4*)fs = (f32x4){v0[0], v0[1], v0[2], v0[3]}; *(f32x4*)(fs + 4) = (f32x4){v0[4], v0[5], v0[6], v0[7]};
                    float* fw = nullptr;
                    if (dec) { const int b = (row - NP) >> 3, tt = (row - NP) & 7; fw = out + O_WINV_S + ((size_t)b * 512 + 504 + tt) * 128 + lc; }
                    else { const int b = row >> 12, t = row & 4095; if (t >= SEQ - 512) fw = out + O_WINV_P + ((size_t)b * 512 + (t - (SEQ - 512))) * 128 + lc; }
                    if (fw) { *(f32x4*)fw = (f32x4){v1[0], v1[1], v1[2], v1[3]}; *(f32x4*)(fw + 4) = (f32x4){v1[4], v1[5], v1[6], v1[7]}; }
                } else {
                    const int cb = (pn - 13) * 256 + lc;
#pragma unroll
                    for (int e = 0; e < 8; ++e) { v0[e] = siluf_(v0[e]); v1[e] = siluf_(v1[e]); }
                    bf16* dst = (bf16*)(ws + WS_NG) + (size_t)row * 512 + cb;
                    *(u32x4*)dst = pack8(v0); *(u32x4*)(dst + 128) = pack8(v1);
                }
            }
    }
};

__device__ __forceinline__ void ngl_unit(unsigned char* ws, int unit, int lane, int wave) {
    const int row0 = unit * 128 + wave * 16, fr = lane & 15, fq = lane >> 4;
    const bf16* a = (const bf16*)(ws + WS_H) + (size_t)(row0 + fr) * DM + 8 * fq;
    const bf16* b0 = (const bf16*)(ws + WS_WNGLT) + (size_t)fr * DM + 8 * fq;
    const bf16* b1 = b0 + 16 * DM;
    f32x4 c0 = {0.f, 0.f, 0.f, 0.f}, c1 = {0.f, 0.f, 0.f, 0.f};
#pragma unroll 8
    for (int s = 0; s < 32; ++s) {
        const bf16x8 av = *(const bf16x8*)(a + 32 * s), bv0 = *(const bf16x8*)(b0 + 32 * s), bv1 = *(const bf16x8*)(b1 + 32 * s);
        c0 = __builtin_amdgcn_mfma_f32_16x16x32_bf16(av, bv0, c0, 0, 0, 0);
        c1 = __builtin_amdgcn_mfma_f32_16x16x32_bf16(av, bv1, c1, 0, 0, 0);
    }
    float* gl = (float*)(ws + WS_GL);
#pragma unroll
    for (int i = 0; i < 4; ++i) { const int r = row0 + 4 * fq + i; gl[(size_t)r * 32 + fr] = sigmoidf_(c0[i]); gl[(size_t)r * 32 + 16 + fr] = sigmoidf_(c1[i]); }
}

template <bool DEC>
__device__ __forceinline__ void compress_unit(const Args& A, LAS unsigned char* lds, int unit, int tid, int lane, int wave) {
    unsigned char* ws = A.ws;
    const int kv = DEC ? (unit >> 7) : (unit >> 2), b = DEC ? ((unit >> 2) & 31) : (unit & 3), part = DEC ? (unit & 3) : 0;
    const int r32 = lane & 31, hi = lane >> 5, kvh = wave >> 2, bt = wave & 3, m = kv * 2 + kvh;
    constexpr int AP = 272;
    LAS unsigned char* bufA = lds;
    LAS float* biasL = (LAS float*)(lds + 2 * 128 * AP);
    __syncthreads();
    if (tid < 128) { const int k2 = tid >> 6, e = tid & 63; const float* cb = (const float*)(ws + WS_CBIAS) + ((kv * 2 + k2) * 32) * 64 + e; float s = 0.f;
#pragma unroll 8
        for (int p = 0; p < 32; ++p) s += cb[p * 64]; biasL[tid] = s; }
    unsigned offs[8];
    const float* src;
    if (DEC) { src = (const float*)A.in[kv ? I_CCV : I_CCK]; const int* pt = (const int*)A.in[I_PT] + b * 128 + part * 32;
#pragma unroll
        for (int i = 0; i < 8; ++i) { const int blk = (tid >> 5) + 16 * i; offs[i] = ((unsigned)pt[blk >> 2] * 128u + (unsigned)(blk & 3) * 32u) * 128u + 4u * (tid & 31); } }
    else { src = A.out + (kv ? O_CMPV_P : O_CMPK_P) + (size_t)b * SEQ * 128;
#pragma unroll
        for (int i = 0; i < 8; ++i) { const int blk = (tid >> 5) + 16 * i; offs[i] = (unsigned)(blk * 32) * 128u + 4u * (tid & 31); } }
    f32x4 pre[8];
#pragma unroll
    for (int i = 0; i < 8; ++i) pre[i] = *(const f32x4*)(src + offs[i]);
    f32x16 acc[2]; acc[0] = f32x16{}; acc[1] = f32x16{};
    const bf16* w1t = (const bf16*)(ws + WS_W1T) + (size_t)m * 64 * 2048 + (size_t)r32 * 2048 + 8 * hi;
    for (int j = 0; j < 32; ++j) {
        LAS unsigned char* buf = bufA + (j & 1) * 128 * AP;
#pragma unroll
        for (int i = 0; i < 8; ++i) { const int blk = (tid >> 5) + 16 * i; u32x2 o; o.x = pk2(pre[i].x, pre[i].y); o.y = pk2(pre[i].z, pre[i].w); *(LAS u32x2*)(buf + blk * AP + (tid & 31) * 8) = o; }
        if (j + 1 < 32) {
#pragma unroll
            for (int i = 0; i < 8; ++i) pre[i] = *(const f32x4*)(src + offs[i] + (unsigned)(j + 1) * 128u); }
        __syncthreads();
#pragma unroll
        for (int d0 = 0; d0 < 4; ++d0) {
            const bf16x8 bf = *(LAS const bf16x8*)(buf + (32 * bt + r32) * AP + (kvh * 64 + 16 * d0 + 8 * hi) * 2);
            const bf16x8 a0 = *(const bf16x8*)(w1t + j * 64 + 16 * d0), a1 = *(const bf16x8*)(w1t + 32 * 2048 + j * 64 + 16 * d0);
            acc[0] = MFMA32(a0, bf, acc[0]); acc[1] = MFMA32(a1, bf, acc[1]);
        }
    }
#pragma unroll
    for (int et = 0; et < 2; ++et)
#pragma unroll
        for (int r = 0; r < 16; ++r) acc[et][r] = gelu_tanh(acc[et][r] + biasL[kvh * 64 + 32 * et + crow(r, hi)]);
    const bf16* w2t = (const bf16*)(ws + WS_W2T) + (size_t)m * 64 * 64;
    f32x16 oacc[2]; oacc[0] = f32x16{}; oacc[1] = f32x16{};
#pragma unroll
    for (int s = 0; s < 4; ++s) {
        const bf16x8 pb = pack_frag(acc[s >> 1], 8 * (s & 1));
#pragma unroll
        for (int ft = 0; ft < 2; ++ft) {
            const bf16* wp = w2t + (32 * ft + r32) * 64 + 16 * s + 4 * hi;
            const s16x4 lo = *(const s16x4*)wp, hh = *(const s16x4*)(wp + 8);
            oacc[ft] = MFMA32(cat8(lo, hh), pb, oacc[ft]);
        }
    }
    const int blk = 32 * bt + r32;
#pragma unroll
    for (int ft = 0; ft < 2; ++ft)
#pragma unroll
        for (int q = 0; q < 4; ++q) {
            const int f = 32 * ft + 8 * q + 4 * hi;
            if (DEC) { float* d = (float*)(ws + (kv ? WS_VCS : WS_KCS)) + (((size_t)b * 512 + part * 128 + blk) * 2 + kvh) * 64 + f;
                *(f32x4*)d = (f32x4){oacc[ft][4 * q], oacc[ft][4 * q + 1], oacc[ft][4 * q + 2], oacc[ft][4 * q + 3]}; }
            else { bf16* d = (bf16*)(ws + (kv ? WS_VCP : WS_KCP)) + (((size_t)b * 128 + blk) * 2 + kvh) * 64 + f;
                u32x2 o; o.x = pk2(oacc[ft][4 * q], oacc[ft][4 * q + 1]); o.y = pk2(oacc[ft][4 * q + 2], oacc[ft][4 * q + 3]); *(u32x2*)d = o; }
        }
}

__device__ __forceinline__ int tr_off(int lane, int pitch) { return ((lane & 15) >> 2) * pitch + (16 * ((lane >> 4) & 1) + 4 * (lane & 3)) * 2; }

__device__ __forceinline__ void ret_pass1_unit(unsigned char* ws, LAS unsigned char* lds, int unit, int tid, int lane, int wave) {
    const int bh = unit >> 5, c = unit & 31, b = bh >> 2, h = bh & 3;
    constexpr int TP = 320;
    LAS unsigned char* Kt = lds; LAS unsigned char* Vt = lds + 128 * TP;
    const size_t row0 = (size_t)b * SEQ + c * 128;
    const float lg = log2g(h);
    __syncthreads();
#pragma unroll
    for (int i = 0; i < 4; ++i) {
        const int row = (tid >> 4) + 32 * i, ch = tid & 15;
        const u32x4 kx = *(const u32x4*)((const bf16*)(ws + WS_KR) + (row0 + row) * 512 + h * 128 + ch * 8);
        const u32x4 vx = *(const u32x4*)((const bf16*)(ws + WS_VR) + (row0 + row) * 512 + h * 128 + ch * 8);
        const float dc = exp2f((float)(127 - row) * lg);
        u32x4 ko; ko.x = pk2(bflo(kx.x) * dc, bfhi(kx.x) * dc); ko.y = pk2(bflo(kx.y) * dc, bfhi(kx.y) * dc); ko.z = pk2(bflo(kx.z) * dc, bfhi(kx.z) * dc); ko.w = pk2(bflo(kx.w) * dc, bfhi(kx.w) * dc);
        *(LAS u32x4*)(Kt + row * TP + ch * 16) = ko; *(LAS u32x4*)(Vt + row * TP + ch * 16) = vx;
    }
    __syncthreads();
    const int r32 = lane & 31, hi = lane >> 5, dvb = wave & 3, dkh = wave >> 2, tro = tr_off(lane, TP);
    f32x16 acc[2]; acc[0] = f32x16{}; acc[1] = f32x16{};
#pragma unroll
    for (int s = 0; s < 8; ++s) {
        const int t0 = 16 * s + 8 * hi;
        const bf16x8 af = cat8(ds_tr(Vt + t0 * TP + 64 * dvb + tro), ds_tr(Vt + (t0 + 4) * TP + 64 * dvb + tro));
#pragma unroll
        for (int n = 0; n < 2; ++n) {
            const int cb = 64 * (2 * dkh + n);
            const bf16x8 bfr = cat8(ds_tr(Kt + t0 * TP + cb + tro), ds_tr(Kt + (t0 + 4) * TP + cb + tro));
            acc[n] = MFMA32(af, bfr, acc[n]);
        }
    }
    float* dst = (float*)(ws + WS_KVT) + (size_t)unit * 16384;
#pragma unroll
    for (int n = 0; n < 2; ++n)
#pragma unroll
        for (int r = 0; r < 16; ++r) dst[(32 * dvb + crow(r, hi)) * 128 + 32 * (2 * dkh + n) + r32] = acc[n][r];
}

__device__ __forceinline__ void ret_pass2(const Args& A, int tid) {
    unsigned char* ws = A.ws;
    for (int e = blockIdx.x * 512 + tid; e < 16 * 16384; e += gridDim.x * 512) {
        const int bh = e >> 14, q = e & 16383, dv = q >> 7, dk = q & 127;
        const float gC = exp2f(128.f * log2g(bh & 3));
        const float* kv = (const float*)(ws + WS_KVT) + (size_t)bh * 32 * 16384 + q;
        bf16* st = (bf16*)(ws + WS_ST) + (size_t)bh * 32 * 16384 + q;
        float S = 0.f;
#pragma unroll 8
        for (int c = 0; c < 32; ++c) { st[(size_t)c * 16384] = (bf16)f2bf(S); S = gC * S + kv[(size_t)c * 16384]; }
        A.out[O_RETP + (size_t)bh * 16384 + dk * 128 + dv] = S;
    }
}

__device__ __forceinline__ void ret_pass3_unit(const Args& A, LAS unsigned char* lds, int unit, int tid, int lane, int wave) {
    unsigned char* ws = A.ws;
    const int bh = unit >> 5, c = unit & 31, b = bh >> 2, h = bh & 3;
    constexpr int KP = 272, VP = 320;
    LAS unsigned char* Kt = lds; LAS unsigned char* Vt = lds + 128 * KP; LAS float* red = (LAS float*)(lds + 128 * KP + 128 * VP);
    const size_t row0 = (size_t)b * SEQ + c * 128;
    const float lg = log2g(h);
    __syncthreads();
#pragma unroll
    for (int i = 0; i < 4; ++i) {
        const int row = (tid >> 4) + 32 * i, ch = tid & 15;
        *(LAS u32x4*)(Kt + row * KP + ch * 16) = *(const u32x4*)((const bf16*)(ws + WS_KR) + (row0 + row) * 512 + h * 128 + ch * 8);
        *(LAS u32x4*)(Vt + row * VP + ch * 16) = *(const u32x4*)((const bf16*)(ws + WS_VR) + (row0 + row) * 512 + h * 128 + ch * 8);
    }
    const int r32 = lane & 31, hi = lane >> 5, ib = wave & 3, dh = wave >> 2, tro = tr_off(lane, VP);
    const int il = 32 * ib + r32;
    bf16x8 qf[8];
    { const bf16* qp = (const bf16*)(ws + WS_QR) + (row0 + il) * 512 + h * 128 + 8 * hi;
#pragma unroll
      for (int s = 0; s < 8; ++s) qf[s] = *(const bf16x8*)(qp + 16 * s); }
    __syncthreads();
    f32x16 oacc[2]; oacc[0] = f32x16{}; oacc[1] = f32x16{};
    for (int jb = 0; jb <= ib; ++jb) {
        f32x16 sT = f32x16{};
#pragma unroll
        for (int s = 0; s < 8; ++s) { const bf16x8 kf = *(LAS const bf16x8*)(Kt + (32 * jb + r32) * KP + (16 * s + 8 * hi) * 2); sT = MFMA32(kf, qf[s], sT); }
#pragma unroll
        for (int r = 0; r < 16; ++r) { const int j = 32 * jb + crow(r, hi); const float d = exp2f((float)(il - j) * lg); sT[r] = (j <= il) ? sT[r] * d : 0.f; }
#pragma unroll
        for (int s2 = 0; s2 < 2; ++s2) {
            const bf16x8 pb = pack_frag(sT, 8 * s2);
            const int j0 = 32 * jb + 16 * s2 + 4 * hi;
#pragma unroll
            for (int dvb = 0; dvb < 2; ++dvb) {
                const int cb = 64 * (2 * dh + dvb);
                const bf16x8 vf = cat8(ds_tr(Vt + j0 * VP + cb + tro), ds_tr(Vt + (j0 + 8) * VP + cb + tro));
                oacc[dvb] = MFMA32(vf, pb, oacc[dvb]);
            }
        }
    }
    f32x16 cacc[2]; cacc[0] = f32x16{}; cacc[1] = f32x16{};
    { const bf16* sp = (const bf16*)(ws + WS_ST) + (size_t)unit * 16384 + (size_t)(64 * dh + r32) * 128 + 8 * hi;
#pragma unroll
      for (int s = 0; s < 8; ++s) {
          const bf16x8 a0 = *(const bf16x8*)(sp + 16 * s), a1 = *(const bf16x8*)(sp + 32 * 128 + 16 * s);
          cacc[0] = MFMA32(a0, qf[s], cacc[0]); cacc[1] = MFMA32(a1, qf[s], cacc[1]);
      } }
    const float qd = exp2f((float)(il + 1) * lg);
    float s1 = 0.f, s2 = 0.f;
#pragma unroll
    for (int dvb = 0; dvb < 2; ++dvb)
#pragma unroll
        for (int r = 0; r < 16; ++r) { const float o = oacc[dvb][r] + qd * cacc[dvb][r]; oacc[dvb][r] = o; s1 += o; s2 += o * o; }
    s1 = xor32_sum(s1); s2 = xor32_sum(s2);
    if (hi == 0) { red[(dh * 128 + il) * 2] = s1; red[(dh * 128 + il) * 2 + 1] = s2; }
    __syncthreads();
    const float t1 = red[il * 2] + red[(128 + il) * 2], t2 = red[il * 2 + 1] + red[(128 + il) * 2 + 1];
    const float mu = t1 * (1.f / 128.f), var = fmaxf(t2 * (1.f / 128.f) - mu * mu, 0.f), rstd = 1.f / sqrtf(var + GN_EPS);
    const float* gg = (const float*)A.in[I_GNG] + h * 128; const float* gb = (const float*)A.in[I_GNB] + h * 128;
    const bf16* rgp = (const bf16*)(ws + WS_RG) + (row0 + il) * 512 + h * 128;
    bf16* yp = (bf16*)(ws + WS_YMIX) + (row0 + il) * 1024 + h * 128;
#pragma unroll
    for (int dvb = 0; dvb < 2; ++dvb)
#pragma unroll
        for (int q = 0; q < 4; ++q) {
            const int dv = 32 * (2 * dh + dvb) + 8 * q + 4 * hi;
            const f32x4 g4 = *(const f32x4*)(gg + dv), b4 = *(const f32x4*)(gb + dv);
            const u32x2 rg = *(const u32x2*)(rgp + dv);
            const float y0 = ((oacc[dvb][4 * q] - mu) * rstd * g4.x + b4.x) * bflo(rg.x), y1 = ((oacc[dvb][4 * q + 1] - mu) * rstd * g4.y + b4.y) * bfhi(rg.x);
            const float y2 = ((oacc[dvb][4 * q + 2] - mu) * rstd * g4.z + b4.z) * bflo(rg.y), y3 = ((oacc[dvb][4 * q + 3] - mu) * rstd * g4.w + b4.w) * bfhi(rg.y);
            u32x2 o; o.x = pk2(y0, y1); o.y = pk2(y2, y3); *(u32x2*)(yp + dv) = o;
        }
}

__device__ __forceinline__ void ret_decode_unit(const Args& A, LAS unsigned char* lds, int unit, int tid, int lane, int wave) {
    unsigned char* ws = A.ws;
    const int b = unit >> 2, h = unit & 3;
    LAS float* qL = (LAS float*)lds; LAS float* kL = qL + 1024; LAS float* vL = kL + 1024; LAS float* sL = vL + 1024;
    LAS float* red = sL + 64;
    const float lg = log2g(h);
    __syncthreads();
    for (int i = tid; i < 3 * 1024; i += 512) { const int w = i >> 10, q = i & 1023, j = q >> 7, d = q & 127;
        const bf16* p = (const bf16*)(ws + (w == 0 ? WS_QR : w == 1 ? WS_KR : WS_VR)) + (size_t)(NP + b * 8 + j) * 512 + h * 128 + d;
        qL[i] = bf2f(*p); }
    __syncthreads();
    {
        const int i = wave, j = lane & 7, sl = lane >> 3; float a = 0.f;
#pragma unroll
        for (int d = 0; d < 16; ++d) a += qL[i * 128 + sl * 16 + d] * kL[j * 128 + sl * 16 + d];
        a += __shfl_xor(a, 8); a += __shfl_xor(a, 16); a += __shfl_xor(a, 32);
        if (lane < 8) sL[i * 8 + j] = (j <= i) ? a * exp2f((float)(i - j) * lg) : 0.f;
    }
    const int dv = tid & 127, dkq = tid >> 7;
    float vj[8], cr[8];
#pragma unroll
    for (int j = 0; j < 8; ++j) { vj[j] = vL[j * 128 + dv] * exp2f((float)(7 - j) * lg); cr[j] = 0.f; }
    const float g8 = exp2f(8.f * lg);
    const float* stp = (const float*)A.in[I_SRET] + (size_t)unit * 16384 + dv;
    float* nsp = A.out + O_RETS + (size_t)unit * 16384 + dv;
#pragma unroll 4
    for (int dk = 32 * dkq; dk < 32 * dkq + 32; ++dk) {
        const float st = stp[dk * 128]; float ns = g8 * st;
#pragma unroll
        for (int j = 0; j < 8; ++j) { cr[j] += qL[j * 128 + dk] * st; ns += kL[j * 128 + dk] * vj[j]; }
        nsp[dk * 128] = ns;
    }
#pragma unroll
    for (int j = 0; j < 8; ++j) red[(dkq * 8 + j) * 128 + dv] = cr[j];
    __syncthreads();
    {
        const int i = wave; const float qd = exp2f((float)(i + 1) * lg);
        float o[2], s1 = 0.f, s2 = 0.f;
#pragma unroll
        for (int k = 0; k < 2; ++k) { const int d = lane + 64 * k;
            float x = (red[(0 * 8 + i) * 128 + d] + red[(1 * 8 + i) * 128 + d]) + (red[(2 * 8 + i) * 128 + d] + red[(3 * 8 + i) * 128 + d]);
            x *= qd;
#pragma unroll
            for (int j = 0; j < 8; ++j) x += sL[i * 8 + j] * vL[j * 128 + d];
            o[k] = x; s1 += x; s2 += x * x; }
        s1 = wave_sum(s1); s2 = wave_sum(s2);
        const float mu = s1 * (1.f / 128.f), var = fmaxf(s2 * (1.f / 128.f) - mu * mu, 0.f), rstd = 1.f / sqrtf(var + GN_EPS);
        const size_t row = (size_t)NP + b * 8 + i;
#pragma unroll
        for (int k = 0; k < 2; ++k) { const int d = lane + 64 * k;
            const float y = ((o[k] - mu) * rstd * ((const float*)A.in[I_GNG])[h * 128 + d] + ((const float*)A.in[I_GNB])[h * 128 + d]) * bf2f(((const bf16*)(ws + WS_RG))[row * 512 + h * 128 + d]);
            ((bf16*)(ws + WS_YMIX))[row * 1024 + h * 128 + d] = (bf16)f2bf(y); }
    }
}

constexpr int NSA_KP = 144, NSA_VP = 192;
constexpr int NSA_KT = 0, NSA_VT = 2 * 64 * NSA_KP, NSA_IMP = NSA_VT + 2 * 64 * NSA_VP, NSA_SEL = NSA_IMP + 4 * 64 * 65 * 4, NSA_END = NSA_SEL + 64 * 8;
static_assert(NSA_END <= MISC_OFF, "nsa lds");

template <int MODE>
__device__ __forceinline__ void nsa_tile(f32x16 (&o)[2], float& m, float& l, const bf16x8 (&q)[4], LAS const unsigned char* Kt, LAS const unsigned char* Vt, int r32, int hi, int tro, int tl, bool on, unsigned* dbgp = nullptr) {
    if (MODE != 0) asm volatile("" : "+v"(tl));
    f32x16 p0 = f32x16{}, p1 = f32x16{};
#pragma unroll
    for (int d0 = 0; d0 < 4; ++d0) {
        const bf16x8 k0 = *(LAS const bf16x8*)(Kt + r32 * NSA_KP + (16 * d0 + 8 * hi) * 2), k1 = *(LAS const bf16x8*)(Kt + (32 + r32) * NSA_KP + (16 * d0 + 8 * hi) * 2);
        p0 = MFMA32(k0, q[d0], p0); p1 = MFMA32(k1, q[d0], p1);
    }
    float mx = NEGBIG;
#pragma unroll
    for (int r = 0; r < 16; ++r) {
        const int kk = crow(r, hi);
        bool v0 = on, v1 = on;
        if (MODE == 1) { v0 = v0 && (kk <= tl); v1 = v1 && (kk + 32 <= tl); }
        if (MODE == 2) { v0 = v0 && (kk >= tl); v1 = v1 && (kk + 32 >= tl); }
        p0[r] = v0 ? p0[r] : NEGBIG; p1[r] = v1 ? p1[r] : NEGBIG;
        mx = fmaxf(mx, fmaxf(p0[r], p1[r]));
    }
    mx = xor32_max(mx);
    const float mn = fmaxf(m, mx), alpha = exp2f(m - mn);
    m = mn;
    float rs = 0.f;
#pragma unroll
    for (int r = 0; r < 16; ++r) { p0[r] = exp2f(p0[r] - mn); p1[r] = exp2f(p1[r] - mn); rs += p0[r] + p1[r]; }
    l = l * alpha + rs;
#pragma unroll
    for (int r = 0; r < 16; ++r) { o[0][r] *= alpha; o[1][r] *= alpha; }
#pragma unroll
    for (int s = 0; s < 4; ++s) {
        const bf16x8 pb = pack_frag(s < 2 ? p0 : p1, 8 * (s & 1));
        const int j0 = 16 * s + 4 * hi;
#pragma unroll
        for (int db = 0; db < 2; ++db) {
            const bf16x8 vf = cat8(ds_tr(Vt + j0 * NSA_VP + 64 * db + tro), ds_tr(Vt + (j0 + 8) * NSA_VP + 64 * db + tro));
            if (MODE == 2 && dbgp) { bool bv = false, bp = false;
#pragma unroll
                for (int e = 0; e < 8; ++e) { bv = bv || !(fabsf(bf2f((bf16)vf[e])) < 1e30f); bp = bp || !(fabsf(bf2f((bf16)pb[e])) < 1e30f); }
                if (bv) atomicAdd(dbgp + 12, 1u); if (bp) atomicAdd(dbgp + 13, 1u);
                bool bo = false;
#pragma unroll
                for (int r = 0; r < 16; ++r) bo = bo || !(fabsf(o[db][r]) < 1e30f);
                if (bo) atomicAdd(dbgp + 14, 1u); if (!(fabsf(alpha) < 1e30f)) atomicAdd(dbgp + 15, 1u); }
            o[db] = MFMA32(vf, pb, o[db]);
        }
    }
}

__device__ __forceinline__ void nsa_prompt_unit(const Args& A, LAS unsigned char* lds, int b, int kvh, int qb, int tid, int lane, int wave) {
    unsigned char* ws = A.ws;
    const int r32 = lane & 31, hi = lane >> 5, g = wave & 3, qs = wave >> 2, hq = kvh * 4 + g, tl = 32 * qs + r32, q0 = 64 * qb, t = q0 + tl;
    const size_t rowb = (size_t)b * SEQ, row = rowb + t;
    const int tro = tr_off(lane, NSA_VP);
    LAS unsigned char* KT = lds + NSA_KT; LAS unsigned char* VT = lds + NSA_VT;
    LAS float* IMP = (LAS float*)(lds + NSA_IMP); LAS unsigned long long* SEL = (LAS unsigned long long*)(lds + NSA_SEL);
    const int lrow = tid >> 3, lch = tid & 7;
    __syncthreads();
    {
        const bf16* kc = (const bf16*)(ws + WS_KCP) + ((size_t)b * 128) * 128 + kvh * 64 + lch * 8; const bf16* vc = (const bf16*)(ws + WS_VCP) + ((size_t)b * 128) * 128 + kvh * 64 + lch * 8;
#pragma unroll
        for (int i = 0; i < 2; ++i) { const int rr = lrow + 64 * i;
            *(LAS u32x4*)(KT + rr * NSA_KP + lch * 16) = *(const u32x4*)(kc + (size_t)rr * 128);
            *(LAS u32x4*)(VT + rr * NSA_VP + lch * 16) = *(const u32x4*)(vc + (size_t)rr * 128); }
    }
    bf16x8 qr[4];
    f32x16 otot[2];
    const float* glp = (const float*)(ws + WS_GL) + row * 32 + hq;
    {
        bf16x8 qn[4];
        const bf16* qp = (const bf16*)(ws + WS_QN) + row * 512 + hq * 64 + 8 * hi;
#pragma unroll
        for (int d0 = 0; d0 < 4; ++d0) qn[d0] = *(const bf16x8*)(qp + 16 * d0);
        __syncthreads();
        const int ntile = (qb >= 31) ? 2 : 1, nvalid = (t + 1) >> 5;
        f32x16 p[4];
        float mx = MINIT;
#pragma unroll
        for (int pt = 0; pt < 4; ++pt) {
            p[pt] = f32x16{};
            if (pt < 2 * ntile) {
#pragma unroll
                for (int d0 = 0; d0 < 4; ++d0) { const bf16x8 kf = *(LAS const bf16x8*)(KT + (32 * pt + r32) * NSA_KP + (16 * d0 + 8 * hi) * 2); p[pt] = MFMA32(kf, qn[d0], p[pt]); }
            }
#pragma unroll
            for (int r = 0; r < 16; ++r) { const int cidx = 32 * pt + crow(r, hi); p[pt][r] = (cidx < nvalid) ? p[pt][r] : NEGBIG; mx = fmaxf(mx, p[pt][r]); }
            __builtin_amdgcn_sched_barrier(0);
        }
        mx = xor32_max(mx);
        float ls = 0.f;
#pragma unroll
        for (int pt = 0; pt < 4; ++pt)
#pragma unroll
            for (int r = 0; r < 16; ++r) { p[pt][r] = exp2f(p[pt][r] - mx); ls += p[pt][r]; }
        ls = xor32_sum(ls);
        const float inv = ls > 0.f ? 1.f / ls : 0.f;
        LAS float* ip = IMP + (g * 64 + tl) * 65;
#pragma unroll
        for (int pt = 0; pt < 4; ++pt)
#pragma unroll
            for (int r = 0; r < 16; ++r) { p[pt][r] *= inv; if (r & 1) ip[16 * pt + (crow(r - 1, hi) >> 1)] = p[pt][r - 1] + p[pt][r]; }
        f32x16 oc[2]; oc[0] = f32x16{}; oc[1] = f32x16{};
#pragma unroll
        for (int pt = 0; pt < 4; ++pt) {
            if (pt < 2 * ntile) {
#pragma unroll
                for (int s2 = 0; s2 < 2; ++s2) {
                    const bf16x8 pb = pack_frag(p[pt], 8 * s2);
                    const int j0 = 32 * pt + 16 * s2 + 4 * hi;
#pragma unroll
                    for (int db = 0; db < 2; ++db) { const bf16x8 vf = cat8(ds_tr(VT + j0 * NSA_VP + 64 * db + tro), ds_tr(VT + (j0 + 8) * NSA_VP + 64 * db + tro)); oc[db] = MFMA32(vf, pb, oc[db]); }
                }
            }
            __builtin_amdgcn_sched_barrier(0);
        }
        const float g0 = glp[0];
#pragma unroll
        for (int r = 0; r < 16; ++r) { otot[0][r] = g0 * oc[0][r]; otot[1][r] = g0 * oc[1][r]; }
    }
    __syncthreads();
#pragma unroll 1
    for (int qi = 0; qi < 8; ++qi) {
        const int tq = 8 * wave + qi;
        const float imp = (IMP[(0 * 64 + tq) * 65 + lane] + IMP[(1 * 64 + tq) * 65 + lane]) + (IMP[(2 * 64 + tq) * 65 + lane] + IMP[(3 * 64 + tq) * 65 + lane]);
        const bool forced = (lane == 0) || (lane == qb), valid = lane <= qb;
        const float sc = forced ? 1e4f : (valid ? imp : -1e9f);
        int rank = 0;
#pragma unroll 8
        for (int j = 0; j < 64; ++j) { const float sj = __builtin_bit_cast(float, __builtin_amdgcn_readlane(__builtin_bit_cast(int, sc), j)); rank += (sj > sc || (sj == sc && j < lane)) ? 1 : 0; }
        const unsigned long long mask = __ballot(rank < 16);
        if (lane == 0) SEL[tq] = mask;
    }
    __syncthreads();
    { const bf16* qp2 = (const bf16*)(ws + WS_QROT) + row * 512 + hq * 64 + 8 * hi;
#pragma unroll
      for (int d0 = 0; d0 < 4; ++d0) qr[d0] = *(const bf16x8*)(qp2 + 16 * d0); }
    const unsigned long long sel = SEL[tl];
    const int jw0 = qb > 8 ? qb - 8 : 0, nB = qb + 1, NT = nB + (qb - jw0 + 1);
    const bf16* ksb = (const bf16*)(ws + WS_KS) + (rowb + lrow) * 128 + kvh * 64 + lch * 8; const bf16* vsb = (const bf16*)(ws + WS_VS) + (rowb + lrow) * 128 + kvh * 64 + lch * 8;
    const bf16* kwb = (const bf16*)(ws + WS_KW) + (rowb + lrow) * 128 + kvh * 64 + lch * 8; const bf16* vwb = (const bf16*)(ws + WS_VW) + (rowb + lrow) * 128 + kvh * 64 + lch * 8;
    u32x4 kreg = *(const u32x4*)ksb, vreg = *(const u32x4*)vsb;
    f32x16 o[2]; o[0] = f32x16{}; o[1] = f32x16{};
    float m = MINIT, l = 0.f;
#ifndef NSA_DBG
#define NSA_DBG 0
#endif
#pragma unroll 1
    for (int n = 0; n < ((NSA_DBG == 1) ? 0 : NT); ++n) {
        LAS unsigned char* kt = KT + (n & 1) * 64 * NSA_KP; LAS unsigned char* vt = VT + (n & 1) * 64 * NSA_VP;
        *(LAS u32x4*)(kt + lrow * NSA_KP + lch * 16) = kreg; *(LAS u32x4*)(vt + lrow * NSA_VP + lch * 16) = vreg;
        if (NSA_DBG == 7 && n >= nB) { unsigned* dbg = (unsigned*)(ws + WS_CTL) + 64; bool bv = false, bk = false;
#pragma unroll
            for (int e = 0; e < 4; ++e) { bv = bv || !(fabsf(bflo(vreg[e])) < 1e30f) || !(fabsf(bfhi(vreg[e])) < 1e30f); bk = bk || !(fabsf(bflo(kreg[e])) < 1e30f) || !(fabsf(bfhi(kreg[e])) < 1e30f); }
            if (bv) atomicAdd(dbg + 6, 1u); if (bk) atomicAdd(dbg + 7, 1u); }
        if (n + 1 < NT) { const int n1 = n + 1;
            if (n1 < nB) { kreg = *(const u32x4*)(ksb + (size_t)n1 * 64 * 128); vreg = *(const u32x4*)(vsb + (size_t)n1 * 64 * 128); }
            else { const int j = jw0 + (n1 - nB); kreg = *(const u32x4*)(kwb + (size_t)j * 64 * 128); vreg = *(const u32x4*)(vwb + (size_t)j * 64 * 128); } }
        __syncthreads();
        if (n == nB) {
            const float lt = xor32_sum(l), sc = glp[8] / lt;
            if (NSA_DBG == 7) { unsigned* dbg = (unsigned*)(ws + WS_CTL) + 64; bool bo = false;
#pragma unroll
                for (int r = 0; r < 16; ++r) bo = bo || !(fabsf(o[0][r]) < 1e30f) || !(fabsf(o[1][r]) < 1e30f);
                if (!(lt > 0.f && lt < 1e30f)) atomicAdd(dbg + 0, 1u); if (bo) atomicAdd(dbg + 1, 1u); if (!(fabsf(glp[8]) < 1e30f)) atomicAdd(dbg + 4, 1u); }
#pragma unroll
            for (int r = 0; r < 16; ++r) { float a0 = sc * o[0][r], a1 = sc * o[1][r];
                if (NSA_DBG == 5) { a0 = (a0 == a0 && fabsf(a0) < 1e30f) ? a0 : 0.f; a1 = (a1 == a1 && fabsf(a1) < 1e30f) ? a1 : 0.f; }
                otot[0][r] += a0; otot[1][r] += a1; }
            o[0] = f32x16{}; o[1] = f32x16{}; m = MINIT; l = 0.f;
        }
        if (n < nB) {
            const bool on = (NSA_DBG == 2) ? true : (bool)((sel >> n) & 1ull);
            if (__any(on)) { if (n == qb) nsa_tile<1>(o, m, l, qr, kt, vt, r32, hi, tro, tl, on); else nsa_tile<0>(o, m, l, qr, kt, vt, r32, hi, tro, tl, on); }
        } else {
            const int j = jw0 + (n - nB);
            int md = 0;
            if (NSA_DBG == 8) nsa_tile<0>(o, m, l, qr, kt, vt, r32, hi, tro, tl, true);
            else if (j == qb) { nsa_tile<1>(o, m, l, qr, kt, vt, r32, hi, tro, tl, true); md = 1; }
            else if (j == qb - 8) { nsa_tile<2>(o, m, l, qr, kt, vt, r32, hi, tro, tl, true, (NSA_DBG == 7) ? (unsigned*)(ws + WS_CTL) + 64 : nullptr); md = 2; }
            else nsa_tile<0>(o, m, l, qr, kt, vt, r32, hi, tro, tl, true);
            if (NSA_DBG == 7) { unsigned* dbg = (unsigned*)(ws + WS_CTL) + 64; bool bo = false;
#pragma unroll
                for (int r = 0; r < 16; ++r) bo = bo || !(fabsf(o[0][r]) < 1e30f) || !(fabsf(o[1][r]) < 1e30f);
                if (bo) { atomicAdd(dbg + 8 + md, 1u); if (!(fabsf(m) < 1e30f)) atomicAdd(dbg + 11, 1u); } }
        }
    }
    if (NSA_DBG != 1) {
        const float lt = xor32_sum(l), sc = glp[16] / lt;
        if (NSA_DBG == 7) { unsigned* dbg = (unsigned*)(ws + WS_CTL) + 64; bool bo = false;
#pragma unroll
            for (int r = 0; r < 16; ++r) bo = bo || !(fabsf(o[0][r]) < 1e30f) || !(fabsf(o[1][r]) < 1e30f);
            if (!(lt > 0.f && lt < 1e30f)) atomicAdd(dbg + 2, 1u); if (bo) atomicAdd(dbg + 3, 1u); if (!(fabsf(glp[16]) < 1e30f)) atomicAdd(dbg + 5, 1u); }
#pragma unroll
        for (int r = 0; r < 16; ++r) { otot[0][r] += sc * o[0][r]; otot[1][r] += sc * o[1][r]; }
    }
    const bf16* ngp = (const bf16*)(ws + WS_NG) + row * 512 + hq * 64; bf16* yp = (bf16*)(ws + WS_YMIX) + row * 1024 + 512 + hq * 64;
#pragma unroll
    for (int db = 0; db < 2; ++db)
#pragma unroll
        for (int q = 0; q < 4; ++q) {
            const int d = 32 * db + 8 * q + 4 * hi;
            const u32x2 ng = *(const u32x2*)(ngp + d);
            if (NSA_DBG == 4 || NSA_DBG == 7) {
#pragma unroll
                for (int e = 0; e < 4; ++e) { const float x = otot[db][4 * q + e]; otot[db][4 * q + e] = (x == x && fabsf(x) < 1e30f) ? x : 0.f; } }
            u32x2 ov; ov.x = pk2(otot[db][4 * q] * bflo(ng.x), otot[db][4 * q + 1] * bfhi(ng.x)); ov.y = pk2(otot[db][4 * q + 2] * bflo(ng.y), otot[db][4 * q + 3] * bfhi(ng.y));
            *(u32x2*)(yp + d) = ov;
        }
}

__device__ __forceinline__ float red16(float v) { v += __shfl_xor(v, 1); v += __shfl_xor(v, 2); v += __shfl_xor(v, 4); v += __shfl_xor(v, 8); return v; }
__device__ __forceinline__ float dot4(const f32x4 a, const f32x4 b) { return (a.x * b.x + a.y * b.y) + (a.z * b.z + a.w * b.w); }

__device__ __forceinline__ void dec_block(float (&m)[4], float (&l)[4], f32x4 (&o)[4], const f32x4 (&q)[4], const float* Kb, const float* Vb, int lo, int hi_, int kk) {
#pragma unroll 1
    for (int sb = 0; sb < 4; ++sb) {
        if (16 * sb >= hi_ || 16 * sb + 16 <= lo) continue;
        float s[4][4]; f32x4 vr[4];
#pragma unroll
        for (int it = 0; it < 4; ++it) {
            const int key = 16 * sb + 4 * it + kk; const bool valid = key >= lo && key < hi_; const int kc = valid ? key : lo;
            const f32x4 kr = *(const f32x4*)(Kb + (size_t)kc * 128); vr[it] = *(const f32x4*)(Vb + (size_t)kc * 128);
#pragma unroll
            for (int g = 0; g < 4; ++g) { const float d = red16(dot4(q[g], kr)); s[it][g] = valid ? d : NEGBIG; }
        }
#pragma unroll
        for (int g = 0; g < 4; ++g) {
            float mx = fmaxf(fmaxf(s[0][g], s[1][g]), fmaxf(s[2][g], s[3][g]));
            mx = fmaxf(mx, __shfl_xor(mx, 16)); mx = fmaxf(mx, __shfl_xor(mx, 32));
            const float mn = fmaxf(m[g], mx), alpha = exp2f(m[g] - mn);
            m[g] = mn; l[g] *= alpha; o[g] = o[g] * alpha;
#pragma unroll
            for (int it = 0; it < 4; ++it) { const float p = exp2f(s[it][g] - mn); l[g] += p; o[g] = o[g] + vr[it] * p; }
        }
    }
}
__device__ __forceinline__ void dec_publish(const float (&m)[4], float (&l)[4], f32x4 (&o)[4], LAS float* st, LAS float* ob, int wave, int lane) {
#pragma unroll
    for (int g = 0; g < 4; ++g) {
        l[g] += __shfl_xor(l[g], 16); l[g] += __shfl_xor(l[g], 32);
#pragma unroll
        for (int e = 0; e < 4; ++e) { float x = o[g][e]; x += __shfl_xor(x, 16); x += __shfl_xor(x, 32); o[g][e] = x; }
        if (lane < 16) *(LAS f32x4*)(ob + (wave * 4 + g) * 64 + 4 * lane) = o[g];
        if (lane == 0) { st[(wave * 4 + g) * 2] = m[g]; st[(wave * 4 + g) * 2 + 1] = l[g]; }
    }
}
__device__ __forceinline__ float dec_combine(LAS const float* st, LAS const float* ob, int g, int d) {
    float M = NEGBIG;
#pragma unroll
    for (int w = 0; w < 8; ++w) M = fmaxf(M, st[(w * 4 + g) * 2]);
    float L = 0.f, O = 0.f;
#pragma unroll
    for (int w = 0; w < 8; ++w) { const float f = exp2f(st[(w * 4 + g) * 2] - M); L += f * st[(w * 4 + g) * 2 + 1]; O += f * ob[(w * 4 + g) * 64 + d]; }
    return L > 0.f ? O / L : 0.f;
}

__device__ __forceinline__ void nsa_decode_unit(const Args& A, LAS unsigned char* lds, int unit, int tid, int lane, int wave) {
    unsigned char* ws = A.ws;
    const int b = unit >> 4, t = (unit >> 1) & 7, kvh = unit & 1, kk = lane >> 4, dq = lane & 15;
    const size_t row = (size_t)NP + b * 8 + t;
    LAS float* sc = (LAS float*)lds;
    LAS float* scr = sc + 2048;
    LAS int* selL = (LAS int*)(scr + 260);
    LAS float* ocmp = (LAS float*)(selL + 16);
    LAS float* st1 = ocmp + 2048; LAS float* ob1 = st1 + 64;
    LAS float* st2 = ob1 + 2048; LAS float* ob2 = st2 + 64;
    f32x4 qn[4], qr[4];
#pragma unroll
    for (int g = 0; g < 4; ++g) {
        const u32x2 a = *(const u32x2*)((const bf16*)(ws + WS_QN) + row * 512 + (kvh * 4 + g) * 64 + 4 * dq), c = *(const u32x2*)((const bf16*)(ws + WS_QROT) + row * 512 + (kvh * 4 + g) * 64 + 4 * dq);
        qn[g] = (f32x4){bflo(a.x), bfhi(a.x), bflo(a.y), bfhi(a.y)}; qr[g] = (f32x4){bflo(c.x), bfhi(c.x), bflo(c.y), bfhi(c.y)};
    }
    __syncthreads();
    const float* kcs = (const float*)(ws + WS_KCS) + ((size_t)b * 512 * 2 + kvh) * 64 + 4 * dq; const float* vcs = (const float*)(ws + WS_VCS) + ((size_t)b * 512 * 2 + kvh) * 64 + 4 * dq;
#pragma unroll 4
    for (int it = 0; it < 16; ++it) {
        const int key = 64 * wave + 4 * it + kk;
        const f32x4 kr = *(const f32x4*)(kcs + (size_t)key * 128);
        const float s0 = red16(dot4(qn[0], kr)), s1 = red16(dot4(qn[1], kr)), s2 = red16(dot4(qn[2], kr)), s3 = red16(dot4(qn[3], kr));
        if (dq < 4) sc[dq * 512 + key] = dq == 0 ? s0 : dq == 1 ? s1 : dq == 2 ? s2 : s3;
    }
    __syncthreads();
    if (wave < 4) {
        float v[8], mx = NEGBIG;
#pragma unroll
        for (int i = 0; i < 8; ++i) { v[i] = sc[wave * 512 + lane + 64 * i]; mx = fmaxf(mx, v[i]); }
        mx = wave_max(mx); float sm = 0.f;
#pragma unroll
        for (int i = 0; i < 8; ++i) { v[i] = exp2f(v[i] - mx); sm += v[i]; }
        sm = wave_sum(sm); const float inv = 1.f / sm;
#pragma unroll
        for (int i = 0; i < 8; ++i) sc[wave * 512 + lane + 64 * i] = v[i] * inv;
    }
    __syncthreads();
    if (tid < 257) { float s = 1e4f; if (tid > 0 && tid < 256) s = (sc[2 * tid] + sc[2 * tid + 1]) + (sc[512 + 2 * tid] + sc[512 + 2 * tid + 1]) + ((sc[1024 + 2 * tid] + sc[1024 + 2 * tid + 1]) + (sc[1536 + 2 * tid] + sc[1536 + 2 * tid + 1])); scr[tid] = s; }
    {
        f32x4 oc[4]; oc[0] = oc[1] = oc[2] = oc[3] = (f32x4){0.f, 0.f, 0.f, 0.f};
#pragma unroll 4
        for (int it = 0; it < 16; ++it) {
            const int key = 64 * wave + 4 * it + kk;
            const f32x4 vr = *(const f32x4*)(vcs + (size_t)key * 128);
#pragma unroll
            for (int g = 0; g < 4; ++g) oc[g] = oc[g] + vr * sc[g * 512 + key];
        }
#pragma unroll
        for (int g = 0; g < 4; ++g) {
#pragma unroll
            for (int e = 0; e < 4; ++e) { float x = oc[g][e]; x += __shfl_xor(x, 16); x += __shfl_xor(x, 32); oc[g][e] = x; }
            if (lane < 16) *(LAS f32x4*)(ocmp + (wave * 4 + g) * 64 + 4 * lane) = oc[g];
        }
    }
    __syncthreads();
    if (tid < 257) { const float s = scr[tid]; int rank = 0;
        for (int j = 0; j < 257; ++j) { const float sj = scr[j]; rank += (sj > s || (sj == s && j < tid)) ? 1 : 0; }
        if (rank < 16) selL[rank] = tid; }
    __syncthreads();
    {
        float m[4], l[4]; f32x4 o[4];
#pragma unroll
        for (int g = 0; g < 4; ++g) { m[g] = MINIT; l[g] = 0.f; o[g] = (f32x4){0.f, 0.f, 0.f, 0.f}; }
#pragma unroll 1
        for (int i = 0; i < 2; ++i) {
            const int bb = selL[2 * wave + i];
            if (bb < 256) {
                const size_t base = ((size_t)((const int*)A.in[I_PT])[b * 128 + (bb >> 1)] * 128 + (bb & 1) * 64) * 128 + kvh * 64 + 4 * dq;
                dec_block(m, l, o, qr, (const float*)A.in[I_CSK] + base, (const float*)A.in[I_CSV] + base, 0, 64, kk);
            } else {
                const size_t base = ((size_t)b * 8) * 128 + kvh * 64 + 4 * dq;
                dec_block(m, l, o, qr, A.out + O_SLCK_S + base, A.out + O_SLCV_S + base, 0, t + 1, kk);
            }
        }
        dec_publish(m, l, o, st1, ob1, wave, lane);
    }
    {
        float m[4], l[4]; f32x4 o[4];
#pragma unroll
        for (int g = 0; g < 4; ++g) { m[g] = MINIT; l[g] = 0.f; o[g] = (f32x4){0.f, 0.f, 0.f, 0.f}; }
        const size_t base = ((size_t)b * 512 + 64 * wave) * 128 + kvh * 64 + 4 * dq;
        const int lo = (t > 64 * wave) ? (t - 64 * wave) : 0;
        dec_block(m, l, o, qr, (const float*)A.in[I_SWK] + base, (const float*)A.in[I_SWV] + base, lo, 64, kk);
        if (wave == 0) { const size_t nb = ((size_t)b * 512 + 504) * 128 + kvh * 64 + 4 * dq; dec_block(m, l, o, qr, A.out + O_WINK_S + nb, A.out + O_WINV_S + nb, 0, t + 1, kk); }
        dec_publish(m, l, o, st2, ob2, wave, lane);
    }
    __syncthreads();
    if (tid < 256) {
        const int g = tid >> 6, d = tid & 63, hq = kvh * 4 + g;
        float oc = 0.f;
#pragma unroll
        for (int w = 0; w < 8; ++w) oc += ocmp[(w * 4 + g) * 64 + d];
        const float os = dec_combine(st1, ob1, g, d), ow = dec_combine(st2, ob2, g, d);
        const float* glp = (const float*)(ws + WS_GL) + row * 32 + hq;
        const float y = (glp[0] * oc + glp[8] * os + glp[16] * ow) * bf2f(((const bf16*)(ws + WS_NG))[row * 512 + hq * 64 + d]);
        ((bf16*)(ws + WS_YMIX))[row * 1024 + 512 + hq * 64 + d] = (bf16)f2bf(y);
    }
    __syncthreads();
}

struct EpiPle {
    static constexpr bool PERM = true, AFTER_DRAIN = false;
    unsigned char* ws;
    __device__ __forceinline__ void operator()(const pg8::f32x4 (&acc)[2][2][4][2], const pg8::Unit& u, int wr, int wc, int fr, int fq) const {
        asm volatile("" : "+v"(fr), "+v"(fq));
#pragma unroll
        for (int ai = 0; ai < 2; ++ai)
#pragma unroll
            for (int m = 0; m < 4; ++m) {
                const size_t row = (size_t)u.pm * 256 + ai * 128 + wr * 64 + m * 16 + fr;
#pragma unroll
                for (int bj = 0; bj < 2; ++bj) { float* d = (float*)(ws + WS_PPO) + row * 1024 + u.pn * 256 + bj * 128 + wc * 32 + 8 * fq;
                    *(f32x4*)d = acc[ai][bj][m][0]; *(f32x4*)(d + 4) = acc[ai][bj][m][1]; }
            }
    }
};
struct EpiOut {
    static constexpr bool PERM = true, AFTER_DRAIN = false;
    unsigned char* ws; const float* xp; const float* xs;
    __device__ __forceinline__ void operator()(const pg8::f32x4 (&acc)[2][2][4][2], const pg8::Unit& u, int wr, int wc, int fr, int fq) const {
        asm volatile("" : "+v"(fr), "+v"(fq));
#pragma unroll
        for (int ai = 0; ai < 2; ++ai)
#pragma unroll
            for (int m = 0; m < 4; ++m) {
                const size_t row = (size_t)u.pm * 256 + ai * 128 + wr * 64 + m * 16 + fr;
                const float* xrow = (row < NP) ? xp + row * 1024 : xs + (row - NP) * 1024;
                float ss = 0.f;
#pragma unroll
                for (int bj = 0; bj < 2; ++bj) { const int col = u.pn * 256 + bj * 128 + wc * 32 + 8 * fq;
                    const f32x4 a = *(const f32x4*)(xrow + col) + acc[ai][bj][m][0], c = *(const f32x4*)(xrow + col + 4) + acc[ai][bj][m][1];
                    float* d = (float*)(ws + WS_X1) + row * 1024 + col; *(f32x4*)d = a; *(f32x4*)(d + 4) = c;
                    u32x4 w; w.x = pk2(a.x, a.y); w.y = pk2(a.z, a.w); w.z = pk2(c.x, c.y); w.w = pk2(c.z, c.w);
                    *(u32x4*)((bf16*)(ws + WS_X1B) + row * 1024 + col) = w;
                    ss += (a.x * a.x + a.y * a.y) + (a.z * a.z + a.w * a.w) + (c.x * c.x + c.y * c.y) + (c.z * c.z + c.w * c.w); }
                ss += __shfl_xor(ss, 16); ss += __shfl_xor(ss, 32);
                if (fq == 0) ((float*)(ws + WS_SS1))[row * 16 + u.pn * 4 + wc] = ss;
            }
    }
};
struct EpiGate {
    static constexpr bool PERM = true, AFTER_DRAIN = false;
    unsigned char* ws; float* out;
    __device__ __forceinline__ void operator()(const pg8::f32x4 (&acc)[2][2][4][2], const pg8::Unit& u, int wr, int wc, int fr, int fq) const {
        asm volatile("" : "+v"(fr), "+v"(fq));
#pragma unroll
        for (int ai = 0; ai < 2; ++ai)
#pragma unroll
            for (int m = 0; m < 4; ++m) {
                const size_t row = (size_t)u.pm * 256 + ai * 128 + wr * 64 + m * 16 + fr;
                const f32x4* sp = (const f32x4*)((const float*)(ws + WS_SS1) + row * 16);
                const f32x4 s0 = sp[0], s1 = sp[1], s2 = sp[2], s3 = sp[3];
                const float tot = ((s0.x + s0.y) + (s0.z + s0.w)) + ((s1.x + s1.y) + (s1.z + s1.w)) + (((s2.x + s2.y) + (s2.z + s2.w)) + ((s3.x + s3.y) + (s3.z + s3.w)));
                const float rstd = 1.f / sqrtf(tot * (1.f / 1024.f) + RMS_EPS);
                float ss = 0.f;
#pragma unroll
                for (int bj = 0; bj < 2; ++bj) { const int col = u.pn * 256 + bj * 128 + wc * 32 + 8 * fq;
                    const float* x1 = (const float*)(ws + WS_X1) + row * 1024 + col; const float* pp = (const float*)(ws + WS_PPO) + row * 1024 + col;
                    f32x4 a = *(const f32x4*)x1, c = *(const f32x4*)(x1 + 4); const f32x4 pa = *(const f32x4*)pp, pc = *(const f32x4*)(pp + 4);
#pragma unroll
                    for (int e = 0; e < 4; ++e) { a[e] += sigmoidf_(rstd * acc[ai][bj][m][0][e]) * pa[e]; c[e] += sigmoidf_(rstd * acc[ai][bj][m][1][e]) * pc[e]; }
                    float* d = out + O_Y + row * 1024 + col; *(f32x4*)d = a; *(f32x4*)(d + 4) = c;
                    ss += (a.x * a.x + a.y * a.y) + (a.z * a.z + a.w * a.w) + (c.x * c.x + c.y * c.y) + (c.z * c.z + c.w * c.w); }
                ss += __shfl_xor(ss, 16); ss += __shfl_xor(ss, 32);
                if (fq == 0) ((float*)(ws + WS_SS2))[row * 16 + u.pn * 4 + wc] = ss;
            }
    }
};
__device__ __forceinline__ void final_norm(const Args& A, int lane, int wave) {
    const int gw = blockIdx.x * 8 + wave, NGW = gridDim.x * 8;
    const f32x4* nf = (const f32x4*)A.in[I_NF];
    f32x4 g[4];
#pragma unroll
    for (int j = 0; j < 4; ++j) g[j] = nf[64 * j + lane];
    for (int row = gw; row < NTOK; row += NGW) {
        const float* sp = (const float*)(A.ws + WS_SS2) + (size_t)row * 16;
        float tot = 0.f;
#pragma unroll
        for (int i = 0; i < 16; ++i) tot += sp[i];
        const float rstd = 1.f / sqrtf(tot * (1.f / 1024.f) + RMS_EPS);
        f32x4* y = (f32x4*)(A.out + O_Y + (size_t)row * 1024) + lane;
#pragma unroll
        for (int j = 0; j < 4; ++j) { f32x4 v = y[64 * j]; v = v * rstd * g[j]; y[64 * j] = v; }
    }
}

constexpr int N_PHASES = 8;
#ifndef MK_SINGLE
#define MK_SINGLE 1
#endif
__global__ void __launch_bounds__(512, 2) mega_fwd(Args args) {
    extern __shared__ __attribute__((aligned(16))) unsigned char lds_raw[];
    LAS unsigned char* lds = (LAS unsigned char*)lds_raw;
    const int tid = threadIdx.x, lane = tid & 63, wave = __builtin_amdgcn_readfirstlane(tid >> 6);
    volatile LAS unsigned* MISC = (volatile LAS unsigned*)(lds + MISC_OFF);
    if (tid < 64) MISC[tid] = 0u;
    __syncthreads();
    const int lo = args.ph_lo, hi = args.ph_hi;
    XcdBarrier bar; bar.bar = (unsigned*)(args.ws + WS_CTL) + CW_BAR; bar.x = 0; bar.st = nullptr;
    if (hi - lo > 1) bar = xcd_barrier_post((unsigned*)(args.ws + WS_CTL) + CW_BAR, MISC + 8);
#ifndef PH_MASK
#define PH_MASK 0xFF
#endif
#define IN(k) (((PH_MASK >> (k)) & 1) && lo <= (k) && (k) < hi)
#define SEAM(k) do { if (IN(k) && IN((k) + 1)) xcd_barrier(bar); } while (0)
    unsigned char* ws = args.ws;
    const int G = gridDim.x, bx = blockIdx.x;

    if (IN(0)) { phase0(args, lds, tid, lane, wave); }
    SEAM(0);
    if (IN(1)) {
        { pg8::Gemm g{(const pg8::bf16_t*)(ws + WS_H), (const pg8::bf16_t*)(ws + WS_WINT), NTOK, NPR, DM}; pg8::StaticOrder S; S.init(NTOK, NPR, G, bx);
          EpiInProj E{ws, args.out};
          pg8::gemm_phase<EpiInProj, pg8::StaticOrder, true, true>(lds, g, S, E); }
        for (int u = G - 1 - bx; u < NTOK / 128; u += G) ngl_unit(ws, u, lane, wave);
        for (int u = bx; u < 256; u += G) compress_unit<true>(args, lds, u, tid, lane, wave);
    }
    SEAM(1);
    if (IN(2)) {
#ifndef P2_PARTS
#define P2_PARTS 15
#endif
        if (P2_PARTS & 1) { int kple = 256; asm volatile("" : "+s"(kple));
          pg8::Gemm g{(const pg8::bf16_t*)(ws + WS_PB), (const pg8::bf16_t*)(ws + WS_WPLET), NTOK, 1024, kple}; pg8::StaticOrder S; S.init(NTOK, 1024, G, bx);
          EpiPle E{ws};
          pg8::gemm_phase<EpiPle, pg8::StaticOrder, true, true>(lds, g, S, E); }
        if (P2_PARTS & 2) for (int u = G - 1 - bx; u < 8; u += G) compress_unit<false>(args, lds, u, tid, lane, wave);
        if (P2_PARTS & 4) for (int u = bx; u < 512; u += G) ret_pass1_unit(ws, lds, u, tid, lane, wave);
        if (P2_PARTS & 8) for (int u = bx; u < 128; u += G) ret_decode_unit(args, lds, u, tid, lane, wave);
    }
    SEAM(2);
    if (IN(3)) {
#ifndef P3_PARTS
#define P3_PARTS 7
#endif
        if (P3_PARTS & 1) ret_pass2(args, tid);
        if (P3_PARTS & 2) for (int pi = bx; pi < 512; pi += G) { const int pr = pi & 255, b = pr >> 6, kvh = (pr >> 5) & 1, s = pr & 31;
            nsa_prompt_unit(args, lds, b, kvh, (pi >= 256) ? s : 63 - s, tid, lane, wave); }
        if (P3_PARTS & 4) for (int u = bx; u < 512; u += G) nsa_decode_unit(args, lds, u, tid, lane, wave);
    }
    SEAM(3);
    if (IN(4)) {
        for (int u = bx; u < 512; u += G) ret_pass3_unit(args, lds, u, tid, lane, wave);
    }
    SEAM(4);
    if (IN(5)) {
        pg8::Gemm g{(const pg8::bf16_t*)(ws + WS_YMIX), (const pg8::bf16_t*)(ws + WS_WOUTT), NTOK, 1024, 1024}; pg8::StaticOrder S; S.init(NTOK, 1024, G, bx);
        EpiOut E{ws, (const float*)args.in[I_XP], (const float*)args.in[I_XS]};
        pg8::gemm_phase<EpiOut, pg8::StaticOrder, true, true>(lds, g, S, E);
    }
    SEAM(5);
    if (IN(6)) {
        pg8::Gemm g{(const pg8::bf16_t*)(ws + WS_X1B), (const pg8::bf16_t*)(ws + WS_WGT), NTOK, 1024, 1024}; pg8::StaticOrder S; S.init(NTOK, 1024, G, bx);
        EpiGate E{ws, args.out};
        pg8::gemm_phase<EpiGate, pg8::StaticOrder, true, true>(lds, g, S, E);
    }
    SEAM(6);
#ifndef DBG_SHIFT
#define DBG_SHIFT 12
#endif
    if (IN(7)) { if (NSA_DBG == 7) { if (bx == 0 && tid == 0) { const unsigned* dbg = (const unsigned*)(ws + WS_CTL) + 64; unsigned code = 1;
                     for (int k = 0; k < 4; ++k) code += (dbg[DBG_SHIFT + k] > 0u) ? (1u << k) : 0u; args.out[0] = 1e5f * (float)code; } }
                 else final_norm(args, lane, wave); }
#undef IN
#undef SEAM
}

extern "C" void kernel_launch(void* const* d_in, const int* in_sizes, int n_in, void* d_out, int out_size, void* d_ws, size_t ws_size, hipStream_t stream) {
    static int grid = 0;
    if (grid == 0) {
        if (n_in != N_IN || out_size != (int)O_END || ws_size < WS_END) { fprintf(stderr, "kernel_launch: unexpected shapes (n_in %d, out %d, ws %zu); nothing launched\n", n_in, out_size, ws_size); grid = -1; return; }
        int dev = 0, cus = 0, per_cu = 0;
        if (hipGetDevice(&dev) != hipSuccess || hipDeviceGetAttribute(&cus, hipDeviceAttributeMultiprocessorCount, dev) != hipSuccess) { grid = -1; return; }
        if (hipFuncSetAttribute((const void*)mega_fwd, hipFuncAttributeMaxDynamicSharedMemorySize, LDS_BYTES) != hipSuccess) { fprintf(stderr, "kernel_launch: hipFuncSetAttribute failed\n"); grid = -1; return; }
        if (hipOccupancyMaxActiveBlocksPerMultiprocessor(&per_cu, (const void*)mega_fwd, 512, LDS_BYTES) != hipSuccess || per_cu < 1) { fprintf(stderr, "kernel_launch: occupancy query says %d blocks per CU\n", per_cu); }
        (void)hipGetLastError();
        grid = cus;
    }
    if (grid < 0) return;
    (void)hipMemsetAsync((char*)d_ws + WS_CTL, 0, CTL_ZERO_BYTES, stream);
    Args a{};
    for (int i = 0; i < N_IN; ++i) a.in[i] = d_in[i];
    a.out = (float*)d_out; a.ws = (unsigned char*)d_ws;
#if MK_SINGLE
    a.ph_lo = 0; a.ph_hi = N_PHASES;
    hipLaunchKernelGGL(mega_fwd, dim3(grid), dim3(512), LDS_BYTES, stream, a);
#else
    for (int p = 0; p < N_PHASES; ++p) { a.ph_lo = p; a.ph_hi = p + 1; hipLaunchKernelGGL(mega_fwd, dim3(grid), dim3(512), LDS_BYTES, stream, a); }
#endif
}
```

```cpp
#include <hip/hip_runtime.h>
#include <cstdio>
#include <cstdint>
namespace pg8 {
#define PG8_LAS __attribute__((address_space(3)))
typedef unsigned short bf16_t;
typedef short bf16x8 __attribute__((ext_vector_type(8)));
typedef float f32x4 __attribute__((ext_vector_type(4)));
typedef unsigned u32x4 __attribute__((ext_vector_type(4)));
constexpr int BM = 256, BK = 64, HALF = 128, HTB = HALF * BK * 2  , STAGE_BYTES = 8 * HTB, NXCD = 8, WGM = 8;

__host__ __device__ __forceinline__ int lds_byte(int r, int c) { const int st = (r >> 4) * 2 + (c >> 5), rr = r & 15, cc = c & 31, ob = rr * 64 + cc * 2; return st * 1024 + (ob ^ (((ob >> 9) & 1) << 5)); }
__host__ __device__ __forceinline__ void stage_rc(int b, int& R, int& C) { const int st = b / 1024, sb = b % 1024, swz = sb ^ (((sb >> 9) & 1) << 5); R = (st >> 1) * 16 + swz / 64; C = (st & 1) * 32 + (swz % 64) / 2; }
__host__ __device__ __forceinline__ int perm32(int rho) { const int n = rho >> 4, i = rho & 15; return 8 * (i >> 2) + 4 * n + (i & 3); }

struct Unit { int pm, pn; };
struct Gemm { const bf16_t* A; const bf16_t* Bt; int M, N, K; };

struct StaticOrder {
    int nM, nN, nwg, G, c;
    __host__ __device__ void init(int M, int N, int G_, int c_) { nM = M / BM; nN = N / BM; nwg = nM * nN; G = G_; c = c_; }
    __host__ __device__ bool next(int i, Unit& u) const {
        const long L = (long)i * G + c; if (L >= nwg) return false;
        int wgid = (int)L; { const int q = nwg / NXCD, r = nwg % NXCD, xcd = wgid % NXCD, off = wgid / NXCD; wgid = (xcd < r ? xcd * (q + 1) : r * (q + 1) + (xcd - r) * q) + off; }
        const int nig = WGM * nN, gid = wgid / nig, fm = gid * WGM, gsz = (nM - fm) < WGM ? (nM - fm) : WGM;
        u.pm = fm + ((wgid % nig) % gsz); u.pn = (wgid % nig) / gsz; return true;
    }
    __device__ __forceinline__ void a_ready(const Unit&) const {}
    __device__ __forceinline__ void done(const Unit&) const {}
};
template <class Epi, class Sched, bool ALIGN_EPI = false, bool SP2 = false>
__device__ __forceinline__ void gemm_phase(PG8_LAS unsigned char* lds, const Gemm g, const Sched& S, const Epi& E) {
    const int tid = threadIdx.x, wid = __builtin_amdgcn_readfirstlane(tid >> 6), lane = tid & 63, wr = wid >> 2, wc = wid & 3, fr = lane & 15, fq = lane >> 4;
    const int K = g.K, nt = K / BK;
    unsigned voffA[2], voffB[2];
#pragma unroll
    for (int i = 0; i < 2; ++i) { int R, C; stage_rc(tid * 16 + i * 8192, R, C); const int Rb = Epi::PERM ? ((R & ~31) + perm32(R & 31)) : R;
        voffA[i] = (unsigned)(R * K + C) * 2u; voffB[i] = (unsigned)(Rb * K + C) * 2u; }
    const size_t kstep = (size_t)(BK * 2);
    const size_t hstep = (size_t)HALF * K * 2;
    const size_t tstep = 2 * hstep;
    const unsigned ldsw = (unsigned)wid * 1024u;
    const int aoff = lds_byte(wr * 64 + fr, fq * 8), boff = lds_byte(wc * 32 + fr, fq * 8);
#define PG8_SA(b, h) (((b) * 2 + (h)) * HTB)
#define PG8_SB(b, h) ((4 + (b) * 2 + (h)) * HTB)
#define PG8_STAGE(bufoff, gbase, voff) do { _Pragma("unroll") for (int _i = 0; _i < 2; ++_i) \
        __builtin_amdgcn_global_load_lds((const unsigned*)((const char*)(gbase) + (voff)[_i]), (PG8_LAS unsigned*)(lds + (bufoff) + ldsw + _i * 8192), 16, 0, 0); } while (0)
#define PG8_LDA(dst, b, h) do { _Pragma("unroll") for (int m = 0; m < 4; ++m) _Pragma("unroll") for (int k = 0; k < 2; ++k) dst[m][k] = *(const PG8_LAS bf16x8*)(lds + PG8_SA(b, h) + aoff + m * 2048 + k * 1024); } while (0)
#define PG8_LDB(dst, b, h) do { _Pragma("unroll") for (int n = 0; n < 2; ++n) _Pragma("unroll") for (int k = 0; k < 2; ++k) dst[n][k] = *(const PG8_LAS bf16x8*)(lds + PG8_SB(b, h) + boff + n * 2048 + k * 1024); } while (0)
#define PG8_MMA(ai, bj, At, Bt) do { __builtin_amdgcn_s_setprio(1); _Pragma("unroll") for (int m = 0; m < 4; ++m) _Pragma("unroll") for (int n = 0; n < 2; ++n) _Pragma("unroll") for (int k = 0; k < 2; ++k) \
        acc[ai][bj][m][n] = __builtin_amdgcn_mfma_f32_16x16x32_bf16(Bt[n][k], At[m][k], acc[ai][bj][m][n], 0, 0, 0); __builtin_amdgcn_s_setprio(0); } while (0)
#define PG8_WAIT_V(n) asm volatile("s_waitcnt vmcnt(" #n ")" ::: "memory")
#define PG8_WAIT_L(n) asm volatile("s_waitcnt lgkmcnt(" #n ")" ::: "memory")
#define PG8_BAR __builtin_amdgcn_s_barrier()
#define PG8_SCHED __builtin_amdgcn_sched_barrier(0)
    Unit cur, nxt; int ui = 0;
    if (!S.next(0, cur)) return;
    f32x4 acc[2][2][4][2];
#pragma unroll
    for (int a = 0; a < 2; ++a)
#pragma unroll
        for (int b = 0; b < 2; ++b)
#pragma unroll
            for (int m = 0; m < 4; ++m)
#pragma unroll
                for (int n = 0; n < 2; ++n) acc[a][b][m][n] = (f32x4){0.f, 0.f, 0.f, 0.f};
    bf16x8 At[4][2], B0[2][2], B1[2][2];
    const char* cA = (const char*)g.A + (size_t)cur.pm * tstep; const char* cB = (const char*)g.Bt + (size_t)cur.pn * tstep;
    S.a_ready(cur);
    if constexpr (SP2) {
        PG8_STAGE(PG8_SB(0, 0), cB, voffB); PG8_STAGE(PG8_SB(0, 1), cB + hstep, voffB); PG8_STAGE(PG8_SA(0, 0), cA, voffA); PG8_STAGE(PG8_SA(0, 1), cA + hstep, voffA);
        if (wr == 1) PG8_BAR;
        PG8_WAIT_V(2); PG8_BAR;
        PG8_STAGE(PG8_SB(1, 0), cB + kstep, voffB); PG8_STAGE(PG8_SA(1, 0), cA + kstep, voffA); PG8_STAGE(PG8_SB(1, 1), cB + hstep + kstep, voffB);
        PG8_WAIT_V(6); PG8_BAR;
    } else {
        PG8_STAGE(PG8_SB(0, 0), cB, voffB); PG8_STAGE(PG8_SA(0, 0), cA, voffA); PG8_STAGE(PG8_SB(0, 1), cB + hstep, voffB); PG8_STAGE(PG8_SA(0, 1), cA + hstep, voffA);
        if (wr == 1) PG8_BAR;
        PG8_WAIT_V(4); PG8_BAR;
        PG8_STAGE(PG8_SB(1, 0), cB + kstep, voffB); PG8_STAGE(PG8_SA(1, 0), cA + kstep, voffA); PG8_STAGE(PG8_SB(1, 1), cB + hstep + kstep, voffB);
        PG8_WAIT_V(6); PG8_BAR;
    }
    for (;;) {
        const bool has_next = S.next(ui + 1, nxt);
        const char* nA = has_next ? (const char*)g.A + (size_t)nxt.pm * tstep : cA; const char* nB = has_next ? (const char*)g.Bt + (size_t)nxt.pn * tstep : cB;
        for (int t = 0; t < nt; t += 2) {
            const bool last = (t == nt - 2);
            const char* a1 = cA + (size_t)(t + 1) * kstep;
            const char* a2 = last ? nA : cA + (size_t)(t + 2) * kstep; const char* b2 = last ? nB : cB + (size_t)(t + 2) * kstep;
            const char* a3 = a2 + kstep; const char* b3 = b2 + kstep;
            if (last && has_next) S.a_ready(nxt);
            if constexpr (SP2) {
            PG8_LDB(B0, 0, 0); PG8_LDB(B1, 0, 1); PG8_SCHED; PG8_LDA(At, 0, 0); PG8_STAGE(PG8_SA(1, 1), a1 + hstep, voffA);
            PG8_WAIT_V(8); PG8_WAIT_L(0); PG8_BAR; PG8_MMA(0, 0, At, B0); PG8_MMA(0, 1, At, B1); PG8_BAR; PG8_SCHED;
            PG8_LDA(At, 0, 1); PG8_STAGE(PG8_SB(0, 0), b2, voffB); PG8_STAGE(PG8_SB(0, 1), b2 + hstep, voffB); PG8_STAGE(PG8_SA(0, 0), a2, voffA);
            PG8_WAIT_V(8); PG8_WAIT_L(0); PG8_BAR; PG8_MMA(1, 0, At, B0); PG8_MMA(1, 1, At, B1); PG8_BAR; PG8_SCHED;
            PG8_LDB(B0, 1, 0); PG8_LDB(B1, 1, 1); PG8_SCHED; PG8_LDA(At, 1, 0); PG8_STAGE(PG8_SA(0, 1), a2 + hstep, voffA);
            PG8_WAIT_V(8); PG8_WAIT_L(0); PG8_BAR; PG8_MMA(0, 0, At, B0); PG8_MMA(0, 1, At, B1); PG8_BAR; PG8_SCHED;
            PG8_LDA(At, 1, 1); PG8_STAGE(PG8_SB(1, 0), b3, voffB); PG8_STAGE(PG8_SB(1, 1), b3 + hstep, voffB); PG8_STAGE(PG8_SA(1, 0), a3, voffA);
            PG8_WAIT_V(8); PG8_WAIT_L(0); PG8_BAR; PG8_MMA(1, 0, At, B0); PG8_MMA(1, 1, At, B1); PG8_BAR; PG8_SCHED;
            } else {
            PG8_LDB(B0, 0, 0); PG8_SCHED; PG8_LDA(At, 0, 0); PG8_STAGE(PG8_SA(1, 1), a1 + hstep, voffA);
            PG8_WAIT_L(8); PG8_BAR; PG8_WAIT_L(0); PG8_MMA(0, 0, At, B0); PG8_BAR; PG8_SCHED;
            PG8_LDB(B1, 0, 1); PG8_STAGE(PG8_SB(0, 0), b2, voffB);
            PG8_BAR; PG8_WAIT_L(0); PG8_MMA(0, 1, At, B1); PG8_BAR;
            PG8_LDA(At, 0, 1); PG8_STAGE(PG8_SA(0, 0), a2, voffA);
            PG8_BAR; PG8_WAIT_L(0); PG8_MMA(1, 0, At, B0); PG8_BAR; PG8_SCHED;
            PG8_STAGE(PG8_SB(0, 1), b2 + hstep, voffB);
            PG8_WAIT_V(6); PG8_BAR; PG8_MMA(1, 1, At, B1); PG8_BAR;
            PG8_LDB(B0, 1, 0); PG8_SCHED; PG8_LDA(At, 1, 0); PG8_STAGE(PG8_SA(0, 1), a2 + hstep, voffA);
            PG8_WAIT_L(8); PG8_BAR; PG8_WAIT_L(0); PG8_MMA(0, 0, At, B0); PG8_BAR; PG8_SCHED;
            PG8_LDB(B1, 1, 1); PG8_STAGE(PG8_SB(1, 0), b3, voffB);
            PG8_BAR; PG8_WAIT_L(0); PG8_MMA(0, 1, At, B1); PG8_BAR;
            PG8_LDA(At, 1, 1); PG8_STAGE(PG8_SA(1, 0), a3, voffA);
            PG8_BAR; PG8_WAIT_L(0); PG8_MMA(1, 0, At, B0); PG8_BAR; PG8_SCHED;
            PG8_STAGE(PG8_SB(1, 1), b3 + hstep, voffB);
            PG8_WAIT_V(6); PG8_BAR; PG8_MMA(1, 1, At, B1); PG8_BAR;
            }
        }
        if constexpr (ALIGN_EPI) { if (wr == 0) PG8_BAR; }
        if constexpr (!Epi::AFTER_DRAIN) { E(acc, cur, wr, wc, fr, fq); S.done(cur); }
        if (!has_next) break;
#pragma unroll
        for (int a = 0; a < 2; ++a)
#pragma unroll
            for (int b = 0; b < 2; ++b)
#pragma unroll
                for (int m = 0; m < 4; ++m)
#pragma unroll
                    for (int n = 0; n < 2; ++n) acc[a][b][m][n] = (f32x4){0.f, 0.f, 0.f, 0.f};
        cur = nxt; cA = nA; cB = nB; ++ui;
        if constexpr (ALIGN_EPI) { if (wr == 1) PG8_BAR; }
    }
    PG8_WAIT_V(0);
    if constexpr (!ALIGN_EPI) { if (wr == 0) PG8_BAR; }
    PG8_BAR;
    if constexpr (Epi::AFTER_DRAIN) { E.fused(acc, cur, wr, wc, fr, fq, lds, wid, lane); S.done(cur); }
#undef PG8_SA
#undef PG8_SB
#undef PG8_STAGE
#undef PG8_LDA
#undef PG8_LDB
#undef PG8_MMA
#undef PG8_WAIT_V
#undef PG8_WAIT_L
#undef PG8_BAR
#undef PG8_SCHED
}
}

#define GAS __attribute__((address_space(1)))
#define LAS __attribute__((address_space(3)))
typedef unsigned short bf16;
typedef short bf16x8 __attribute__((ext_vector_type(8)));
typedef short s16x4 __attribute__((ext_vector_type(4)));
typedef float f32x2 __attribute__((ext_vector_type(2)));
typedef float f32x4 __attribute__((ext_vector_type(4)));
typedef float f32x16 __attribute__((ext_vector_type(16)));
typedef unsigned u32x2 __attribute__((ext_vector_type(2)));
typedef unsigned u32x4 __attribute__((ext_vector_type(4)));
typedef __bf16 bf16x2_t __attribute__((ext_vector_type(2)));

constexpr int NP = 16384, ND = 256, NTOK = NP + ND;
constexpr int SEQ = 4096, NBATCH = 4, DBATCH = 32, DSEQ = 8, PAST = 16384;
constexpr int DM = 1024, NPR = 3840, PROJW = 3864;
constexpr int NPOS = SEQ + DSEQ;
constexpr float C2 = 0.125f * 1.4426950408889634f;
constexpr float RMS_EPS = 1e-6f, GN_EPS = 1e-5f;
constexpr float NEGBIG = -1e30f, MINIT = -1e4f;

constexpr size_t O_Y = 0;
constexpr size_t O_RETP = (size_t)NTOK * 1024;
constexpr size_t O_CMPK_P = O_RETP + 4 * 4 * 128 * 128;
constexpr size_t O_CMPV_P = O_CMPK_P + (size_t)NP * 128;
constexpr size_t O_SLCK_P = O_CMPV_P + (size_t)NP * 128;
constexpr size_t O_SLCV_P = O_SLCK_P + (size_t)NP * 128;
constexpr size_t O_WINK_P = O_SLCV_P + (size_t)NP * 128;
constexpr size_t O_WINV_P = O_WINK_P + 4 * 512 * 128;
constexpr size_t O_RETS = O_WINV_P + 4 * 512 * 128;
constexpr size_t O_CMPK_S = O_RETS + (size_t)32 * 4 * 128 * 128;
constexpr size_t O_CMPV_S = O_CMPK_S + ND * 128;
constexpr size_t O_SLCK_S = O_CMPV_S + ND * 128;
constexpr size_t O_SLCV_S = O_SLCK_S + ND * 128;
constexpr size_t O_WINK_S = O_SLCV_S + ND * 128;
constexpr size_t O_WINV_S = O_WINK_S + (size_t)32 * 512 * 128;
constexpr size_t O_END = O_WINV_S + (size_t)32 * 512 * 128;
static_assert(O_END == 32636928, "output size");

enum { I_XP = 0, I_XS, I_CCK, I_CCV, I_CSK, I_CSV, I_SWK, I_SWV, I_SRET, I_PT, I_PP, I_PS, I_NMIX, I_WIN, I_GNG, I_GNB, I_PEK, I_W1K, I_W2K, I_PEV, I_W1V, I_W2V, I_WOUT, I_NPLE, I_WG, I_WPLE, I_NF, N_IN };

constexpr size_t MiB = 1u << 20;
constexpr size_t WS_CTL = 0, CTL_ZERO_BYTES = 1 * MiB;
constexpr size_t WS_COSR = 1 * MiB;
constexpr size_t WS_SINR = WS_COSR + (size_t)NPOS * 64 * 4;
constexpr size_t WS_COSN = WS_SINR + (size_t)NPOS * 64 * 4;
constexpr size_t WS_SINN = WS_COSN + (size_t)NPOS * 32 * 4;
constexpr size_t WS_CBIAS = 5 * MiB;
constexpr size_t WS_W2T = WS_CBIAS + 65536;
constexpr size_t WS_W1T = 6 * MiB;
constexpr size_t WS_WINT = 8 * MiB;
constexpr size_t WS_WNGLT = 16 * MiB;
constexpr size_t WS_WOUTT = 17 * MiB;
constexpr size_t WS_WGT = 19 * MiB;
constexpr size_t WS_WPLET = 21 * MiB;
constexpr size_t WS_H = 24 * MiB;
constexpr size_t WS_PB = 57 * MiB;
constexpr size_t WS_QR = 66 * MiB, WS_KR = 83 * MiB, WS_VR = 100 * MiB, WS_RG = 117 * MiB, WS_QN = 134 * MiB, WS_QROT = 151 * MiB, WS_NG = 168 * MiB;
constexpr size_t WS_KS = 185 * MiB, WS_VS = 190 * MiB, WS_KW = 195 * MiB, WS_VW = 200 * MiB;
constexpr size_t WS_GL = 205 * MiB;
constexpr size_t WS_KCP = 208 * MiB, WS_VCP = WS_KCP + 131072;
constexpr size_t WS_KCS = 209 * MiB, WS_VCS = 217 * MiB;
constexpr size_t WS_KVT = 225 * MiB;
constexpr size_t WS_ST = 257 * MiB;
constexpr size_t WS_YMIX = 273 * MiB;
constexpr size_t WS_X1 = 306 * MiB;
constexpr size_t WS_X1B = 371 * MiB;
constexpr size_t WS_PPO = 404 * MiB;
constexpr size_t WS_SS1 = 469 * MiB;
constexpr size_t WS_SS2 = 471 * MiB;
constexpr size_t WS_SS1D = 473 * MiB, WS_SS2D = WS_SS1D + 65536;
constexpr size_t WS_END = 474 * MiB;
constexpr int CW_BAR = 4096;

constexpr int LDS_BYTES = 147456;
constexpr int MISC_OFF = LDS_BYTES - 256;

#define CM(col, row) (((size_t)((col) >> 3) * NTOK + (size_t)(row)) * 8 + ((col) & 7))
struct Args { const void* in[N_IN]; float* out; unsigned char* ws; int ph_lo, ph_hi, rep, pad; };

__device__ __forceinline__ unsigned f2bf(float f) { unsigned u = __builtin_bit_cast(unsigned, f); return (u + 0x7fffu + ((u >> 16) & 1u)) >> 16; }
__device__ __forceinline__ unsigned pk2(float lo, float hi) { f32x2 v = {lo, hi}; bf16x2_t b = __builtin_convertvector(v, bf16x2_t); return __builtin_bit_cast(unsigned, b); }
__device__ __forceinline__ float bflo(unsigned u) { return __builtin_bit_cast(float, u << 16); }
__device__ __forceinline__ float bfhi(unsigned u) { return __builtin_bit_cast(float, u & 0xffff0000u); }
__device__ __forceinline__ float bf2f(bf16 h) { return __builtin_bit_cast(float, (unsigned)h << 16); }
__device__ __forceinline__ u32x4 pack8(const float* v) { u32x4 w; w.x = pk2(v[0], v[1]); w.y = pk2(v[2], v[3]); w.z = pk2(v[4], v[5]); w.w = pk2(v[6], v[7]); return w; }
__device__ __forceinline__ float wave_sum(float v) {
#pragma unroll
    for (int o = 1; o < 64; o <<= 1) v += __shfl_xor(v, o);
    return v;
}
__device__ __forceinline__ float wave_max(float v) {
#pragma unroll
    for (int o = 1; o < 64; o <<= 1) v = fmaxf(v, __shfl_xor(v, o));
    return v;
}
__device__ __forceinline__ void swap32(float& a, float& b) { asm volatile("s_nop 1\n\tv_permlane32_swap_b32 %0, %1\n\ts_nop 1" : "+v"(a), "+v"(b)); }
__device__ __forceinline__ float xor32_sum(float x) { float a = x, b = x; swap32(a, b); return a + b; }
__device__ __forceinline__ float xor32_max(float x) { float a = x, b = x; swap32(a, b); return fmaxf(a, b); }
__device__ __forceinline__ float sigmoidf_(float x) { return __builtin_amdgcn_rcpf(1.f + __builtin_amdgcn_exp2f(-1.4426950408889634f * x)); }
__device__ __forceinline__ float siluf_(float x) { return x * __builtin_amdgcn_rcpf(1.f + __builtin_amdgcn_exp2f(-1.4426950408889634f * x)); }
__device__ __forceinline__ float gelu_tanh(float x) { const float u = 0.7978845608028654f * (x + 0.044715f * x * x * x); const float e = __expf(2.f * u); const float t = 1.f - 2.f / (e + 1.f); return 0.5f * x * (1.f + t); }
__device__ __forceinline__ int crow(int r, int hi) { return (r & 3) + 8 * (r >> 2) + 4 * hi; }
#define LDS_WAIT() asm volatile("s_waitcnt lgkmcnt(0)" ::: "memory")
#define MFMA32(a, b, c) __builtin_amdgcn_mfma_f32_32x32x16_bf16((a), (b), (c), 0, 0, 0)
typedef short v4i16_t __attribute__((ext_vector_type(4)));
__device__ __forceinline__ s16x4 ds_tr(LAS const unsigned char* p) { return __builtin_bit_cast(s16x4, __builtin_amdgcn_ds_read_tr16_b64_v4i16((LAS v4i16_t*)p)); }
__device__ __forceinline__ bf16x8 cat8(s16x4 a, s16x4 b) { return (bf16x8){a[0], a[1], a[2], a[3], b[0], b[1], b[2], b[3]}; }
__device__ __forceinline__ bf16x8 pack_frag(const f32x16& p, int base) {
    u32x4 w; w.x = pk2(p[base + 0], p[base + 1]); w.y = pk2(p[base + 2], p[base + 3]); w.z = pk2(p[base + 4], p[base + 5]); w.w = pk2(p[base + 6], p[base + 7]);
    return __builtin_bit_cast(bf16x8, w);
}
__device__ __forceinline__ float log2g(int h) { return h == 0 ? -0.04580368961312479f : h == 1 ? -0.02272007650008353f : h == 2 ? -0.011315313227834146f : -0.005646563141142063f; }

__device__ __forceinline__ void sincos_d(double a, double& s, double& c) {
    const double q = __builtin_rint(a * 0.63661977236758134308);
    double y = __builtin_fma(-q, 1.57079632679489655800e+00, a); y = __builtin_fma(-q, 6.12323399573676603587e-17, y);
    const int quad = ((int)q) & 3; const double y2 = y * y;
    double sp = -1.0 / 1307674368000.0; sp = sp * y2 + 1.0 / 6227020800.0; sp = sp * y2 - 1.0 / 39916800.0; sp = sp * y2 + 1.0 / 362880.0; sp = sp * y2 - 1.0 / 5040.0; sp = sp * y2 + 1.0 / 120.0; sp = sp * y2 - 1.0 / 6.0; sp = sp * y2 + 1.0; sp *= y;
    double cp = 1.0 / 20922789888000.0; cp = cp * y2 - 1.0 / 87178291200.0; cp = cp * y2 + 1.0 / 479001600.0; cp = cp * y2 - 1.0 / 3628800.0; cp = cp * y2 + 1.0 / 40320.0; cp = cp * y2 - 1.0 / 720.0; cp = cp * y2 + 1.0 / 24.0; cp = cp * y2 - 0.5; cp = cp * y2 + 1.0;
    s = (quad == 0) ? sp : (quad == 1) ? cp : (quad == 2) ? -sp : -cp;
    c = (quad == 0) ? cp : (quad == 1) ? -sp : (quad == 2) ? -cp : sp;
}
__device__ __forceinline__ double ipow_d(double r, int n) { double acc = 1.0;
#pragma unroll
    for (int b = 0; b < 6; ++b) { if (n & (1 << b)) acc *= r; r *= r; } return acc; }

__device__ __forceinline__ int orig_base32(int g32) {
    const int tile = g32 >> 3, gi = g32 & 7, bj = gi >> 2, wq = gi & 3;
    if (tile < 2)  return (2 * tile + (wq >> 1)) * 128 + (wq & 1) * 32 + 64 * bj;
    if (tile < 4)  return 512 + (2 * (tile - 2) + (wq >> 1)) * 128 + (wq & 1) * 32 + 64 * bj;
    if (tile < 6)  return 1024 + (tile - 4) * 256 + gi * 32;
    if (tile < 8)  return 1536 + (tile - 6) * 256 + gi * 32;
    if (tile < 10) return 2048 + (4 * (tile - 8) + wq) * 64 + 32 * bj;
    if (tile == 10) return 2560 + gi * 32;
    if (tile == 11) return ((wq >> 1) ? 3072 : 2816) + (wq & 1) * 64 + 32 * bj;
    if (tile == 12) return (bj ? 3200 : 2944) + wq * 32;
    return 3352 + (tile - 13) * 256 + gi * 32;
}
#define XB_TMO      128
#define XB_XCNT(j)  (256  + 64 * (j))
#define XB_XSUB(j)  (1280 + 64 * (j))
#define XB_XGEN(j)  (2304 + 64 * (j))
#define XB_TOP      3328
#define XB_TOPGEN   3392
#define XCD_BAR_WORDS 3456
#define XB_SPIN_CAP (1u << 18)
#define LAS __attribute__((address_space(3)))

__device__ __forceinline__ unsigned xb_ld(unsigned* p)              { return __hip_atomic_load(p, __ATOMIC_RELAXED, __HIP_MEMORY_SCOPE_AGENT); }
__device__ __forceinline__ unsigned xb_add(unsigned* p, unsigned v) { return __hip_atomic_fetch_add(p, v, __ATOMIC_RELAXED, __HIP_MEMORY_SCOPE_AGENT); }
__device__ __forceinline__ unsigned xb_xcc_id() { return (unsigned)__builtin_amdgcn_s_getreg((3 << 11) | 20) & 0xFu; }
#define XB_SPIN(cond, bar) do { unsigned _sp = 0; while (cond) { __builtin_amdgcn_s_sleep(1); \
    if ((++_sp & 255u) == 0u) { if (xb_ld(&(bar)[XB_TMO])) break; if (_sp > XB_SPIN_CAP) { atomicAdd(&(bar)[XB_TMO], 1u); break; } } } } while (0)

struct XcdBarrier {
    unsigned* bar; unsigned x;
    volatile LAS unsigned* st;
};

__device__ __forceinline__ XcdBarrier xcd_barrier_post(unsigned* bar, volatile LAS unsigned* st) {
    XcdBarrier b; b.bar = bar; b.x = xb_xcc_id(); b.st = st;
    if (threadIdx.x == 0) (void)xb_add(&bar[XB_XCNT(b.x)], 1u);
    return b;
}
__device__ __forceinline__ void xcd_barrier_complete(unsigned* bar, unsigned x, unsigned& nloc, unsigned& nx) {
    const unsigned G = gridDim.x * gridDim.y * gridDim.z;
    unsigned sum, cnt, mine, sp = 0u;
    for (;;) {
        sum = 0u; cnt = 0u; mine = 0u;
#pragma unroll
        for (unsigned j = 0; j < 16; ++j) { const unsigned c = xb_ld(&bar[XB_XCNT(j)]); sum += c; cnt += (c > 0u) ? 1u : 0u; mine = (j == x) ? c : mine; }
        if (sum == G) break;
        __builtin_amdgcn_s_sleep(1);
        if ((++sp & 255u) == 0u) { if (xb_ld(&bar[XB_TMO])) break; if (sp > XB_SPIN_CAP) { atomicAdd(&bar[XB_TMO], 1u); break; } }
    }
    nloc = mine > 0u ? mine : 1u; nx = cnt > 0u ? cnt : 1u;
}

__device__ __forceinline__ void xcd_barrier(const XcdBarrier& b) {
    asm volatile("s_waitcnt vmcnt(0)" ::: "memory");
    __syncthreads();
    if (threadIdx.x == 0) {
        unsigned* bar = b.bar;
        __builtin_amdgcn_s_waitcnt(0);
        unsigned nloc = b.st[0], nx = b.st[1];
        if (nloc == 0u) { xcd_barrier_complete(bar, b.x, nloc, nx); b.st[0] = nloc; b.st[1] = nx; }
        const unsigned old = xb_add(&bar[XB_XSUB(b.x)], 1u);
        const unsigned gen = old / nloc;
        if (old + 1u == (gen + 1u) * nloc) {
            __builtin_amdgcn_fence(__ATOMIC_RELEASE, "agent");
            asm volatile("s_waitcnt vmcnt(0)" ::: "memory");
            const unsigned og = xb_add(&bar[XB_TOP], 1u);
            const unsigned tg = og / nx;
            if (og + 1u == (tg + 1u) * nx) xb_add(&bar[XB_TOPGEN], 1u);
            else XB_SPIN(xb_ld(&bar[XB_TOPGEN]) == tg, bar);
            __builtin_amdgcn_fence(__ATOMIC_ACQUIRE, "agent");
            xb_add(&bar[XB_XGEN(b.x)], 1u);
            asm volatile("s_waitcnt vmcnt(0)" ::: "memory");
        } else {
            XB_SPIN(xb_ld(&bar[XB_XGEN(b.x)]) == gen, bar);
            __builtin_amdgcn_fence(__ATOMIC_ACQUIRE, "agent");
            asm volatile("s_waitcnt vmcnt(0)" ::: "memory");
        }
    }
    __syncthreads();
}

template <bool FRAG = false>
__device__ __forceinline__ void transpose_item(const float* W, int ldw, int k0, int n0, int nvalid, const float* kscale, bf16* WT, int ldt, int drow0, LAS float* scr, int lane) {
    float tv[32];
#pragma unroll
    for (int i = 0; i < 32; ++i) { const int kk = 2 * i + (lane >> 5), c = lane & 31; tv[i] = W[(size_t)(k0 + kk) * ldw + n0 + ((c < nvalid) ? c : 0)]; }
#pragma unroll
    for (int i = 0; i < 32; ++i) { const int kk = 2 * i + (lane >> 5), c = lane & 31; float v = (c < nvalid) ? tv[i] : 0.f; if (kscale) v *= kscale[k0 + kk]; scr[kk * 33 + c] = v; }
    LDS_WAIT(); asm volatile("" ::: "memory");
    const int c8 = lane & 7;
#pragma unroll
    for (int j = 0; j < 4; ++j) { const int n = (lane >> 3) + 8 * j; const LAS float* s = scr + (8 * c8) * 33 + n;
        u32x4 o; o.x = pk2(s[0 * 33], s[1 * 33]); o.y = pk2(s[2 * 33], s[3 * 33]); o.z = pk2(s[4 * 33], s[5 * 33]); o.w = pk2(s[6 * 33], s[7 * 33]);
        if (FRAG) { const int e = drow0 + n, k8 = (k0 >> 3) + c8;
            *(u32x4*)(WT + (size_t)((((k8 >> 4) * 2 + (e >> 5)) * 8 + ((k8 >> 1) & 7)) * 64 + (e & 31) + 32 * (k8 & 1)) * 8) = o; }
        else *(u32x4*)(WT + (size_t)(drow0 + n) * ldt + k0 + 8 * c8) = o; }
    LDS_WAIT(); asm volatile("" ::: "memory");
}

__device__ __forceinline__ void phase0(const Args& A, LAS unsigned char* lds, int tid, int lane, int wave) {
    unsigned char* ws = A.ws;
    const int gw = blockIdx.x * 8 + wave, NGW = gridDim.x * 8;
    const int gt = blockIdx.x * 512 + tid, NGT = gridDim.x * 512;
    LAS float* scr = (LAS float*)(lds + wave * 16384);
    constexpr int I_IN = 16 * 120, I_NGL = 16, I_OUT = 16 * 32, I_G = 16 * 32, I_PLE = 4 * 32, I_W1 = 4 * 64, I_W2 = 4 * 2;
    constexpr int NITEMS = I_IN + I_NGL + I_OUT + I_G + I_PLE + I_W1 + I_W2;
    for (int it = gw; it < NITEMS; it += NGW) {
        int r = it;
        if (r < I_IN) { const int kb = r / 120, g32 = r % 120; transpose_item((const float*)A.in[I_WIN], PROJW, 64 * kb, orig_base32(g32), 32, nullptr, (bf16*)(ws + WS_WINT), 1024, 32 * g32, scr, lane); continue; } r -= I_IN;
        if (r < I_NGL) { transpose_item((const float*)A.in[I_WIN], PROJW, 64 * r, 3328, 24, nullptr, (bf16*)(ws + WS_WNGLT), 1024, 0, scr, lane); continue; } r -= I_NGL;
        if (r < I_OUT) { const int kb = r / 32, nb = r % 32; transpose_item((const float*)A.in[I_WOUT], 1024, 64 * kb, 32 * nb, 32, nullptr, (bf16*)(ws + WS_WOUTT), 1024, 32 * nb, scr, lane); continue; } r -= I_OUT;
        if (r < I_G) { const int kb = r / 32, nb = r % 32; transpose_item((const float*)A.in[I_WG], 1024, 64 * kb, 32 * nb, 32, (const float*)A.in[I_NPLE], (bf16*)(ws + WS_WGT), 1024, 32 * nb, scr, lane); continue; } r -= I_G;
        if (r < I_PLE) { const int kb = r / 32, nb = r % 32; transpose_item((const float*)A.in[I_WPLE], 1024, 64 * kb, 32 * nb, 32, nullptr, (bf16*)(ws + WS_WPLET), 256, 32 * nb, scr, lane); continue; } r -= I_PLE;
        if (r < I_W1) { const int m = r >> 6, q = r & 63, kb = q >> 1, nb = q & 1;
            const float* W = (const float*)A.in[(m >> 1) ? I_W1V : I_W1K] + (size_t)(m & 1) * 2048 * 64;
            transpose_item<true>(W, 64, 64 * kb, 32 * nb, 32, nullptr, (bf16*)(ws + WS_W1T) + (size_t)m * 64 * 2048, 2048, 32 * nb, scr, lane); continue; } r -= I_W1;
        { const int m = r >> 1, nb = r & 1;
            const float* W = (const float*)A.in[(m >> 1) ? I_W2V : I_W2K] + (size_t)(m & 1) * 64 * 64;
            transpose_item(W, 64, 0, 32 * nb, 32, nullptr, (bf16*)(ws + WS_W2T) + (size_t)m * 64 * 64, 64, 32 * nb, scr, lane); }
    }
    {
        const f32x4* gm = (const f32x4*)A.in[I_NMIX];
        f32x4 g[4];
#pragma unroll
        for (int j = 0; j < 4; ++j) g[j] = gm[64 * j + lane];
        for (int m0 = gw; m0 < NTOK; m0 += 4 * NGW) {
            f32x4 v[4][4];
#pragma unroll
            for (int r = 0; r < 4; ++r) { const int mm = m0 + r * NGW, m = (mm < NTOK) ? mm : m0;
                const float* xrow = (m < NP) ? (const float*)A.in[I_XP] + (size_t)m * DM : (const float*)A.in[I_XS] + (size_t)(m - NP) * DM;
                const f32x4* xr = (const f32x4*)xrow + lane;
#pragma unroll
                for (int j = 0; j < 4; ++j) v[r][j] = xr[64 * j]; }
#pragma unroll
            for (int r = 0; r < 4; ++r) { const int m = m0 + r * NGW;
                float s = 0.f;
#pragma unroll
                for (int j = 0; j < 4; ++j) s += (v[r][j].x * v[r][j].x + v[r][j].y * v[r][j].y) + (v[r][j].z * v[r][j].z + v[r][j].w * v[r][j].w);
                const float rstd = 1.f / sqrtf(wave_sum(s) * (1.f / DM) + RMS_EPS);
                if (m < NTOK) {
                    u32x2* o8 = (u32x2*)((bf16*)(ws + WS_H) + (size_t)m * DM) + lane;
#pragma unroll
                    for (int j = 0; j < 4; ++j) { u32x2 o; o.x = pk2(v[r][j].x * rstd * g[j].x, v[r][j].y * rstd * g[j].y); o.y = pk2(v[r][j].z * rstd * g[j].z, v[r][j].w * rstd * g[j].w); o8[64 * j] = o; }
                } }
        }
    }
    for (int i0 = gt; i0 < NTOK * 64; i0 += 8 * NGT) {
        f32x4 v[8];
#pragma unroll
        for (int u = 0; u < 8; ++u) { const int ii = i0 + u * NGT, i = (ii < NTOK * 64) ? ii : i0; const int row = i >> 6, c4 = i & 63;
            v[u] = (row < NP) ? ((const f32x4*)A.in[I_PP])[(size_t)row * 64 + c4] : ((const f32x4*)A.in[I_PS])[(size_t)(row - NP) * 64 + c4]; }
#pragma unroll
        for (int u = 0; u < 8; ++u) { const int i = i0 + u * NGT;
            if (i < NTOK * 64) { u32x2 o; o.x = pk2(v[u].x, v[u].y); o.y = pk2(v[u].z, v[u].w); ((u32x2*)(ws + WS_PB))[i] = o; } }
    }
    for (int i = gt; i < NPOS * 96; i += NGT) {
        const int pi = i / 96, k = i % 96;
        const double pos = (pi < SEQ) ? (double)pi : (double)(PAST + pi - SEQ);
        double s, c;
        if (k < 64) { sincos_d(pos * ipow_d(0.86596432336006535235, k), s, c); ((float*)(ws + WS_COSR))[pi * 64 + k] = (float)c; ((float*)(ws + WS_SINR))[pi * 64 + k] = (float)s; }
        else { const int kk = k - 64; sincos_d(pos * ipow_d(0.74989420933245582730, kk), s, c); ((float*)(ws + WS_COSN))[pi * 32 + kk] = (float)c; ((float*)(ws + WS_SINN))[pi * 32 + kk] = (float)s; }
    }
    for (int it = blockIdx.x; it < 4 * 32; it += gridDim.x) {
        const int m = it >> 5, part = it & 31, kv = m >> 1, kvh = m & 1;
        const float* pe = (const float*)A.in[kv ? I_PEV : I_PEK];
        const float* w1 = (const float*)A.in[kv ? I_W1V : I_W1K] + (size_t)kvh * 2048 * 64;
        float pv[8], wv8[8];
#pragma unroll
        for (int q = 0; q < 8; ++q) { const int jd = part * 64 + 8 * wave + q, j = jd >> 6, d = jd & 63; pv[q] = pe[(j * 2 + kvh) * 64 + d]; wv8[q] = w1[(size_t)jd * 64 + lane]; }
        float acc = 0.f;
#pragma unroll
        for (int q = 0; q < 8; ++q) acc += pv[q] * wv8[q];
        LAS float* cb = (LAS float*)lds;
        __syncthreads();
        cb[wave * 64 + lane] = acc;
        __syncthreads();
        if (wave == 0) { float t = 0.f;
#pragma unroll
            for (int w = 0; w < 8; ++w) t += cb[w * 64 + lane];
            ((float*)(ws + WS_CBIAS))[(m * 32 + part) * 64 + lane] = t; }
    }
    for (int i0 = gt; i0 < 2 * 32 * 504 * 32; i0 += 8 * NGT) {
        f32x4 v[8];
#pragma unroll
        for (int u = 0; u < 8; ++u) { const int ii = i0 + u * NGT, i = (ii < 2 * 32 * 504 * 32) ? ii : i0;
            const int kv = i / (32 * 504 * 32), r = i % (32 * 504 * 32), b = r / (504 * 32), q = r % (504 * 32);
            v[u] = ((const f32x4*)A.in[kv ? I_SWV : I_SWK])[(size_t)b * 512 * 32 + 8 * 32 + q]; }
#pragma unroll
        for (int u = 0; u < 8; ++u) { const int i = i0 + u * NGT;
            if (i < 2 * 32 * 504 * 32) { const int kv = i / (32 * 504 * 32), r = i % (32 * 504 * 32), b = r / (504 * 32), q = r % (504 * 32);
                ((f32x4*)(A.out + (kv ? O_WINV_S : O_WINK_S)))[(size_t)b * 512 * 32 + q] = v[u]; } }
    }
}

struct EpiInProj {
    static constexpr bool PERM = true, AFTER_DRAIN = false;
    unsigned char* ws; float* out;
    __device__ __forceinline__ void operator()(const pg8::f32x4 (&acc)[2][2][4][2], const pg8::Unit& u, int wr, int wc, int fr, int fq) const {
        const int pn = u.pn;
        asm volatile("" : "+v"(fr), "+v"(fq));
        const int lc = wc * 32 + 8 * fq;
        const bool rope = pn < 4 || pn == 8 || pn == 9 || pn == 11;
        f32x4 tb[2][4];
        auto ldtab = [&](int ai_, int m_, f32x4 (&t)[4]) {
            const int row_ = u.pm * 256 + ai_ * 128 + wr * 64 + m_ * 16 + fr;
            const int pidx_ = (row_ >= NP) ? (SEQ + ((row_ - NP) & 7)) : (row_ & (SEQ - 1));
            const bool big = pn < 4; const int nd = big ? 64 : 32, dl = big ? ((wc & 1) * 32 + 8 * fq) : 8 * fq;
            const float* ct = (const float*)(ws + (big ? WS_COSR : WS_COSN)) + pidx_ * nd + dl; const float* st = (const float*)(ws + (big ? WS_SINR : WS_SINN)) + pidx_ * nd + dl;
            t[0] = *(const f32x4*)ct; t[1] = *(const f32x4*)(ct + 4); t[2] = *(const f32x4*)st; t[3] = *(const f32x4*)(st + 4); };
        if (rope) ldtab(0, 0, tb[0]);
#pragma unroll
        for (int ai = 0; ai < 2; ++ai)
#pragma unroll
            for (int m = 0; m < 4; ++m) {
                const int row = u.pm * 256 + ai * 128 + wr * 64 + m * 16 + fr;
                const bool dec = row >= NP;
                const int pidx = dec ? (SEQ + ((row - NP) & 7)) : (row & (SEQ - 1));
                float cc[8], ss[8];
                if (rope) {
                    const int idx = ai * 4 + m;
                    if (idx + 1 < 8) ldtab((idx + 1) >> 2, (idx + 1) & 3, tb[(idx + 1) & 1]);
#pragma unroll
                    for (int e = 0; e < 8; ++e) { cc[e] = e < 4 ? tb[idx & 1][0][e & 3] : tb[idx & 1][1][e & 3]; ss[e] = e < 4 ? tb[idx & 1][2][e & 3] : tb[idx & 1][3][e & 3]; }
                }
                float v0[8], v1[8];
#pragma unroll
                for (int e = 0; e < 4; ++e) { v0[e] = acc[ai][0][m][0][e]; v0[4 + e] = acc[ai][0][m][1][e]; v1[e] = acc[ai][1][m][0][e]; v1[4 + e] = acc[ai][1][m][1][e]; }
                if (pn < 4) {
                    const int t2 = pn & 1, head = 2 * t2 + (wc >> 1), dlo = (wc & 1) * 32 + 8 * fq;
                    const float sc = (pn >= 2) ? 0.08838834764831845f : 1.f;
                    float o0[8], o1[8];
#pragma unroll
                    for (int e = 0; e < 8; ++e) { const float c = cc[e], s = ss[e]; o0[e] = (v0[e] * c - v1[e] * s) * sc; o1[e] = (v1[e] * c + v0[e] * s) * sc; }
                    bf16* dst = (bf16*)(ws + (pn >= 2 ? WS_KR : WS_QR));
                    *(u32x4*)(dst + CM(head * 128 + dlo, row)) = pack8(o0); *(u32x4*)(dst + CM(head * 128 + 64 + dlo, row)) = pack8(o1);
                } else if (pn < 8) {
                    const int cb = ((pn - 4) & 1) * 256 + lc;
                    if (pn >= 6) {
#pragma unroll
                        for (int e = 0; e < 8; ++e) { v0[e] = siluf_(v0[e]); v1[e] = siluf_(v1[e]); } }
                    bf16* dst = (bf16*)(ws + (pn >= 6 ? WS_RG : WS_VR));
                    *(u32x4*)(dst + CM(cb, row)) = pack8(v0); *(u32x4*)(dst + CM(cb + 128, row)) = pack8(v1);
                } else if (pn < 10) {
                    const int head = 4 * (pn - 8) + wc, dlo = 8 * fq;
                    float o0[8], o1[8], r0[8], r1[8];
#pragma unroll
                    for (int e = 0; e < 8; ++e) { const float c = cc[e], s = ss[e]; o0[e] = (v0[e] * c - v1[e] * s) * C2; o1[e] = (v1[e] * c + v0[e] * s) * C2; r0[e] = v0[e] * C2; r1[e] = v1[e] * C2; }
                    bf16* dq = (bf16*)(ws + WS_QN); bf16* dr = (bf16*)(ws + WS_QROT); const size_t c0_ = CM(head * 64 + dlo, row), c1_ = CM(head * 64 + 32 + dlo, row);
                    *(u32x4*)(dq + c0_) = pack8(r0); *(u32x4*)(dq + c1_) = pack8(r1); *(u32x4*)(dr + c0_) = pack8(o0); *(u32x4*)(dr + c1_) = pack8(o1);
                } else if (pn == 10) {
                    float* dk = out + (dec ? O_CMPK_S + (size_t)(row - NP) * 128 : O_CMPK_P + (size_t)row * 128) + lc;
                    float* dv = out + (dec ? O_CMPV_S + (size_t)(row - NP) * 128 : O_CMPV_P + (size_t)row * 128) + lc;
                    *(f32x4*)dk = (f32x4){v0[0], v0[1], v0[2], v0[3]}; *(f32x4*)(dk + 4) = (f32x4){v0[4], v0[5], v0[6], v0[7]};
                    *(f32x4*)dv = (f32x4){v1[0], v1[1], v1[2], v1[3]}; *(f32x4*)(dv + 4) = (f32x4){v1[4], v1[5], v1[6], v1[7]};
                } else if (pn == 11) {
                    const int which = wc >> 1, kvh = wc & 1, dlo = 8 * fq, col = kvh * 64 + dlo;
                    float o0[8], o1[8];
#pragma unroll
                    for (int e = 0; e < 8; ++e) { const float c = cc[e], s = ss[e]; o0[e] = v0[e] * c - v1[e] * s; o1[e] = v1[e] * c + v0[e] * s; }
                    bf16* db = (bf16*)(ws + (which ? WS_KW : WS_KS));
                    *(u32x4*)(db + CM(col, row)) = pack8(o0); *(u32x4*)(db + CM(col + 32, row)) = pack8(o1);
                    float* df = nullptr;
                    if (which == 0) df = out + (dec ? O_SLCK_S + (size_t)(row - NP) * 128 : O_SLCK_P + (size_t)row * 128) + col;
                    else if (dec) { const int b = (row - NP) >> 3, tt = (row - NP) & 7; df = out + O_WINK_S + ((size_t)b * 512 + 504 + tt) * 128 + col; }
                    else { const int b = row >> 12, t = row & 4095; if (t >= SEQ - 512) df = out + O_WINK_P + ((size_t)b * 512 + (t - (SEQ - 512))) * 128 + col; }
                    if (df) { *(f32x4*)df = (f32x4){o0[0], o0[1], o0[2], o0[3]}; *(f32x4*)(df + 4) = (f32x4){o0[4], o0[5], o0[6], o0[7]};
                              *(f32x4*)(df + 32) = (f32x4){o1[0], o1[1], o1[2], o1[3]}; *(f32x4*)(df + 36) = (f32x4){o1[4], o1[5], o1[6], o1[7]}; }
                } else if (pn == 12) {
                    *(u32x4*)((bf16*)(ws + WS_VS) + CM(lc, row)) = pack8(v0); *(u32x4*)((bf16*)(ws + WS_VW) + CM(lc, row)) = pack8(v1);
                    float* fs = out + (dec ? O_SLCV_S + (size_t)(row - NP) * 128 : O_SLCV_P + (size_t)row * 128) + lc;
                    *(f32x4*)fs = (f32x4){v0[0], v0[1], v0[2], v0[3]}; *(f32x4*)(fs + 4) = (f32x4){v0[4], v0[5], v0[6], v0[7]};
                    float* fw = nullptr;
                    if (dec) { const int b = (row - NP) >> 3, tt = (row - NP) & 7; fw = out + O_WINV_S + ((size_t)b * 512 + 504 + tt) * 128 + lc; }
                    else { const int b = row >> 12, t = row & 4095; if (t >= SEQ - 512) fw = out + O_WINV_P + ((size_t)b * 512 + (t - (SEQ - 512))) * 128 + lc; }
                    if (fw) { *(f32x4*)fw = (f32x4){v1[0], v1[1], v1[2], v1[3]}; *(f32x4*)(fw + 4) = (f32x4){v1[4], v1[5], v1[6], v1[7]}; }
                } else {
                    const int cb = (pn - 13) * 256 + lc;
#pragma unroll
                    for (int e = 0; e < 8; ++e) { v0[e] = siluf_(v0[e]); v1[e] = siluf_(v1[e]); }
                    bf16* dst = (bf16*)(ws + WS_NG);
                    *(u32x4*)(dst + CM(cb, row)) = pack8(v0); *(u32x4*)(dst + CM(cb + 128, row)) = pack8(v1);
                }
            }
    }
};

__device__ __forceinline__ void ngl_unit(unsigned char* ws, int unit, int lane, int wave) {
    const int row0 = unit * 128 + wave * 16, fr = lane & 15, fq = lane >> 4;
    const bf16* a = (const bf16*)(ws + WS_H) + (size_t)(row0 + fr) * DM + 8 * fq;
    const bf16* b0 = (const bf16*)(ws + WS_WNGLT) + (size_t)fr * DM + 8 * fq;
    const bf16* b1 = b0 + 16 * DM;
    f32x4 c0 = {0.f, 0.f, 0.f, 0.f}, c1 = {0.f, 0.f, 0.f, 0.f};
#pragma unroll 8
    for (int s = 0; s < 32; ++s) {
        const bf16x8 av = *(const bf16x8*)(a + 32 * s), bv0 = *(const bf16x8*)(b0 + 32 * s), bv1 = *(const bf16x8*)(b1 + 32 * s);
        c0 = __builtin_amdgcn_mfma_f32_16x16x32_bf16(av, bv0, c0, 0, 0, 0);
        c1 = __builtin_amdgcn_mfma_f32_16x16x32_bf16(av, bv1, c1, 0, 0, 0);
    }
    float* gl = (float*)(ws + WS_GL);
#pragma unroll
    for (int i = 0; i < 4; ++i) { const int r = row0 + 4 * fq + i; gl[(size_t)r * 32 + fr] = sigmoidf_(c0[i]); gl[(size_t)r * 32 + 16 + fr] = sigmoidf_(c1[i]); }
}

template <bool DEC>
__device__ __forceinline__ void compress_unit(const Args& A, LAS unsigned char* lds, int unit, int tid, int lane, int wave) {
    unsigned char* ws = A.ws;
    asm volatile("" : "+v"(tid), "+v"(lane));
    const int kv = DEC ? (unit >> 8) : (unit >> 3), b = DEC ? ((unit >> 3) & 31) : ((unit >> 1) & 3), part = DEC ? (unit & 7) : (unit & 1);
    const int r32 = lane & 31, hi = lane >> 5, kvh = wave >> 2, bt = (wave >> 1) & 1, et = wave & 1, m = kv * 2 + kvh;
    constexpr int AP = 528;
    LAS unsigned char* bufA = lds;
    LAS float* biasL = (LAS float*)(lds + 2 * 64 * AP);
    LAS float* xch = (LAS float*)(lds + 2 * 64 * AP + 512);
    __syncthreads();
    unsigned offs[8];
    const float* src;
    if (DEC) { src = (const float*)A.in[kv ? I_CCV : I_CCK]; const int* pt = (const int*)A.in[I_PT] + b * 128 + part * 16;
#pragma unroll
        for (int i = 0; i < 8; ++i) { const int blk = (tid >> 6) + 8 * i; offs[i] = ((unsigned)pt[blk >> 2] * 128u + (unsigned)(blk & 3) * 32u) * 128u + 4u * (tid & 63); } }
    else { src = A.out + (kv ? O_CMPV_P : O_CMPK_P) + (size_t)b * SEQ * 128 + (size_t)part * 64 * 32 * 128;
#pragma unroll
        for (int i = 0; i < 8; ++i) { const int blk = (tid >> 6) + 8 * i; offs[i] = (unsigned)(blk * 32) * 128u + 4u * (tid & 63); } }
#define GLD16(dst, ptr) asm volatile("global_load_dwordx4 %0, %1, off" : "=v"(dst) : "v"(ptr) : "memory")
#define GLD16NT(dst, ptr) asm volatile("global_load_dwordx4 %0, %1, off nt" : "=v"(dst) : "v"(ptr) : "memory")
#define WAIT8(N, a) asm volatile("s_waitcnt vmcnt(" #N ")" : "+v"(a[0]), "+v"(a[1]), "+v"(a[2]), "+v"(a[3]), "+v"(a[4]), "+v"(a[5]), "+v"(a[6]), "+v"(a[7]) :: "memory")
    const unsigned rot = DEC ? (unsigned)(unit & 15) : 0u;
    f32x4 preA[8], preB[8];
    bf16x8 wA[8], wB[8];
    f32x16 acc = f32x16{};
    const bf16* w1t = (const bf16*)(ws + WS_W1T) + (size_t)m * 64 * 2048 + (size_t)(et * 512 + lane) * 8;
#define LD_ROWS(PRE, S) do { const unsigned s2_ = ((((S) < 16) ? (unsigned)(S) : 15u) + rot) & 15u; _Pragma("unroll") for (int i = 0; i < 8; ++i) { const float* p_ = src + offs[i] + s2_ * 256u; if (DEC) GLD16NT(PRE[i], p_); else GLD16(PRE[i], p_); } } while (0)
#define LD_W1(W, S) do { const int sn_ = (int)(((((S) < 16) ? (unsigned)(S) : 15u) + rot) & 15u); _Pragma("unroll") for (int q = 0; q < 8; ++q) { const bf16* p_ = w1t + sn_ * 8192 + 512 * q; GLD16(W[q], p_); } } while (0)
    LD_ROWS(preA, 0); LD_W1(wA, 0); LD_ROWS(preB, 1);
    if (tid < 128) { const int k2 = tid >> 6, e = tid & 63; const float* cb = (const float*)(ws + WS_CBIAS) + ((kv * 2 + k2) * 32) * 64 + e; float bp[32];
#pragma unroll
        for (int p = 0; p < 32; ++p) bp[p] = cb[p * 64];
        float s = 0.f;
#pragma unroll
        for (int p = 0; p < 32; ++p) s += bp[p];
        biasL[tid] = s; }
#define CMP_STEP(PRE, WC, WN, S) do { \
        LAS unsigned char* buf = bufA + ((S) & 1) * 64 * AP; \
        WAIT8(16, PRE); \
        _Pragma("unroll") for (int i = 0; i < 8; ++i) { const int blk = (tid >> 6) + 8 * i; u32x2 o; o.x = pk2(PRE[i].x, PRE[i].y); o.y = pk2(PRE[i].z, PRE[i].w); *(LAS u32x2*)(buf + blk * AP + (tid & 63) * 8) = o; } \
        LD_W1(WN, (S) + 1); LD_ROWS(PRE, (S) + 2); \
        __syncthreads(); \
        WAIT8(24, WC); \
        _Pragma("unroll") for (int q = 0; q < 8; ++q) { \
            const bf16x8 bf = *(LAS const bf16x8*)(buf + (32 * bt + r32) * AP + ((q >> 2) * 128 + kvh * 64 + 16 * (q & 3) + 8 * hi) * 2); \
            acc = MFMA32(WC[q], bf, acc); } } while (0)
#pragma unroll 1
    for (int s = 0; s < 16; s += 2) { CMP_STEP(preA, wA, wB, s); CMP_STEP(preB, wB, wA, s + 1); }
    asm volatile("s_waitcnt vmcnt(0)" ::: "memory");
#undef CMP_STEP
#undef LD_ROWS
#undef LD_W1
#undef GLD16
#undef GLD16NT
#undef WAIT8
#pragma unroll
    for (int r = 0; r < 16; ++r) acc[r] = gelu_tanh(acc[r] + biasL[kvh * 64 + 32 * et + crow(r, hi)]);
    const bf16* w2t = (const bf16*)(ws + WS_W2T) + (size_t)m * 64 * 64;
    f32x16 oacc[2]; oacc[0] = f32x16{}; oacc[1] = f32x16{};
#pragma unroll
    for (int s2 = 0; s2 < 2; ++s2) {
        const bf16x8 pb = pack_frag(acc, 8 * s2);
#pragma unroll
        for (int ft = 0; ft < 2; ++ft) {
            const bf16* wp = w2t + (32 * ft + r32) * 64 + 32 * et + 16 * s2 + 4 * hi;
            const s16x4 lo = *(const s16x4*)wp, hh = *(const s16x4*)(wp + 8);
            oacc[ft] = MFMA32(cat8(lo, hh), pb, oacc[ft]);
        }
    }
    LAS float* xp = xch + ((kvh * 2 + bt) * 32) * 64 + lane;
    if (et == 1) {
#pragma unroll
        for (int ft = 0; ft < 2; ++ft)
#pragma unroll
            for (int r = 0; r < 16; ++r) xp[(ft * 16 + r) * 64] = oacc[ft][r];
    }
    __syncthreads();
    if (et == 0) {
        const int blk = 32 * bt + r32;
#pragma unroll
        for (int ft = 0; ft < 2; ++ft)
#pragma unroll
            for (int q = 0; q < 4; ++q) {
                const int f = 32 * ft + 8 * q + 4 * hi;
                const float v0 = oacc[ft][4 * q] + xp[(ft * 16 + 4 * q) * 64], v1 = oacc[ft][4 * q + 1] + xp[(ft * 16 + 4 * q + 1) * 64];
                const float v2 = oacc[ft][4 * q + 2] + xp[(ft * 16 + 4 * q + 2) * 64], v3 = oacc[ft][4 * q + 3] + xp[(ft * 16 + 4 * q + 3) * 64];
                if (DEC) { float* d = (float*)(ws + (kv ? WS_VCS : WS_KCS)) + (((size_t)b * 512 + part * 64 + blk) * 2 + kvh) * 64 + f; *(f32x4*)d = (f32x4){v0, v1, v2, v3}; }
                else { bf16* d = (bf16*)(ws + (kv ? WS_VCP : WS_KCP)) + (((size_t)b * 128 + part * 64 + blk) * 2 + kvh) * 64 + f;
                    u32x2 o; o.x = pk2(v0, v1); o.y = pk2(v2, v3); *(u32x2*)d = o; }
            }
    }
}

__device__ __forceinline__ int tr_off(int lane, int pitch) { return ((lane & 15) >> 2) * pitch + (16 * ((lane >> 4) & 1) + 4 * (lane & 3)) * 2; }

__device__ __forceinline__ void ret_pass1_unit(unsigned char* ws, LAS unsigned char* lds, int unit, int tid, int lane, int wave) {
    const int bh = unit >> 5, c = unit & 31, b = bh >> 2, h = bh & 3;
    constexpr int TP = 320;
    LAS unsigned char* Kt = lds; LAS unsigned char* Vt = lds + 128 * TP;
    const size_t row0 = (size_t)b * SEQ + c * 128;
    const float lg = log2g(h);
    __syncthreads();
#pragma unroll
    for (int i = 0; i < 4; ++i) {
        const int row = tid & 127, ch = (tid >> 7) + 4 * i;
        const u32x4 kx = *(const u32x4*)((const bf16*)(ws + WS_KR) + CM(h * 128 + ch * 8, row0 + row));
        const u32x4 vx = *(const u32x4*)((const bf16*)(ws + WS_VR) + CM(h * 128 + ch * 8, row0 + row));
        const float dc = exp2f((float)(127 - row) * lg);
        u32x4 ko; ko.x = pk2(bflo(kx.x) * dc, bfhi(kx.x) * dc); ko.y = pk2(bflo(kx.y) * dc, bfhi(kx.y) * dc); ko.z = pk2(bflo(kx.z) * dc, bfhi(kx.z) * dc); ko.w = pk2(bflo(kx.w) * dc, bfhi(kx.w) * dc);
        *(LAS u32x4*)(Kt + row * TP + ch * 16) = ko; *(LAS u32x4*)(Vt + row * TP + ch * 16) = vx;
    }
    __syncthreads();
    const int r32 = lane & 31, hi = lane >> 5, dvb = wave & 3, dkh = wave >> 2, tro = tr_off(lane, TP);
    f32x16 acc[2]; acc[0] = f32x16{}; acc[1] = f32x16{};
#pragma unroll
    for (int s = 0; s < 8; ++s) {
        const int t0 = 16 * s + 8 * hi;
        const bf16x8 af = cat8(ds_tr(Vt + t0 * TP + 64 * dvb + tro), ds_tr(Vt + (t0 + 4) * TP + 64 * dvb + tro));
#pragma unroll
        for (int n = 0; n < 2; ++n) {
            const int cb = 64 * (2 * dkh + n);
            const bf16x8 bfr = cat8(ds_tr(Kt + t0 * TP + cb + tro), ds_tr(Kt + (t0 + 4) * TP + cb + tro));
            acc[n] = MFMA32(af, bfr, acc[n]);
        }
    }
    float* dst = (float*)(ws + WS_KVT) + (size_t)unit * 16384;
#pragma unroll
    for (int n = 0; n < 2; ++n)
#pragma unroll
        for (int r = 0; r < 16; ++r) dst[(32 * dvb + crow(r, hi)) * 128 + 32 * (2 * dkh + n) + r32] = acc[n][r];
}

__device__ __forceinline__ void ret_pass2(const Args& A, int tid) {
    unsigned char* ws = A.ws;
    for (int e = blockIdx.x * 512 + tid; e < 16 * 16384; e += gridDim.x * 512) {
        const int bh = e >> 14, q = e & 16383, dv = q >> 7, dk = q & 127;
        const float gC = exp2f(128.f * log2g(bh & 3));
        const float* kv = (const float*)(ws + WS_KVT) + (size_t)bh * 32 * 16384 + q;
        bf16* st = (bf16*)(ws + WS_ST) + (size_t)bh * 32 * 16384 + (size_t)(((((dv >> 6) * 2 + ((dv >> 5) & 1)) * 8 + (dk >> 4)) * 64 + (dv & 31) + 32 * ((dk >> 3) & 1)) * 8 + (dk & 7));
        float kvr[32];
#pragma unroll
        for (int c = 0; c < 32; ++c) kvr[c] = kv[(size_t)c * 16384];
        float S = 0.f;
#pragma unroll
        for (int c = 0; c < 32; ++c) { st[(size_t)c * 16384] = (bf16)f2bf(S); S = gC * S + kvr[c]; }
        A.out[O_RETP + (size_t)bh * 16384 + dk * 128 + dv] = S;
    }
}

__device__ __forceinline__ void ret_pass3_unit(const Args& A, LAS unsigned char* lds, int unit, int tid, int lane, int wave) {
    unsigned char* ws = A.ws;
    const int bh = unit >> 5, c = unit & 31, b = bh >> 2, h = bh & 3;
    constexpr int KP = 272, VP = 320;
    LAS unsigned char* Kt = lds; LAS unsigned char* Vt = lds + 128 * KP; LAS float* red = (LAS float*)(lds + 128 * KP + 128 * VP);
    const size_t row0 = (size_t)b * SEQ + c * 128;
    const float lg = log2g(h);
    __syncthreads();
#pragma unroll
    for (int i = 0; i < 4; ++i) {
        const int row = tid & 127, ch = (tid >> 7) + 4 * i;
        *(LAS u32x4*)(Kt + row * KP + ch * 16) = *(const u32x4*)((const bf16*)(ws + WS_KR) + CM(h * 128 + ch * 8, row0 + row));
        *(LAS u32x4*)(Vt + row * VP + ch * 16) = *(const u32x4*)((const bf16*)(ws + WS_VR) + CM(h * 128 + ch * 8, row0 + row));
    }
    const int r32 = lane & 31, hi = lane >> 5, ib = wave & 3, dh = wave >> 2, tro = tr_off(lane, VP);
    const int il = 32 * ib + r32;
    bf16x8 qf[8];
    { const bf16* qp = (const bf16*)(ws + WS_QR) + CM(h * 128 + 8 * hi, row0 + il);
#pragma unroll
      for (int s = 0; s < 8; ++s) qf[s] = *(const bf16x8*)(qp + (size_t)s * (2 * NTOK * 8)); }
    __syncthreads();
    f32x16 oacc[2]; oacc[0] = f32x16{}; oacc[1] = f32x16{};
    for (int jb = 0; jb <= ib; ++jb) {
        f32x16 sT = f32x16{};
#pragma unroll
        for (int s = 0; s < 8; ++s) { const bf16x8 kf = *(LAS const bf16x8*)(Kt + (32 * jb + r32) * KP + (16 * s + 8 * hi) * 2); sT = MFMA32(kf, qf[s], sT); }
#pragma unroll
        for (int r = 0; r < 16; ++r) { const int j = 32 * jb + crow(r, hi); const float d = __builtin_amdgcn_exp2f((float)(il - j) * lg); sT[r] = (j <= il) ? sT[r] * d : 0.f; }
#pragma unroll
        for (int s2 = 0; s2 < 2; ++s2) {
            const bf16x8 pb = pack_frag(sT, 8 * s2);
            const int j0 = 32 * jb + 16 * s2 + 4 * hi;
#pragma unroll
            for (int dvb = 0; dvb < 2; ++dvb) {
                const int cb = 64 * (2 * dh + dvb);
                const bf16x8 vf = cat8(ds_tr(Vt + j0 * VP + cb + tro), ds_tr(Vt + (j0 + 8) * VP + cb + tro));
                oacc[dvb] = MFMA32(vf, pb, oacc[dvb]);
            }
        }
    }
    f32x16 cacc[2]; cacc[0] = f32x16{}; cacc[1] = f32x16{};
    { const bf16* sp = (const bf16*)(ws + WS_ST) + (size_t)unit * 16384 + (size_t)(dh * 2 * 8 * 64 + lane) * 8;
#pragma unroll
      for (int s = 0; s < 8; ++s) {
          const bf16x8 a0 = *(const bf16x8*)(sp + s * 512), a1 = *(const bf16x8*)(sp + 8 * 512 + s * 512);
          cacc[0] = MFMA32(a0, qf[s], cacc[0]); cacc[1] = MFMA32(a1, qf[s], cacc[1]);
      } }
    const float qd = exp2f((float)(il + 1) * lg);
    float s1 = 0.f, s2 = 0.f;
#pragma unroll
    for (int dvb = 0; dvb < 2; ++dvb)
#pragma unroll
        for (int r = 0; r < 16; ++r) { const float o = oacc[dvb][r] + qd * cacc[dvb][r]; oacc[dvb][r] = o; s1 += o; s2 += o * o; }
    s1 = xor32_sum(s1); s2 = xor32_sum(s2);
    if (hi == 0) { red[(dh * 128 + il) * 2] = s1; red[(dh * 128 + il) * 2 + 1] = s2; }
    __syncthreads();
    const float t1 = red[il * 2] + red[(128 + il) * 2], t2 = red[il * 2 + 1] + red[(128 + il) * 2 + 1];
    const float mu = t1 * (1.f / 128.f), var = fmaxf(t2 * (1.f / 128.f) - mu * mu, 0.f), rstd = 1.f / sqrtf(var + GN_EPS);
    const float* gg = (const float*)A.in[I_GNG] + h * 128; const float* gb = (const float*)A.in[I_GNB] + h * 128;
    const bf16* rgp = (const bf16*)(ws + WS_RG);
    bf16* yp = (bf16*)(ws + WS_YMIX) + (row0 + il) * 1024 + h * 128;
    u32x2 rgv[2][4];
#pragma unroll
    for (int dvb = 0; dvb < 2; ++dvb)
#pragma unroll
        for (int q = 0; q < 4; ++q) rgv[dvb][q] = *(const u32x2*)(rgp + CM(h * 128 + 32 * (2 * dh + dvb) + 8 * q + 4 * hi, row0 + il));
#pragma unroll
    for (int dvb = 0; dvb < 2; ++dvb)
#pragma unroll
        for (int q = 0; q < 4; ++q) {
            const int dv = 32 * (2 * dh + dvb) + 8 * q + 4 * hi;
            const f32x4 g4 = *(const f32x4*)(gg + dv), b4 = *(const f32x4*)(gb + dv);
            const u32x2 rg = rgv[dvb][q];
            const float y0 = ((oacc[dvb][4 * q] - mu) * rstd * g4.x + b4.x) * bflo(rg.x), y1 = ((oacc[dvb][4 * q + 1] - mu) * rstd * g4.y + b4.y) * bfhi(rg.x);
            const float y2 = ((oacc[dvb][4 * q + 2] - mu) * rstd * g4.z + b4.z) * bflo(rg.y), y3 = ((oacc[dvb][4 * q + 3] - mu) * rstd * g4.w + b4.w) * bfhi(rg.y);
            u32x2 o; o.x = pk2(y0, y1); o.y = pk2(y2, y3); *(u32x2*)(yp + dv) = o;
        }
}

__device__ __forceinline__ void ret_decode_unit(const Args& A, LAS unsigned char* lds, int unit, int tid, int lane, int wave) {
    unsigned char* ws = A.ws;
    const int b = unit >> 2, h = unit & 3;
    LAS float* qL = (LAS float*)lds; LAS float* kL = qL + 1024; LAS float* vL = kL + 1024; LAS float* sL = vL + 1024;
    LAS float* red = sL + 64;
    const float lg = log2g(h);
    __syncthreads();
    { bf16 t6[6];
#pragma unroll
      for (int u = 0; u < 6; ++u) { const int i = tid + 512 * u, w = i >> 10, q = i & 1023, j = q >> 7, d = q & 127;
          t6[u] = *((const bf16*)(ws + (w == 0 ? WS_QR : w == 1 ? WS_KR : WS_VR)) + CM(h * 128 + d, NP + b * 8 + j)); }
#pragma unroll
      for (int u = 0; u < 6; ++u) qL[tid + 512 * u] = bf2f(t6[u]); }
    __syncthreads();
    {
        const int i = wave, j = lane & 7, sl = lane >> 3; float a = 0.f;
#pragma unroll
        for (int d = 0; d < 16; ++d) a += qL[i * 128 + sl * 16 + d] * kL[j * 128 + sl * 16 + d];
        a += __shfl_xor(a, 8); a += __shfl_xor(a, 16); a += __shfl_xor(a, 32);
        if (lane < 8) sL[i * 8 + j] = (j <= i) ? a * exp2f((float)(i - j) * lg) : 0.f;
    }
    const int dv = tid & 127, dkq = tid >> 7;
    float vj[8], cr[8];
#pragma unroll
    for (int j = 0; j < 8; ++j) { vj[j] = vL[j * 128 + dv] * exp2f((float)(7 - j) * lg); cr[j] = 0.f; }
    const float g8 = exp2f(8.f * lg);
    const float* stp = (const float*)A.in[I_SRET] + (size_t)unit * 16384 + dv;
    float* nsp = A.out + O_RETS + (size_t)unit * 16384 + dv;
    float stv[32];
#pragma unroll
    for (int k = 0; k < 32; ++k) stv[k] = stp[(32 * dkq + k) * 128];
#pragma unroll
    for (int k = 0; k < 32; ++k) { const int dk = 32 * dkq + k;
        const float st = stv[k]; float ns = g8 * st;
#pragma unroll
        for (int j = 0; j < 8; ++j) { cr[j] += qL[j * 128 + dk] * st; ns += kL[j * 128 + dk] * vj[j]; }
        nsp[dk * 128] = ns;
    }
#pragma unroll
    for (int j = 0; j < 8; ++j) red[(dkq * 8 + j) * 128 + dv] = cr[j];
    __syncthreads();
    {
        const int i = wave; const float qd = exp2f((float)(i + 1) * lg);
        float o[2], s1 = 0.f, s2 = 0.f;
#pragma unroll
        for (int k = 0; k < 2; ++k) { const int d = lane + 64 * k;
            float x = (red[(0 * 8 + i) * 128 + d] + red[(1 * 8 + i) * 128 + d]) + (red[(2 * 8 + i) * 128 + d] + red[(3 * 8 + i) * 128 + d]);
            x *= qd;
#pragma unroll
            for (int j = 0; j < 8; ++j) x += sL[i * 8 + j] * vL[j * 128 + d];
            o[k] = x; s1 += x; s2 += x * x; }
        s1 = wave_sum(s1); s2 = wave_sum(s2);
        const float mu = s1 * (1.f / 128.f), var = fmaxf(s2 * (1.f / 128.f) - mu * mu, 0.f), rstd = 1.f / sqrtf(var + GN_EPS);
        const size_t row = (size_t)NP + b * 8 + i;
#pragma unroll
        for (int k = 0; k < 2; ++k) { const int d = lane + 64 * k;
            const float y = ((o[k] - mu) * rstd * ((const float*)A.in[I_GNG])[h * 128 + d] + ((const float*)A.in[I_GNB])[h * 128 + d]) * bf2f(((const bf16*)(ws + WS_RG))[CM(h * 128 + d, row)]);
            ((bf16*)(ws + WS_YMIX))[row * 1024 + h * 128 + d] = (bf16)f2bf(y); }
    }
}

constexpr int NSA_KP = 144, NSA_VP = 192;
constexpr int NSA_SLOT = 8192;
constexpr int NSA_KT = 0, NSA_VT = 3 * NSA_SLOT, NSA_IMP = NSA_VT + 4 * NSA_SLOT,
     NSA_SEL = NSA_IMP + 4 * 64 * 65 * 4, NSA_IMPF = NSA_SEL + 64 * 8, NSA_GLS = NSA_IMPF + 4 * 64 * 4, NSA_END = NSA_GLS + 3 * 512 * 4;
static_assert(NSA_END <= MISC_OFF && 128 * NSA_KP <= 3 * NSA_SLOT && 128 * NSA_VP <= 4 * NSA_SLOT, "nsa lds");
__device__ __forceinline__ void glds16(const void* g, unsigned lds_base) {
    unsigned sv; asm volatile("s_mov_b32 %0, m0\n\ts_mov_b32 m0, %2\n\ts_nop 0\n\tglobal_load_lds_dwordx4 %1, off\n\ts_mov_b32 m0, %0" : "=&s"(sv) : "v"(g), "s"(lds_base) : "memory"); }

__device__ __forceinline__ float max3f(float a, float b, float c) { float r; asm("v_max3_f32 %0, %1, %2, %3" : "=v"(r) : "v"(a), "v"(b), "v"(c)); return r; }
__device__ __forceinline__ float max2f(float a, float b) { float r; asm("v_max_f32_e32 %0, %1, %2" : "=v"(r) : "v"(a), "v"(b)); return r; }
constexpr float NSA_THR = 8.f;
__device__ __forceinline__ void nsa_qk(f32x16& p0, f32x16& p1, const f32x16& negm, const bf16x8 (&q)[4], LAS const unsigned char* Kt, int r32, int hi, int tl, bool on, int mode) {
    f32x16 c0;
#pragma unroll
    for (int r = 0; r < 16; ++r) c0[r] = on ? negm[r] : NEGBIG;
    bf16x8 kf[8];
#pragma unroll
    for (int d0 = 0; d0 < 4; ++d0) { kf[2 * d0] = *(LAS const bf16x8*)(Kt + d0 * 2048 + hi * 1024 + r32 * 16); kf[2 * d0 + 1] = *(LAS const bf16x8*)(Kt + d0 * 2048 + hi * 1024 + 512 + r32 * 16); }
    __builtin_amdgcn_sched_barrier(0);
#pragma unroll
    for (int d0 = 0; d0 < 4; ++d0) {
        if (d0 == 0) { p0 = MFMA32(kf[0], q[0], c0); p1 = MFMA32(kf[1], q[0], c0); } else { p0 = MFMA32(kf[2 * d0], q[d0], p0); p1 = MFMA32(kf[2 * d0 + 1], q[d0], p1); }
    }
    if (mode != 0) {
        asm volatile("" : "+v"(tl));
        const int lo = (mode == 2) ? tl : 0, hb = (mode == 1) ? tl : 63;
#pragma unroll
        for (int r = 0; r < 16; ++r) { const int kk = crow(r, hi);
            p0[r] = (kk >= lo && kk <= hb) ? p0[r] : NEGBIG; p1[r] = (kk + 32 >= lo && kk + 32 <= hb) ? p1[r] : NEGBIG; }
    }
}
__device__ __forceinline__ void nsa_sv(f32x16 (&o)[2], f32x16& negm, float& m, float& l, f32x16& p0, f32x16& p1, LAS const unsigned char* Vt, int hi, int vb) {
    float mx = max3f(p0[0], p0[1], p1[0]), mb = max3f(p0[2], p0[3], p1[1]); mx = max3f(mx, p1[2], p1[3]);
#pragma unroll
    for (int r = 4; r < 16; r += 4) { mx = max3f(mx, p0[r], p0[r + 1]); mb = max3f(mb, p0[r + 2], p0[r + 3]); mx = max3f(mx, p1[r], p1[r + 1]); mb = max3f(mb, p1[r + 2], p1[r + 3]); }
    mx = xor32_max(max2f(mx, mb));
    if (__any(mx > NSA_THR)) {
        const float d = fmaxf(mx, 0.f), alpha = __builtin_amdgcn_exp2f(-d);
        m += d; l *= alpha;
#pragma unroll
        for (int r = 0; r < 16; ++r) { p0[r] -= d; p1[r] -= d; o[0][r] *= alpha; o[1][r] *= alpha; negm[r] = -m; }
    }
    f32x2 rs0 = {0.f, 0.f}, rs1 = {0.f, 0.f};
#pragma unroll
    for (int r = 0; r < 16; r += 2) {
        p0[r] = __builtin_amdgcn_exp2f(p0[r]); p0[r + 1] = __builtin_amdgcn_exp2f(p0[r + 1]); p1[r] = __builtin_amdgcn_exp2f(p1[r]); p1[r + 1] = __builtin_amdgcn_exp2f(p1[r + 1]);
        rs0 += (f32x2){p0[r], p0[r + 1]}; rs1 += (f32x2){p1[r], p1[r + 1]};
    }
    l += (rs0.x + rs0.y) + (rs1.x + rs1.y);
#pragma unroll
    for (int s = 0; s < 4; ++s) {
        const bf16x8 pb = pack_frag(s < 2 ? p0 : p1, 8 * (s & 1));
#pragma unroll
        for (int db = 0; db < 2; ++db) {
            const bf16x8 vf = cat8(ds_tr(Vt + db * 4096 + s * 1024 + vb), ds_tr(Vt + db * 4096 + s * 1024 + 512 + vb));
            o[db] = MFMA32(vf, pb, o[db]);
        }
    }
}

__device__ __forceinline__ void nsa_prompt_unit(const Args& A, LAS unsigned char* lds, int b, int kvh, int qb, int tid, int lane, int wave) {
    unsigned char* ws = A.ws;
    asm volatile("" : "+v"(tid), "+v"(lane));
    const int r32 = lane & 31, hi = lane >> 5, g = wave & 3, qs = wave >> 2, hq = kvh * 4 + g, tl = 32 * qs + r32, q0 = 64 * qb, t = q0 + tl;
    const size_t rowb = (size_t)b * SEQ, row = rowb + t;
    const int tro = tr_off(lane, NSA_VP);
    LAS unsigned char* KT = lds + NSA_KT; LAS unsigned char* VT = lds + NSA_VT;
    LAS float* IMP = (LAS float*)(lds + NSA_IMP); LAS unsigned long long* SEL = (LAS unsigned long long*)(lds + NSA_SEL); LAS float* IMPF = (LAS float*)(lds + NSA_IMPF); LAS float* GLS = (LAS float*)(lds + NSA_GLS);
    const int lrow = tid & 63, lch = tid >> 6;
    __syncthreads();
    {
        const bf16* kc = (const bf16*)(ws + WS_KCP) + ((size_t)b * 128) * 128 + kvh * 64 + lch * 8; const bf16* vc = (const bf16*)(ws + WS_VCP) + ((size_t)b * 128) * 128 + kvh * 64 + lch * 8;
#pragma unroll
        for (int i = 0; i < 2; ++i) { const int rr = lrow + 64 * i;
            *(LAS u32x4*)(KT + rr * NSA_KP + lch * 16) = *(const u32x4*)(kc + (size_t)rr * 128);
            *(LAS u32x4*)(VT + rr * NSA_VP + lch * 16) = *(const u32x4*)(vc + (size_t)rr * 128); }
    }
    bf16x8 qr[4];
    f32x16 otot[2];
    const float* glp = (const float*)(ws + WS_GL) + row * 32 + hq;
    {
        bf16x8 qn[4];
        const bf16* qp = (const bf16*)(ws + WS_QN) + CM(hq * 64 + 8 * hi, row);
#pragma unroll
        for (int d0 = 0; d0 < 4; ++d0) qn[d0] = *(const bf16x8*)(qp + (size_t)d0 * (2 * NTOK * 8));
        { const float ga = glp[0], gb = glp[8], gc = glp[16]; GLS[tid] = ga; GLS[512 + tid] = gb; GLS[1024 + tid] = gc; }
        __syncthreads();
        const int ntile = (qb >= 31) ? 2 : 1, nvalid = (t + 1) >> 5;
        float mx = MINIT;
#pragma unroll 1
        for (int pt = 0; pt < 2 * ntile; ++pt) {
            f32x16 p = f32x16{};
#pragma unroll
            for (int d0 = 0; d0 < 4; ++d0) { const bf16x8 kf = *(LAS const bf16x8*)(KT + (32 * pt + r32) * NSA_KP + (16 * d0 + 8 * hi) * 2); p = MFMA32(kf, qn[d0], p); }
#pragma unroll
            for (int r = 0; r < 16; ++r) { const int cidx = 32 * pt + crow(r, hi); mx = fmaxf(mx, (cidx < nvalid) ? p[r] : NEGBIG); }
        }
        mx = xor32_max(mx);
        float ls = 0.f;
        f32x16 oc[2]; oc[0] = f32x16{}; oc[1] = f32x16{};
        LAS float* ip = IMP + (g * 64 + tl) * 65;
#pragma unroll 1
        for (int pt = 0; pt < 4; ++pt) {
            f32x16 p = f32x16{};
            if (pt < 2 * ntile) {
#pragma unroll
                for (int d0 = 0; d0 < 4; ++d0) { const bf16x8 kf = *(LAS const bf16x8*)(KT + (32 * pt + r32) * NSA_KP + (16 * d0 + 8 * hi) * 2); p = MFMA32(kf, qn[d0], p); }
            }
#pragma unroll
            for (int r = 0; r < 16; ++r) { const int cidx = 32 * pt + crow(r, hi); p[r] = (cidx < nvalid) ? __builtin_amdgcn_exp2f(p[r] - mx) : 0.f; ls += p[r]; }
#pragma unroll
            for (int r = 1; r < 16; r += 2) ip[16 * pt + (crow(r - 1, hi) >> 1)] = p[r - 1] + p[r];
            if (pt < 2 * ntile) {
#pragma unroll
                for (int s2 = 0; s2 < 2; ++s2) {
                    const bf16x8 pb = pack_frag(p, 8 * s2);
                    const int j0 = 32 * pt + 16 * s2 + 4 * hi;
#pragma unroll
                    for (int db = 0; db < 2; ++db) { const bf16x8 vf = cat8(ds_tr(VT + j0 * NSA_VP + 64 * db + tro), ds_tr(VT + (j0 + 8) * NSA_VP + 64 * db + tro)); oc[db] = MFMA32(vf, pb, oc[db]); }
                }
            }
        }
        ls = xor32_sum(ls);
        const float inv = ls > 0.f ? 1.f / ls : 0.f;
        if (hi == 0) IMPF[g * 64 + tl] = inv;
#pragma unroll
        for (int r = 0; r < 16; ++r) { oc[0][r] *= inv; oc[1][r] *= inv; }
        const float g0 = GLS[tid];
#pragma unroll
        for (int r = 0; r < 16; ++r) { otot[0][r] = g0 * oc[0][r]; otot[1][r] = g0 * oc[1][r]; }
    }
    __syncthreads();
#pragma unroll 1
    for (int q4 = 0; q4 < 8; q4 += 4) {
        unsigned key[4], thr[4];
#pragma unroll
        for (int u = 0; u < 4; ++u) {
            const int tq = 8 * wave + q4 + u;
            const float imp = (IMP[(0 * 64 + tq) * 65 + lane] * IMPF[tq] + IMP[(1 * 64 + tq) * 65 + lane] * IMPF[64 + tq]) + (IMP[(2 * 64 + tq) * 65 + lane] * IMPF[128 + tq] + IMP[(3 * 64 + tq) * 65 + lane] * IMPF[192 + tq]);
            const bool forced = (lane == 0) || (lane == qb), valid = lane <= qb;
            key[u] = forced ? 0xFFFFFFFFu : (valid ? (__builtin_bit_cast(unsigned, imp) | 0x80000000u) : 0u);
            thr[u] = 0u;
        }
#pragma unroll 2
        for (int bit = 31; bit >= 0; --bit) {
#pragma unroll
            for (int u = 0; u < 4; ++u) { const unsigned cand = thr[u] | (1u << bit); if (__popcll(__ballot(key[u] >= cand)) >= 16) thr[u] = cand; }
        }
#pragma unroll
        for (int u = 0; u < 4; ++u) {
            const int tq = 8 * wave + q4 + u;
            const unsigned long long mgt = __ballot(key[u] > thr[u]), meq = __ballot(key[u] == thr[u]);
            const int need = 16 - __popcll(mgt);
            const int below = __builtin_amdgcn_mbcnt_hi((unsigned)(meq >> 32), __builtin_amdgcn_mbcnt_lo((unsigned)meq, 0u));
            const unsigned long long mask = mgt | __ballot(key[u] == thr[u] && below < need);
            if (lane == 0) SEL[tq] = mask;
        }
    }
    __syncthreads();
    LAS float* park = IMP + tid;
#pragma unroll
    for (int r = 0; r < 16; ++r) { park[r * 512] = otot[0][r]; park[(16 + r) * 512] = otot[1][r]; }
    { const bf16* qp2 = (const bf16*)(ws + WS_QROT) + CM(hq * 64 + 8 * hi, row);
#pragma unroll
      for (int d0 = 0; d0 < 4; ++d0) qr[d0] = *(const bf16x8*)(qp2 + (size_t)d0 * (2 * NTOK * 8)); }
    const unsigned long long sel = SEL[tl];
    const int jw0 = qb > 8 ? qb - 8 : 0, nB = qb + 1, NT = nB + (qb - jw0 + 1);
    const int wv = __builtin_amdgcn_readfirstlane(wave);
    const size_t kso = CM(kvh * 64 + wv * 8, rowb + lane), vso = CM(kvh * 64 + (wv >> 2) * 32 + (lane & 3) * 8, rowb + 16 * (wv & 3) + (lane >> 2));
    const bf16* ksb = (const bf16*)(ws + WS_KS) + kso; const bf16* vsb = (const bf16*)(ws + WS_VS) + vso;
    const bf16* kwb = (const bf16*)(ws + WS_KW) + kso; const bf16* vwb = (const bf16*)(ws + WS_VW) + vso;
    const unsigned kdst = (unsigned)(size_t)(lds + NSA_KT) + wv * 1024, vdst = (unsigned)(size_t)(lds + NSA_VT) + wv * 1024;
    const int vb = ((lane >> 4) & 1) * 32 + (lane & 3) * 8 + (4 * hi + ((lane & 15) >> 2)) * 64;
    f32x16 o[2]; o[0] = f32x16{}; o[1] = f32x16{};
    f32x16 negm = f32x16{};
    float m = 0.f, l = 0.f;
    const bool trail = qs != 0;
    f32x16 p0, p1; bool pend = false; int pend_v = 0, ks = 0;
#define NSA_DMA(T, KSL) do { const int t_ = ((T) < NT) ? (T) : NT - 1; const bool sl_ = t_ < nB; const int j_ = sl_ ? t_ : jw0 + (t_ - nB); \
        glds16((sl_ ? ksb : kwb) + (size_t)j_ * 512, (unsigned)__builtin_amdgcn_readfirstlane(kdst + (KSL) * NSA_SLOT)); \
        glds16((sl_ ? vsb : vwb) + (size_t)j_ * 512, (unsigned)__builtin_amdgcn_readfirstlane(vdst + ((T) & 3) * NSA_SLOT)); } while (0)
    asm volatile("" : "+v"(qr[0]), "+v"(qr[1]), "+v"(qr[2]), "+v"(qr[3]));
    NSA_DMA(0, 0); NSA_DMA(1, 1);
    if (trail) __builtin_amdgcn_s_setprio(1);
#pragma unroll 1
    for (int n = 0; n < NT; ++n) {
        asm volatile("s_waitcnt vmcnt(2) lgkmcnt(0)\n\ts_barrier" ::: "memory");
        const int ks2 = (ks == 0) ? 2 : ks - 1;
        NSA_DMA(n + 2, ks2);
        LAS unsigned char* kt = KT + ks * NSA_SLOT; LAS unsigned char* vt = VT + (n & 3) * NSA_SLOT;
        if (pend) { nsa_sv(o, negm, m, l, p0, p1, VT + pend_v, hi, vb); pend = false; }
        if (n == nB) {
            const float lt = xor32_sum(l), sc = GLS[512 + tid] / lt;
#pragma unroll
            for (int r = 0; r < 16; ++r) { park[r * 512] += sc * o[0][r]; park[(16 + r) * 512] += sc * o[1][r]; }
            o[0] = f32x16{}; o[1] = f32x16{}; negm = f32x16{}; m = 0.f; l = 0.f;
        }
        const bool slc = n < nB; const int j = slc ? n : jw0 + (n - nB);
        const bool on = slc ? (bool)((sel >> n) & 1ull) : true;
        const bool act = __any(on);
        const int mode = (j == qb) ? 1 : ((!slc && j == qb - 8) ? 2 : 0);
        if (act) nsa_qk(p0, p1, negm, qr, kt, r32, hi, tl, on, mode);
        if (trail) { pend = act; pend_v = (n & 3) * NSA_SLOT; }
        else if (act) nsa_sv(o, negm, m, l, p0, p1, vt, hi, vb);
        ks = (ks == 2) ? 0 : ks + 1;
    }
#undef NSA_DMA
    __builtin_amdgcn_s_setprio(0);
    asm volatile("s_waitcnt vmcnt(0)" ::: "memory");
    if (pend) nsa_sv(o, negm, m, l, p0, p1, VT + pend_v, hi, vb);
    {
        const float lt = xor32_sum(l), sc = GLS[1024 + tid] / lt;
#pragma unroll
        for (int r = 0; r < 16; ++r) { otot[0][r] = park[r * 512] + sc * o[0][r]; otot[1][r] = park[(16 + r) * 512] + sc * o[1][r]; }
    }
    const bf16* ngp = (const bf16*)(ws + WS_NG); bf16* yp = (bf16*)(ws + WS_YMIX) + row * 1024 + 512 + hq * 64;
    u32x2 ngv[2][4];
#pragma unroll
    for (int db = 0; db < 2; ++db)
#pragma unroll
        for (int q = 0; q < 4; ++q) ngv[db][q] = *(const u32x2*)(ngp + CM(hq * 64 + 32 * db + 8 * q + 4 * hi, row));
#pragma unroll
    for (int db = 0; db < 2; ++db)
#pragma unroll
        for (int q = 0; q < 4; ++q) {
            const int d = 32 * db + 8 * q + 4 * hi;
            const u32x2 ng = ngv[db][q];
            u32x2 ov; ov.x = pk2(otot[db][4 * q] * bflo(ng.x), otot[db][4 * q + 1] * bfhi(ng.x)); ov.y = pk2(otot[db][4 * q + 2] * bflo(ng.y), otot[db][4 * q + 3] * bfhi(ng.y));
            *(u32x2*)(yp + d) = ov;
        }
}

template <int CTRL> __device__ __forceinline__ float dpp_add(float v) { return v + __builtin_bit_cast(float, __builtin_amdgcn_update_dpp(0, __builtin_bit_cast(int, v), CTRL, 0xf, 0xf, true)); }
__device__ __forceinline__ float red16(float v) { v = dpp_add<0xB1>(v); v = dpp_add<0x4E>(v); v = dpp_add<0x141>(v); v = dpp_add<0x140>(v); return v; }
__device__ __forceinline__ float dot4(const f32x4 a, const f32x4 b) { return (a.x * b.x + a.y * b.y) + (a.z * b.z + a.w * b.w); }

__device__ __forceinline__ void dec_block(float (&m)[4], float (&l)[4], f32x4 (&o)[4], const f32x4 (&q)[4], const float* Kb, const float* Vb, int lo, int hi_, int kk) {
#pragma unroll 1
    for (int hb = 0; hb < 2; ++hb) {
        if (32 * hb >= hi_ || 32 * hb + 32 <= lo) continue;
        f32x4 kr[8], vr[8]; float s[8][4];
#pragma unroll
        for (int it = 0; it < 8; ++it) { const int key = 32 * hb + 4 * it + kk; const int kc = (key >= lo && key < hi_) ? key : lo; kr[it] = *(const f32x4*)(Kb + (size_t)kc * 128); }
#pragma unroll
        for (int it = 0; it < 8; ++it) { const int key = 32 * hb + 4 * it + kk; const bool valid = key >= lo && key < hi_; const int kc = valid ? key : lo;
            vr[it] = *(const f32x4*)(Vb + (size_t)kc * 128);
#pragma unroll
            for (int g = 0; g < 4; ++g) { const float d = red16(dot4(q[g], kr[it])); s[it][g] = valid ? d : NEGBIG; } }
#pragma unroll
        for (int g = 0; g < 4; ++g) {
            float mx = s[0][g];
#pragma unroll
            for (int it = 1; it < 8; ++it) mx = fmaxf(mx, s[it][g]);
            mx = fmaxf(mx, __shfl_xor(mx, 16)); mx = fmaxf(mx, __shfl_xor(mx, 32));
            const float mn = fmaxf(m[g], mx), alpha = __builtin_amdgcn_exp2f(m[g] - mn);
            m[g] = mn; l[g] *= alpha; o[g] = o[g] * alpha;
#pragma unroll
            for (int it = 0; it < 8; ++it) { const float p = __builtin_amdgcn_exp2f(s[it][g] - mn); l[g] += p; o[g] = o[g] + vr[it] * p; }
        }
    }
}
__device__ __forceinline__ void dec_publish(const float (&m)[4], float (&l)[4], f32x4 (&o)[4], LAS float* st, LAS float* ob, int wave, int lane) {
#pragma unroll
    for (int g = 0; g < 4; ++g) {
        l[g] += __shfl_xor(l[g], 16); l[g] += __shfl_xor(l[g], 32);
#pragma unroll
        for (int e = 0; e < 4; ++e) { float x = o[g][e]; x += __shfl_xor(x, 16); x += __shfl_xor(x, 32); o[g][e] = x; }
        if (lane < 16) *(LAS f32x4*)(ob + (wave * 4 + g) * 64 + 4 * lane) = o[g];
        if (lane == 0) { st[(wave * 4 + g) * 2] = m[g]; st[(wave * 4 + g) * 2 + 1] = l[g]; }
    }
}
__device__ __forceinline__ float dec_combine(LAS const float* st, LAS const float* ob, int g, int d) {
    float M = NEGBIG;
#pragma unroll
    for (int w = 0; w < 8; ++w) M = fmaxf(M, st[(w * 4 + g) * 2]);
    float L = 0.f, O = 0.f;
#pragma unroll
    for (int w = 0; w < 8; ++w) { const float f = exp2f(st[(w * 4 + g) * 2] - M); L += f * st[(w * 4 + g) * 2 + 1]; O += f * ob[(w * 4 + g) * 64 + d]; }
    return L > 0.f ? O / L : 0.f;
}

__device__ __forceinline__ void nsa_decode_unit(const Args& A, LAS unsigned char* lds, int unit, int tid, int lane, int wave) {
    unsigned char* ws = A.ws;
    const int b = unit >> 4, kvh = (unit >> 3) & 1, t = unit & 7, kk = lane >> 4, dq = lane & 15;
    const size_t row = (size_t)NP + b * 8 + t;
    LAS float* sc = (LAS float*)lds;
    LAS float* scr = sc + 2048;
    LAS int* selL = (LAS int*)(scr + 260);
    LAS float* ocmp = (LAS float*)(selL + 16);
    LAS float* st1 = ocmp + 2048; LAS float* ob1 = st1 + 64;
    LAS float* st2 = ob1 + 2048; LAS float* ob2 = st2 + 64;
    f32x4 qn[4], qr[4];
#pragma unroll
    for (int g = 0; g < 4; ++g) {
        const u32x2 a = *(const u32x2*)((const bf16*)(ws + WS_QN) + CM((kvh * 4 + g) * 64 + 4 * dq, row)), c = *(const u32x2*)((const bf16*)(ws + WS_QROT) + CM((kvh * 4 + g) * 64 + 4 * dq, row));
        qn[g] = (f32x4){bflo(a.x), bfhi(a.x), bflo(a.y), bfhi(a.y)}; qr[g] = (f32x4){bflo(c.x), bfhi(c.x), bflo(c.y), bfhi(c.y)};
    }
    __syncthreads();
    const float* kcs = (const float*)(ws + WS_KCS) + ((size_t)b * 512 * 2 + kvh) * 64 + 4 * dq; const float* vcs = (const float*)(ws + WS_VCS) + ((size_t)b * 512 * 2 + kvh) * 64 + 4 * dq;
    f32x4 krr[16];
#pragma unroll
    for (int it = 0; it < 16; ++it) krr[it] = *(const f32x4*)(kcs + (size_t)(64 * wave + 4 * it + kk) * 128);
#pragma unroll
    for (int it = 0; it < 16; ++it) {
        const int key = 64 * wave + 4 * it + kk;
        const f32x4 kr = krr[it];
        const float s0 = red16(dot4(qn[0], kr)), s1 = red16(dot4(qn[1], kr)), s2 = red16(dot4(qn[2], kr)), s3 = red16(dot4(qn[3], kr));
        if (dq < 4) sc[dq * 512 + key] = dq == 0 ? s0 : dq == 1 ? s1 : dq == 2 ? s2 : s3;
    }
    __syncthreads();
    if (wave < 4) {
        float v[8], mx = NEGBIG;
#pragma unroll
        for (int i = 0; i < 8; ++i) { v[i] = sc[wave * 512 + lane + 64 * i]; mx = fmaxf(mx, v[i]); }
        mx = wave_max(mx); float sm = 0.f;
#pragma unroll
        for (int i = 0; i < 8; ++i) { v[i] = __builtin_amdgcn_exp2f(v[i] - mx); sm += v[i]; }
        sm = wave_sum(sm); const float inv = 1.f / sm;
#pragma unroll
        for (int i = 0; i < 8; ++i) sc[wave * 512 + lane + 64 * i] = v[i] * inv;
    }
    __syncthreads();
    if (tid < 256) { float s = -1.f; if (tid > 0) s = (sc[2 * tid] + sc[2 * tid + 1]) + (sc[512 + 2 * tid] + sc[512 + 2 * tid + 1]) + ((sc[1024 + 2 * tid] + sc[1024 + 2 * tid + 1]) + (sc[1536 + 2 * tid] + sc[1536 + 2 * tid + 1])); scr[tid] = s; }
    {
        f32x4 oc[4]; oc[0] = oc[1] = oc[2] = oc[3] = (f32x4){0.f, 0.f, 0.f, 0.f};
        f32x4 vrr[16];
#pragma unroll
        for (int it = 0; it < 16; ++it) vrr[it] = *(const f32x4*)(vcs + (size_t)(64 * wave + 4 * it + kk) * 128);
#pragma unroll
        for (int it = 0; it < 16; ++it) {
            const int key = 64 * wave + 4 * it + kk;
            const f32x4 vr = vrr[it];
#pragma unroll
            for (int g = 0; g < 4; ++g) oc[g] = oc[g] + vr * sc[g * 512 + key];
        }
#pragma unroll
        for (int g = 0; g < 4; ++g) {
#pragma unroll
            for (int e = 0; e < 4; ++e) { float x = oc[g][e]; x += __shfl_xor(x, 16); x += __shfl_xor(x, 32); oc[g][e] = x; }
            if (lane < 16) *(LAS f32x4*)(ocmp + (wave * 4 + g) * 64 + 4 * lane) = oc[g];
        }
    }
    __syncthreads();
    {
        LAS int* rk = (LAS int*)ob1;
        const int c = tid & 255, half = tid >> 8; const float s = scr[c]; int rank = 0;
#pragma unroll 8
        for (int j4 = 0; j4 < 32; ++j4) { const f32x4 v = *(LAS const f32x4*)(scr + 128 * half + 4 * j4);
#pragma unroll
            for (int e = 0; e < 4; ++e) { const int j = 128 * half + 4 * j4 + e; rank += (v[e] > s || (v[e] == s && j < c)) ? 1 : 0; } }
        rk[tid] = rank;
        __syncthreads();
        if (tid > 0 && tid < 256) { const int r2 = rk[tid] + rk[tid + 256]; if (r2 < 14) selL[2 + r2] = tid; }
        if (tid == 0) { selL[0] = 0; selL[1] = 256; }
    }
    __syncthreads();
    {
        float m[4], l[4]; f32x4 o[4];
#pragma unroll
        for (int g = 0; g < 4; ++g) { m[g] = MINIT; l[g] = 0.f; o[g] = (f32x4){0.f, 0.f, 0.f, 0.f}; }
        const int bb0 = selL[2 * wave], bb1 = selL[2 * wave + 1];
        const int pg0 = ((const int*)A.in[I_PT])[b * 128 + ((bb0 < 256 ? bb0 : 0) >> 1)], pg1 = ((const int*)A.in[I_PT])[b * 128 + ((bb1 < 256 ? bb1 : 0) >> 1)];
#pragma unroll 1
        for (int i = 0; i < 2; ++i) {
            const int bb = i ? bb1 : bb0, pg = i ? pg1 : pg0;
            const bool past = bb < 256;
            const size_t base = past ? ((size_t)pg * 128 + (bb & 1) * 64) * 128 + kvh * 64 + 4 * dq : ((size_t)b * 8) * 128 + kvh * 64 + 4 * dq;
            const float* Kb = (past ? (const float*)A.in[I_CSK] : (const float*)(A.out + O_SLCK_S)) + base;
            const float* Vb = (past ? (const float*)A.in[I_CSV] : (const float*)(A.out + O_SLCV_S)) + base;
            dec_block(m, l, o, qr, Kb, Vb, 0, past ? 64 : t + 1, kk);
        }
        dec_publish(m, l, o, st1, ob1, wave, lane);
    }
    {
        float m[4], l[4]; f32x4 o[4];
#pragma unroll
        for (int g = 0; g < 4; ++g) { m[g] = MINIT; l[g] = 0.f; o[g] = (f32x4){0.f, 0.f, 0.f, 0.f}; }
#pragma unroll 1
        for (int i = 0; i < ((wave == 0) ? 2 : 1); ++i) {
            const size_t base = ((size_t)b * 512 + (i ? 504 : 64 * wave)) * 128 + kvh * 64 + 4 * dq;
            const float* Kb = (i ? (const float*)(A.out + O_WINK_S) : (const float*)A.in[I_SWK]) + base;
            const float* Vb = (i ? (const float*)(A.out + O_WINV_S) : (const float*)A.in[I_SWV]) + base;
            const int lo = i ? 0 : ((t > 64 * wave) ? (t - 64 * wave) : 0);
            dec_block(m, l, o, qr, Kb, Vb, lo, i ? t + 1 : 64, kk);
        }
        dec_publish(m, l, o, st2, ob2, wave, lane);
    }
    __syncthreads();
    if (tid < 256) {
        const int g = tid >> 6, d = tid & 63, hq = kvh * 4 + g;
        float oc = 0.f;
#pragma unroll
        for (int w = 0; w < 8; ++w) oc += ocmp[(w * 4 + g) * 64 + d];
        const float os = dec_combine(st1, ob1, g, d), ow = dec_combine(st2, ob2, g, d);
        const float* glp = (const float*)(ws + WS_GL) + row * 32 + hq;
        const float y = (glp[0] * oc + glp[8] * os + glp[16] * ow) * bf2f(((const bf16*)(ws + WS_NG))[CM(hq * 64 + d, row)]);
        ((bf16*)(ws + WS_YMIX))[row * 1024 + 512 + hq * 64 + d] = (bf16)f2bf(y);
    }
    __syncthreads();
}

struct EpiPle {
    static constexpr bool PERM = true, AFTER_DRAIN = false;
    unsigned char* ws;
    __device__ __forceinline__ void operator()(const pg8::f32x4 (&acc)[2][2][4][2], const pg8::Unit& u, int wr, int wc, int fr, int fq) const {
        asm volatile("" : "+v"(fr), "+v"(fq));
#pragma unroll
        for (int ai = 0; ai < 2; ++ai)
#pragma unroll
            for (int m = 0; m < 4; ++m) {
                const size_t row = (size_t)u.pm * 256 + ai * 128 + wr * 64 + m * 16 + fr;
#pragma unroll
                for (int bj = 0; bj < 2; ++bj) { bf16* d = (bf16*)(ws + WS_PPO) + row * 1024 + u.pn * 256 + bj * 128 + wc * 32 + 8 * fq;
                    const f32x4 a = acc[ai][bj][m][0], c = acc[ai][bj][m][1];
                    u32x4 w; w.x = pk2(a.x, a.y); w.y = pk2(a.z, a.w); w.z = pk2(c.x, c.y); w.w = pk2(c.z, c.w); *(u32x4*)d = w; }
            }
    }
};
struct EpiOut {
    static constexpr bool PERM = true, AFTER_DRAIN = false;
    unsigned char* ws; const float* xp; const float* xs;
    __device__ __forceinline__ void operator()(const pg8::f32x4 (&acc)[2][2][4][2], const pg8::Unit& u, int wr, int wc, int fr, int fq) const {
        asm volatile("" : "+v"(fr), "+v"(fq));
#pragma unroll
        for (int ai = 0; ai < 2; ++ai)
#pragma unroll
            for (int m = 0; m < 4; ++m) {
                const size_t row = (size_t)u.pm * 256 + ai * 128 + wr * 64 + m * 16 + fr;
                const float* xrow = (row < NP) ? xp + row * 1024 : xs + (row - NP) * 1024;
                float ss = 0.f;
#pragma unroll
                for (int bj = 0; bj < 2; ++bj) { const int col = u.pn * 256 + bj * 128 + wc * 32 + 8 * fq;
                    const f32x4 a = *(const f32x4*)(xrow + col) + acc[ai][bj][m][0], c = *(const f32x4*)(xrow + col + 4) + acc[ai][bj][m][1];
                    u32x4 w; w.x = pk2(a.x, a.y); w.y = pk2(a.z, a.w); w.z = pk2(c.x, c.y); w.w = pk2(c.z, c.w);
                    *(u32x4*)((bf16*)(ws + WS_X1B) + row * 1024 + col) = w;
                    ss += (a.x * a.x + a.y * a.y) + (a.z * a.z + a.w * a.w) + (c.x * c.x + c.y * c.y) + (c.z * c.z + c.w * c.w); }
                ss += __shfl_xor(ss, 16); ss += __shfl_xor(ss, 32);
                if (fq == 0) ((float*)(ws + WS_SS1))[row * 16 + u.pn * 4 + wc] = ss;
            }
    }
};
__device__ __forceinline__ void panel_meet(unsigned* cnt, unsigned expect, int tid) {
    asm volatile("s_waitcnt vmcnt(0)" ::: "memory");
    __syncthreads();
    if (tid == 0) {
        __hip_atomic_fetch_add(cnt, 1u, __ATOMIC_RELAXED, __HIP_MEMORY_SCOPE_AGENT);
        unsigned sp = 0;
        while (__hip_atomic_load(cnt, __ATOMIC_RELAXED, __HIP_MEMORY_SCOPE_AGENT) < expect) { __builtin_amdgcn_s_sleep(1); if (++sp > (1u << 22)) break; }
    }
    __syncthreads();
}
struct EpiGateNorm {
    static constexpr bool PERM = true, AFTER_DRAIN = false;
    unsigned char* ws; float* out; const float* nf;
    __device__ __forceinline__ void operator()(const pg8::f32x4 (&acc_)[2][2][4][2], const pg8::Unit& u, int wr, int wc, int fr, int fq) const {
        pg8::f32x4 (&acc)[2][2][4][2] = const_cast<pg8::f32x4 (&)[2][2][4][2]>(acc_);
        asm volatile("" : "+v"(fr), "+v"(fq));
#pragma unroll
        for (int ai = 0; ai < 2; ++ai)
#pragma unroll
            for (int m = 0; m < 4; ++m) {
                const size_t row = (size_t)u.pm * 256 + ai * 128 + wr * 64 + m * 16 + fr;
                const f32x4* sp = (const f32x4*)((const float*)(ws + WS_SS1) + row * 16);
                const f32x4 s0 = sp[0], s1 = sp[1], s2 = sp[2], s3 = sp[3];
                const float tot = ((s0.x + s0.y) + (s0.z + s0.w)) + ((s1.x + s1.y) + (s1.z + s1.w)) + (((s2.x + s2.y) + (s2.z + s2.w)) + ((s3.x + s3.y) + (s3.z + s3.w)));
                const float rstd = 1.f / sqrtf(tot * (1.f / 1024.f) + RMS_EPS);
                float ss = 0.f;
#pragma unroll
                for (int bj = 0; bj < 2; ++bj) { const int col = u.pn * 256 + bj * 128 + wc * 32 + 8 * fq;
                    const u32x4 xb = *(const u32x4*)((const bf16*)(ws + WS_X1B) + row * 1024 + col), pb = *(const u32x4*)((const bf16*)(ws + WS_PPO) + row * 1024 + col);
                    f32x4 a = {bflo(xb.x), bfhi(xb.x), bflo(xb.y), bfhi(xb.y)}, c = {bflo(xb.z), bfhi(xb.z), bflo(xb.w), bfhi(xb.w)};
                    const f32x4 pa = {bflo(pb.x), bfhi(pb.x), bflo(pb.y), bfhi(pb.y)}, pc = {bflo(pb.z), bfhi(pb.z), bflo(pb.w), bfhi(pb.w)};
#pragma unroll
                    for (int e = 0; e < 4; ++e) { a[e] += sigmoidf_(rstd * acc[ai][bj][m][0][e]) * pa[e]; c[e] += sigmoidf_(rstd * acc[ai][bj][m][1][e]) * pc[e]; }
                    acc[ai][bj][m][0] = a; acc[ai][bj][m][1] = c;
                    ss += (a.x * a.x + a.y * a.y) + (a.z * a.z + a.w * a.w) + (c.x * c.x + c.y * c.y) + (c.z * c.z + c.w * c.w); }
                ss += __shfl_xor(ss, 16); ss += __shfl_xor(ss, 32);
                if (fq == 0) __hip_atomic_store((float*)(ws + WS_SS2) + row * 16 + u.pn * 4 + wc, ss, __ATOMIC_RELAXED, __HIP_MEMORY_SCOPE_AGENT);
            }
        panel_meet((unsigned*)(ws + WS_CTL) + 16384 + 64 * u.pm, 4u, (int)threadIdx.x);
#pragma unroll
        for (int ai = 0; ai < 2; ++ai)
#pragma unroll
            for (int m = 0; m < 4; ++m) {
                const size_t row = (size_t)u.pm * 256 + ai * 128 + wr * 64 + m * 16 + fr;
                float* sp = (float*)(ws + WS_SS2) + row * 16 + 4 * fq;
                float tot = (__hip_atomic_load(sp, __ATOMIC_RELAXED, __HIP_MEMORY_SCOPE_AGENT) + __hip_atomic_load(sp + 1, __ATOMIC_RELAXED, __HIP_MEMORY_SCOPE_AGENT))
                          + (__hip_atomic_load(sp + 2, __ATOMIC_RELAXED, __HIP_MEMORY_SCOPE_AGENT) + __hip_atomic_load(sp + 3, __ATOMIC_RELAXED, __HIP_MEMORY_SCOPE_AGENT));
                tot += __shfl_xor(tot, 16); tot += __shfl_xor(tot, 32);
                const float rstd2 = 1.f / sqrtf(tot * (1.f / 1024.f) + RMS_EPS);
#pragma unroll
                for (int bj = 0; bj < 2; ++bj) { const int col = u.pn * 256 + bj * 128 + wc * 32 + 8 * fq;
                    const f32x4 g0 = *(const f32x4*)(nf + col), g1 = *(const f32x4*)(nf + col + 4);
                    float* d = out + O_Y + row * 1024 + col; *(f32x4*)d = acc[ai][bj][m][0] * rstd2 * g0; *(f32x4*)(d + 4) = acc[ai][bj][m][1] * rstd2 * g1; }
            }
    }
};
__device__ __forceinline__ void final_norm(const Args& A, int lane, int wave) {
    const int gw = blockIdx.x * 8 + wave, NGW = gridDim.x * 8;
    const f32x4* nf = (const f32x4*)A.in[I_NF];
    f32x4 g[4];
#pragma unroll
    for (int j = 0; j < 4; ++j) g[j] = nf[64 * j + lane];
    for (int row = gw; row < NTOK; row += NGW) {
        float tot = 0.f;
        if (row < NP) { const float* sp = (const float*)(A.ws + WS_SS2) + (size_t)row * 16;
#pragma unroll
            for (int i = 0; i < 16; ++i) tot += sp[i]; }
        else tot = wave_sum(lane < 32 ? ((const float*)(A.ws + WS_SS2D))[(size_t)(row - NP) * 32 + lane] : 0.f);
        const float rstd = 1.f / sqrtf(tot * (1.f / 1024.f) + RMS_EPS);
        f32x4* y = (f32x4*)(A.out + O_Y + (size_t)row * 1024) + lane;
#pragma unroll
        for (int j = 0; j < 4; ++j) { f32x4 v = y[64 * j]; v = v * rstd * g[j]; y[64 * j] = v; }
    }
}

template <int K, class Epi>
__device__ __forceinline__ void mini_gemm_unit(LAS unsigned char* lds, const bf16* A, int lda, const bf16* Bt, int rowblk, int colblk, const Epi& E, int tid, int lane, int wave) {
    const int row0 = rowblk * 128 + wave * 16, fr = lane & 15, fq = lane >> 4, col0 = colblk * 32;
    constexpr int BP = K * 2 + 16, CPR = K / 8;
    __syncthreads();
#pragma unroll
    for (int i = 0; i < 32 * CPR / 512; ++i) { const int q = tid + 512 * i, c = q / CPR, ch = q % CPR;
        *(LAS u32x4*)(lds + c * BP + ch * 16) = *(const u32x4*)(Bt + (size_t)(col0 + c) * K + ch * 8); }
    const bf16* a = A + (size_t)(row0 + fr) * lda + 8 * fq;
    LAS const unsigned char* b0 = lds + fr * BP + 16 * fq;
    __syncthreads();
    f32x4 c0 = {0.f, 0.f, 0.f, 0.f}, c1 = {0.f, 0.f, 0.f, 0.f};
#pragma unroll 8
    for (int s = 0; s < K / 32; ++s) {
        const bf16x8 av = *(const bf16x8*)(a + 32 * s), bv0 = *(LAS const bf16x8*)(b0 + 64 * s), bv1 = *(LAS const bf16x8*)(b0 + 16 * BP + 64 * s);
        c0 = __builtin_amdgcn_mfma_f32_16x16x32_bf16(av, bv0, c0, 0, 0, 0);
        c1 = __builtin_amdgcn_mfma_f32_16x16x32_bf16(av, bv1, c1, 0, 0, 0);
    }
    E(row0 + 4 * fq, col0 + fr, colblk, c0, c1, fr);
}
struct EpiNgl { unsigned char* ws;
    __device__ __forceinline__ void operator()(int r0, int col, int cb, const f32x4& c0, const f32x4& c1, int fr) const {
        float* gl = (float*)(ws + WS_GL);
#pragma unroll
        for (int i = 0; i < 4; ++i) { gl[(size_t)(r0 + i) * 32 + col] = sigmoidf_(c0[i]); gl[(size_t)(r0 + i) * 32 + col + 16] = sigmoidf_(c1[i]); } } };
struct DEpiPle { unsigned char* ws;
    __device__ __forceinline__ void operator()(int r0, int col, int cb, const f32x4& c0, const f32x4& c1, int fr) const {
#pragma unroll
        for (int i = 0; i < 4; ++i) { bf16* d = (bf16*)(ws + WS_PPO) + (size_t)(NP + r0 + i) * 1024 + col; d[0] = (bf16)f2bf(c0[i]); d[16] = (bf16)f2bf(c1[i]); } } };
struct DEpiOut { unsigned char* ws; const float* xs;
    __device__ __forceinline__ void operator()(int r0, int col, int cb, const f32x4& c0, const f32x4& c1, int fr) const {
#pragma unroll
        for (int i = 0; i < 4; ++i) { const size_t rd = r0 + i, row = NP + rd;
            const float a = xs[rd * 1024 + col] + c0[i], c = xs[rd * 1024 + col + 16] + c1[i];
            bf16* db = (bf16*)(ws + WS_X1B) + row * 1024 + col; db[0] = (bf16)f2bf(a); db[16] = (bf16)f2bf(c);
            const float ss = red16(a * a + c * c);
            if (fr == 0) ((float*)(ws + WS_SS1D))[rd * 32 + cb] = ss; } } };
struct DEpiGate { unsigned char* ws; float* out; const float* nf;
    __device__ __forceinline__ void operator()(int r0, int col, int cb, const f32x4& c0, const f32x4& c1, int fr) const {
        float va[4], vc[4];
#pragma unroll
        for (int i = 0; i < 4; ++i) { const size_t rd = r0 + i, row = NP + rd;
            const float* sp = (const float*)(ws + WS_SS1D) + rd * 32;
            const float tot = red16(sp[fr] + sp[16 + fr]), rstd = 1.f / sqrtf(tot * (1.f / 1024.f) + RMS_EPS);
            const bf16* x1 = (const bf16*)(ws + WS_X1B) + row * 1024 + col; const bf16* pp = (const bf16*)(ws + WS_PPO) + row * 1024 + col;
            va[i] = bf2f(x1[0]) + sigmoidf_(rstd * c0[i]) * bf2f(pp[0]); vc[i] = bf2f(x1[16]) + sigmoidf_(rstd * c1[i]) * bf2f(pp[16]);
            const float ss = red16(va[i] * va[i] + vc[i] * vc[i]);
            if (fr == 0) __hip_atomic_store((float*)(ws + WS_SS2D) + rd * 32 + cb, ss, __ATOMIC_RELAXED, __HIP_MEMORY_SCOPE_AGENT); }
        panel_meet((unsigned*)(ws + WS_CTL) + 32768 + 64 * (r0 >> 7), 32u, (int)threadIdx.x);
#pragma unroll
        for (int i = 0; i < 4; ++i) { const size_t rd = r0 + i, row = NP + rd;
            float* sp = (float*)(ws + WS_SS2D) + rd * 32;
            const float tot = red16(__hip_atomic_load(sp + fr, __ATOMIC_RELAXED, __HIP_MEMORY_SCOPE_AGENT) + __hip_atomic_load(sp + 16 + fr, __ATOMIC_RELAXED, __HIP_MEMORY_SCOPE_AGENT));
            const float rstd2 = 1.f / sqrtf(tot * (1.f / 1024.f) + RMS_EPS);
            float* d = out + O_Y + row * 1024 + col; d[0] = va[i] * rstd2 * nf[col]; d[16] = vc[i] * rstd2 * nf[col + 16]; } } };

constexpr int N_PHASES = 7;
#ifndef REP_PHASE
#define REP_PHASE -1
#endif
#ifndef MK_SINGLE
#define MK_SINGLE 1
#endif
__global__ void __launch_bounds__(512, 2) mega_fwd(Args args) {
    extern __shared__ __attribute__((aligned(16))) unsigned char lds_raw[];
    LAS unsigned char* lds = (LAS unsigned char*)lds_raw;
    const int tid = threadIdx.x, lane = tid & 63, wave = __builtin_amdgcn_readfirstlane(tid >> 6);
    volatile LAS unsigned* MISC = (volatile LAS unsigned*)(lds + MISC_OFF);
    if (tid < 64) MISC[tid] = 0u;
    __syncthreads();
    const int lo = args.ph_lo, hi = args.ph_hi;
    XcdBarrier bar; bar.bar = (unsigned*)(args.ws + WS_CTL) + CW_BAR; bar.x = 0; bar.st = nullptr;
    if (hi - lo > 1) bar = xcd_barrier_post((unsigned*)(args.ws + WS_CTL) + CW_BAR, MISC + 8);
#ifndef PH_MASK
#define PH_MASK 0xFF
#endif
#define IN(k) (((PH_MASK >> (k)) & 1) && lo <= (k) && (k) < hi)
#define SEAM(k) do { if (IN(k) && IN((k) + 1)) xcd_barrier(bar); } while (0)
    unsigned char* ws = args.ws;
    const int G = gridDim.x, bx = blockIdx.x;
#ifndef STAMP_A
#define STAMP_A -1
#define STAMP_B -1
#endif
#define STAMP(k) do { if (STAMP_A >= 0 && tid == 0) { const unsigned long long t_ = __builtin_amdgcn_s_memrealtime(); MISC[16 + 2 * (k)] = (unsigned)t_; MISC[17 + 2 * (k)] = (unsigned)(t_ >> 32); } } while (0)
    STAMP(0);

    if (IN(0)) { phase0(args, lds, tid, lane, wave); }
    SEAM(0); STAMP(1);
    if (IN(1)) {
#ifndef P1_REP_PARTS
#define P1_REP_PARTS 7
#endif
        const int p1m = args.rep ? P1_REP_PARTS : 7;
        const bool cfirst = (bx & 1) != 0;
        if (cfirst) { if (p1m & 4) for (int u = bx; u < 512; u += G) compress_unit<true>(args, lds, u, tid, lane, wave); }
        __syncthreads();
        if (p1m & 1) { pg8::Gemm g{(const pg8::bf16_t*)(ws + WS_H), (const pg8::bf16_t*)(ws + WS_WINT), NTOK, NPR, DM}; pg8::StaticOrder S; S.init(NTOK, NPR, G, bx);
          EpiInProj E{ws, args.out};
          pg8::gemm_phase<EpiInProj, pg8::StaticOrder, true, true>(lds, g, S, E); }
        if (p1m & 2) {
            const int nun = (NTOK / 256) * (NPR / 256), fl = (nun % G) ? (nun % G) : 0, nl = G - fl;
            if (bx >= fl) for (int u = bx - fl; u < NTOK / 128; u += nl) { EpiNgl E{ws}; mini_gemm_unit<1024>(lds, (const bf16*)(ws + WS_H), 1024, (const bf16*)(ws + WS_WNGLT), u, 0, E, tid, lane, wave); } }
        if (!cfirst) { if (p1m & 4) for (int u = bx; u < 512; u += G) compress_unit<true>(args, lds, u, tid, lane, wave); }
    }
    SEAM(1); STAMP(2);
    if (IN(2)) {
#ifndef P2_REP_PARTS
#define P2_REP_PARTS 15
#endif
        const int p2m = args.rep ? P2_REP_PARTS : 15;
        const int GW = (G > 32) ? G - 16 : G; const bool worker = bx < GW;
        if ((p2m & 1) && worker) { int kple = 256; asm volatile("" : "+s"(kple));
          pg8::Gemm g{(const pg8::bf16_t*)(ws + WS_PB), (const pg8::bf16_t*)(ws + WS_WPLET), NP, 1024, kple}; pg8::StaticOrder S; S.init(NP, 1024, GW, (bx + GW - 128) % GW);
          EpiPle E{ws};
          pg8::gemm_phase<EpiPle, pg8::StaticOrder, true, true>(lds, g, S, E); }
        for (int u = G - 17 - bx; u >= 0 && u < 64; u += G) { DEpiPle E{ws}; mini_gemm_unit<256>(lds, (const bf16*)(ws + WS_PB) + (size_t)NP * 256, 256, (const bf16*)(ws + WS_WPLET), u >> 5, u & 31, E, tid, lane, wave); }
        if (p2m & 2) for (int u = G - 1 - bx; u < 16; u += G) compress_unit<false>(args, lds, u, tid, lane, wave);
        if ((p2m & 4) && worker) for (int u = (bx + GW - 144) % GW; u < 512; u += GW) ret_pass1_unit(ws, lds, u, tid, lane, wave);
        if (p2m & 8) for (int u = bx; u < 128; u += G) ret_decode_unit(args, lds, u, tid, lane, wave);
    }
    SEAM(2); STAMP(3);
    if (IN(3)) {
#ifndef P3_REP_PARTS
#define P3_REP_PARTS 7
#endif
        const int p3m = args.rep ? P3_REP_PARTS : 7;
        if (p3m & 1) ret_pass2(args, tid);
        const bool dfirst = ((bx >> 5) & 1) != 0;
        if (dfirst && (p3m & 4)) for (int u = bx; u < 512; u += G) { const int w = u & 255, grp = (w & 7) + 8 * (w >> 5), tt = 2 * ((w >> 3) & 3) + (u >> 8);
            nsa_decode_unit(args, lds, grp * 8 + tt, tid, lane, wave); }
        if (p3m & 2) for (int pi = bx; pi < 512; pi += G) { const int pr = pi & 255, b = (pr & 7) >> 1, kvh = pr & 1, s = pr >> 3;
            nsa_prompt_unit(args, lds, b, kvh, (pi >= 256) ? s : 63 - s, tid, lane, wave); }
        if (!dfirst && (p3m & 4)) for (int u = bx; u < 512; u += G) { const int w = u & 255, grp = (w & 7) + 8 * (w >> 5), tt = 2 * ((w >> 3) & 3) + (u >> 8);
            nsa_decode_unit(args, lds, grp * 8 + tt, tid, lane, wave); }
    }
    SEAM(3); STAMP(4);
    if (IN(4)) {
        for (int u = bx; u < 512; u += G) ret_pass3_unit(args, lds, u, tid, lane, wave);
        for (int u = G - 1 - bx; u < 64; u += G) { DEpiOut E{ws, (const float*)args.in[I_XS]}; mini_gemm_unit<1024>(lds, (const bf16*)(ws + WS_YMIX) + (size_t)NP * 1024, 1024, (const bf16*)(ws + WS_WOUTT), u >> 5, u & 31, E, tid, lane, wave); }
    }
    SEAM(4); STAMP(5);
    if (IN(5)) {
        pg8::Gemm g{(const pg8::bf16_t*)(ws + WS_YMIX), (const pg8::bf16_t*)(ws + WS_WOUTT), NP, 1024, 1024}; pg8::StaticOrder S; S.init(NP, 1024, G, bx);
        EpiOut E{ws, (const float*)args.in[I_XP], (const float*)args.in[I_XS]};
        pg8::gemm_phase<EpiOut, pg8::StaticOrder, true, true>(lds, g, S, E);
        for (int u = G - 1 - bx; u < 64; u += G) { DEpiGate E2{ws, args.out, (const float*)args.in[I_NF]}; mini_gemm_unit<1024>(lds, (const bf16*)(ws + WS_X1B) + (size_t)NP * 1024, 1024, (const bf16*)(ws + WS_WGT), u >> 5, u & 31, E2, tid, lane, wave); }
    }
    SEAM(5); STAMP(6);
    if (IN(6)) {
        pg8::Gemm g{(const pg8::bf16_t*)(ws + WS_X1B), (const pg8::bf16_t*)(ws + WS_WGT), NP, 1024, 1024}; pg8::StaticOrder S; S.init(NP, 1024, G, bx);
        EpiGateNorm E{ws, args.out, (const float*)args.in[I_NF]};
        pg8::gemm_phase<EpiGateNorm, pg8::StaticOrder, true, true>(lds, g, S, E);
    }
    if (STAMP_A >= 0) { STAMP(8); if (bx == 0 && tid == 0) {
        const unsigned a0 = MISC[16 + 2 * STAMP_A], a1 = MISC[16 + 2 * (STAMP_A + 1)], b0 = MISC[16 + 2 * STAMP_B], b1 = MISC[16 + 2 * (STAMP_B + 1)];
        __builtin_amdgcn_s_waitcnt(0);
        args.out[O_Y] = 10.f * (float)(a1 - a0); args.out[O_Y + (size_t)NP * 1024] = 10.f * (float)(b1 - b0); } }
#undef IN
#undef SEAM
}

extern "C" void kernel_launch(void* const* d_in, const int* in_sizes, int n_in, void* d_out, int out_size, void* d_ws, size_t ws_size, hipStream_t stream) {
    static int grid = 0;
    if (grid == 0) {
        if (n_in != N_IN || out_size != (int)O_END || ws_size < WS_END) { fprintf(stderr, "kernel_launch: unexpected shapes (n_in %d, out %d, ws %zu); nothing launched\n", n_in, out_size, ws_size); grid = -1; return; }
        int dev = 0, cus = 0, per_cu = 0;
        if (hipGetDevice(&dev) != hipSuccess || hipDeviceGetAttribute(&cus, hipDeviceAttributeMultiprocessorCount, dev) != hipSuccess) { grid = -1; return; }
        if (hipFuncSetAttribute((const void*)mega_fwd, hipFuncAttributeMaxDynamicSharedMemorySize, LDS_BYTES) != hipSuccess) { fprintf(stderr, "kernel_launch: hipFuncSetAttribute failed\n"); grid = -1; return; }
        if (hipOccupancyMaxActiveBlocksPerMultiprocessor(&per_cu, (const void*)mega_fwd, 512, LDS_BYTES) != hipSuccess || per_cu < 1) { fprintf(stderr, "kernel_launch: occupancy query says %d blocks per CU\n", per_cu); }
        (void)hipGetLastError();
        grid = cus;
    }
    if (grid < 0) return;
    (void)hipMemsetAsync((char*)d_ws + WS_CTL, 0, CTL_ZERO_BYTES, stream);
    Args a{};
    for (int i = 0; i < N_IN; ++i) a.in[i] = d_in[i];
    a.out = (float*)d_out; a.ws = (unsigned char*)d_ws;
    a.rep = 0; a.pad = 0;
#if MK_SINGLE
    a.ph_lo = 0; a.ph_hi = N_PHASES;
    hipLaunchKernelGGL(mega_fwd, dim3(grid), dim3(512), LDS_BYTES, stream, a);
#else
    for (int p = 0; p < N_PHASES; ++p) { a.ph_lo = p; a.ph_hi = p + 1;
        for (int r = 0; r < ((p == REP_PHASE) ? 2 : 1); ++r) { a.rep = r; hipLaunchKernelGGL(mega_fwd, dim3(grid), dim3(512), LDS_BYTES, stream, a); } }
#endif
}
```

```cpp
#include <hip/hip_runtime.h>
#include <cstdio>
#include <cstdint>
namespace pg8 {
#define PG8_LAS __attribute__((address_space(3)))
typedef unsigned short bf16_t;
typedef short bf16x8 __attribute__((ext_vector_type(8)));
typedef float f32x4 __attribute__((ext_vector_type(4)));
typedef unsigned u32x4 __attribute__((ext_vector_type(4)));
constexpr int BM = 256, BK = 64, HALF = 128, HTB = HALF * BK * 2  , STAGE_BYTES = 8 * HTB, NXCD = 8, WGM = 8;

__host__ __device__ __forceinline__ int lds_byte(int r, int c) { const int st = (r >> 4) * 2 + (c >> 5), rr = r & 15, cc = c & 31, ob = rr * 64 + cc * 2; return st * 1024 + (ob ^ (((ob >> 9) & 1) << 5)); }
__host__ __device__ __forceinline__ void stage_rc(int b, int& R, int& C) { const int st = b / 1024, sb = b % 1024, swz = sb ^ (((sb >> 9) & 1) << 5); R = (st >> 1) * 16 + swz / 64; C = (st & 1) * 32 + (swz % 64) / 2; }
__host__ __device__ __forceinline__ int perm32(int rho) { const int n = rho >> 4, i = rho & 15; return 8 * (i >> 2) + 4 * n + (i & 3); }

struct Unit { int pm, pn; };
struct Gemm { const bf16_t* A; const bf16_t* Bt; int M, N, K; };

struct StaticOrder {
    int nM, nN, nwg, G, c;
    __host__ __device__ void init(int M, int N, int G_, int c_) { nM = M / BM; nN = N / BM; nwg = nM * nN; G = G_; c = c_; }
    __host__ __device__ bool next(int i, Unit& u) const {
        const long L = (long)i * G + c; if (L >= nwg) return false;
        int wgid = (int)L; { const int q = nwg / NXCD, r = nwg % NXCD, xcd = wgid % NXCD, off = wgid / NXCD; wgid = (xcd < r ? xcd * (q + 1) : r * (q + 1) + (xcd - r) * q) + off; }
        const int nig = WGM * nN, gid = wgid / nig, fm = gid * WGM, gsz = (nM - fm) < WGM ? (nM - fm) : WGM;
        u.pm = fm + ((wgid % nig) % gsz); u.pn = (wgid % nig) / gsz; return true;
    }
    __device__ __forceinline__ void a_ready(const Unit&) const {}
    __device__ __forceinline__ void done(const Unit&) const {}
};
template <class Epi, class Sched, bool ALIGN_EPI = false, bool SP2 = false>
__device__ __forceinline__ void gemm_phase(PG8_LAS unsigned char* lds, const Gemm g, const Sched& S, const Epi& E) {
    const int tid = threadIdx.x, wid = __builtin_amdgcn_readfirstlane(tid >> 6), lane = tid & 63, wr = wid >> 2, wc = wid & 3, fr = lane & 15, fq = lane >> 4;
    const int K = g.K, nt = K / BK;
    unsigned voffA[2], voffB[2];
#pragma unroll
    for (int i = 0; i < 2; ++i) { int R, C; stage_rc(tid * 16 + i * 8192, R, C); const int Rb = Epi::PERM ? ((R & ~31) + perm32(R & 31)) : R;
        voffA[i] = (unsigned)(R * K + C) * 2u; voffB[i] = (unsigned)(Rb * K + C) * 2u; }
    const size_t kstep = (size_t)(BK * 2);
    const size_t hstep = (size_t)HALF * K * 2;
    const size_t tstep = 2 * hstep;
    const unsigned ldsw = (unsigned)wid * 1024u;
    const int aoff = lds_byte(wr * 64 + fr, fq * 8), boff = lds_byte(wc * 32 + fr, fq * 8);
#define PG8_SA(b, h) (((b) * 2 + (h)) * HTB)
#define PG8_SB(b, h) ((4 + (b) * 2 + (h)) * HTB)
#define PG8_STAGE(bufoff, gbase, voff) do { _Pragma("unroll") for (int _i = 0; _i < 2; ++_i) \
        __builtin_amdgcn_global_load_lds((const unsigned*)((const char*)(gbase) + (voff)[_i]), (PG8_LAS unsigned*)(lds + (bufoff) + ldsw + _i * 8192), 16, 0, 0); } while (0)
#define PG8_LDA(dst, b, h) do { _Pragma("unroll") for (int m = 0; m < 4; ++m) _Pragma("unroll") for (int k = 0; k < 2; ++k) dst[m][k] = *(const PG8_LAS bf16x8*)(lds + PG8_SA(b, h) + aoff + m * 2048 + k * 1024); } while (0)
#define PG8_LDB(dst, b, h) do { _Pragma("unroll") for (int n = 0; n < 2; ++n) _Pragma("unroll") for (int k = 0; k < 2; ++k) dst[n][k] = *(const PG8_LAS bf16x8*)(lds + PG8_SB(b, h) + boff + n * 2048 + k * 1024); } while (0)
#define PG8_MMA(ai, bj, At, Bt) do { __builtin_amdgcn_s_setprio(1); _Pragma("unroll") for (int m = 0; m < 4; ++m) _Pragma("unroll") for (int n = 0; n < 2; ++n) _Pragma("unroll") for (int k = 0; k < 2; ++k) \
        acc[ai][bj][m][n] = __builtin_amdgcn_mfma_f32_16x16x32_bf16(Bt[n][k], At[m][k], acc[ai][bj][m][n], 0, 0, 0); __builtin_amdgcn_s_setprio(0); } while (0)
#define PG8_WAIT_V(n) asm volatile("s_waitcnt vmcnt(" #n ")" ::: "memory")
#define PG8_WAIT_L(n) asm volatile("s_waitcnt lgkmcnt(" #n ")" ::: "memory")
#define PG8_BAR __builtin_amdgcn_s_barrier()
#define PG8_SCHED __builtin_amdgcn_sched_barrier(0)
    Unit cur, nxt; int ui = 0;
    if (!S.next(0, cur)) return;
    f32x4 acc[2][2][4][2];
#pragma unroll
    for (int a = 0; a < 2; ++a)
#pragma unroll
        for (int b = 0; b < 2; ++b)
#pragma unroll
            for (int m = 0; m < 4; ++m)
#pragma unroll
                for (int n = 0; n < 2; ++n) acc[a][b][m][n] = (f32x4){0.f, 0.f, 0.f, 0.f};
    bf16x8 At[4][2], B0[2][2], B1[2][2];
    const char* cA = (const char*)g.A + (size_t)cur.pm * tstep; const char* cB = (const char*)g.Bt + (size_t)cur.pn * tstep;
    S.a_ready(cur);
    if constexpr (SP2) {
        PG8_STAGE(PG8_SB(0, 0), cB, voffB); PG8_STAGE(PG8_SB(0, 1), cB + hstep, voffB); PG8_STAGE(PG8_SA(0, 0), cA, voffA); PG8_STAGE(PG8_SA(0, 1), cA + hstep, voffA);
        if (wr == 1) PG8_BAR;
        PG8_WAIT_V(2); PG8_BAR;
        PG8_STAGE(PG8_SB(1, 0), cB + kstep, voffB); PG8_STAGE(PG8_SA(1, 0), cA + kstep, voffA); PG8_STAGE(PG8_SB(1, 1), cB + hstep + kstep, voffB);
        PG8_WAIT_V(6); PG8_BAR;
    } else {
        PG8_STAGE(PG8_SB(0, 0), cB, voffB); PG8_STAGE(PG8_SA(0, 0), cA, voffA); PG8_STAGE(PG8_SB(0, 1), cB + hstep, voffB); PG8_STAGE(PG8_SA(0, 1), cA + hstep, voffA);
        if (wr == 1) PG8_BAR;
        PG8_WAIT_V(4); PG8_BAR;
        PG8_STAGE(PG8_SB(1, 0), cB + kstep, voffB); PG8_STAGE(PG8_SA(1, 0), cA + kstep, voffA); PG8_STAGE(PG8_SB(1, 1), cB + hstep + kstep, voffB);
        PG8_WAIT_V(6); PG8_BAR;
    }
    for (;;) {
        const bool has_next = S.next(ui + 1, nxt);
        const char* nA = has_next ? (const char*)g.A + (size_t)nxt.pm * tstep : cA; const char* nB = has_next ? (const char*)g.Bt + (size_t)nxt.pn * tstep : cB;
        for (int t = 0; t < nt; t += 2) {
            const bool last = (t == nt - 2);
            const char* a1 = cA + (size_t)(t + 1) * kstep;
            const char* a2 = last ? nA : cA + (size_t)(t + 2) * kstep; const char* b2 = last ? nB : cB + (size_t)(t + 2) * kstep;
            const char* a3 = a2 + kstep; const char* b3 = b2 + kstep;
            if (last && has_next) S.a_ready(nxt);
            if constexpr (SP2) {
            PG8_LDB(B0, 0, 0); PG8_LDB(B1, 0, 1); PG8_SCHED; PG8_LDA(At, 0, 0); PG8_STAGE(PG8_SA(1, 1), a1 + hstep, voffA);
            PG8_WAIT_V(8); PG8_WAIT_L(0); PG8_BAR; PG8_MMA(0, 0, At, B0); PG8_MMA(0, 1, At, B1); PG8_BAR; PG8_SCHED;
            PG8_LDA(At, 0, 1); PG8_STAGE(PG8_SB(0, 0), b2, voffB); PG8_STAGE(PG8_SB(0, 1), b2 + hstep, voffB); PG8_STAGE(PG8_SA(0, 0), a2, voffA);
            PG8_WAIT_V(8); PG8_WAIT_L(0); PG8_BAR; PG8_MMA(1, 0, At, B0); PG8_MMA(1, 1, At, B1); PG8_BAR; PG8_SCHED;
            PG8_LDB(B0, 1, 0); PG8_LDB(B1, 1, 1); PG8_SCHED; PG8_LDA(At, 1, 0); PG8_STAGE(PG8_SA(0, 1), a2 + hstep, voffA);
            PG8_WAIT_V(8); PG8_WAIT_L(0); PG8_BAR; PG8_MMA(0, 0, At, B0); PG8_MMA(0, 1, At, B1); PG8_BAR; PG8_SCHED;
            PG8_LDA(At, 1, 1); PG8_STAGE(PG8_SB(1, 0), b3, voffB); PG8_STAGE(PG8_SB(1, 1), b3 + hstep, voffB); PG8_STAGE(PG8_SA(1, 0), a3, voffA);
            PG8_WAIT_V(8); PG8_WAIT_L(0); PG8_BAR; PG8_MMA(1, 0, At, B0); PG8_MMA(1, 1, At, B1); PG8_BAR; PG8_SCHED;
            } else {
            PG8_LDB(B0, 0, 0); PG8_SCHED; PG8_LDA(At, 0, 0); PG8_STAGE(PG8_SA(1, 1), a1 + hstep, voffA);
            PG8_WAIT_L(8); PG8_BAR; PG8_WAIT_L(0); PG8_MMA(0, 0, At, B0); PG8_BAR; PG8_SCHED;
            PG8_LDB(B1, 0, 1); PG8_STAGE(PG8_SB(0, 0), b2, voffB);
            PG8_BAR; PG8_WAIT_L(0); PG8_MMA(0, 1, At, B1); PG8_BAR;
            PG8_LDA(At, 0, 1); PG8_STAGE(PG8_SA(0, 0), a2, voffA);
            PG8_BAR; PG8_WAIT_L(0); PG8_MMA(1, 0, At, B0); PG8_BAR; PG8_SCHED;
            PG8_STAGE(PG8_SB(0, 1), b2 + hstep, voffB);
            PG8_WAIT_V(6); PG8_BAR; PG8_MMA(1, 1, At, B1); PG8_BAR;
            PG8_LDB(B0, 1, 0); PG8_SCHED; PG8_LDA(At, 1, 0); PG8_STAGE(PG8_SA(0, 1), a2 + hstep, voffA);
            PG8_WAIT_L(8); PG8_BAR; PG8_WAIT_L(0); PG8_MMA(0, 0, At, B0); PG8_BAR; PG8_SCHED;
            PG8_LDB(B1, 1, 1); PG8_STAGE(PG8_SB(1, 0), b3, voffB);
            PG8_BAR; PG8_WAIT_L(0); PG8_MMA(0, 1, At, B1); PG8_BAR;
            PG8_LDA(At, 1, 1); PG8_STAGE(PG8_SA(1, 0), a3, voffA);
            PG8_BAR; PG8_WAIT_L(0); PG8_MMA(1, 0, At, B0); PG8_BAR; PG8_SCHED;
            PG8_STAGE(PG8_SB(1, 1), b3 + hstep, voffB);
            PG8_WAIT_V(6); PG8_BAR; PG8_MMA(1, 1, At, B1); PG8_BAR;
            }
        }
        if constexpr (ALIGN_EPI) { if (wr == 0) PG8_BAR; }
        if constexpr (!Epi::AFTER_DRAIN) { E(acc, cur, wr, wc, fr, fq); S.done(cur); }
        if (!has_next) break;
#pragma unroll
        for (int a = 0; a < 2; ++a)
#pragma unroll
            for (int b = 0; b < 2; ++b)
#pragma unroll
                for (int m = 0; m < 4; ++m)
#pragma unroll
                    for (int n = 0; n < 2; ++n) acc[a][b][m][n] = (f32x4){0.f, 0.f, 0.f, 0.f};
        cur = nxt; cA = nA; cB = nB; ++ui;
        if constexpr (ALIGN_EPI) { if (wr == 1) PG8_BAR; }
    }
    PG8_WAIT_V(0);
    if constexpr (!ALIGN_EPI) { if (wr == 0) PG8_BAR; }
    PG8_BAR;
    if constexpr (Epi::AFTER_DRAIN) { E.fused(acc, cur, wr, wc, fr, fq, lds, wid, lane); S.done(cur); }
#undef PG8_SA
#undef PG8_SB
#undef PG8_STAGE
#undef PG8_LDA
#undef PG8_LDB
#undef PG8_MMA
#undef PG8_WAIT_V
#undef PG8_WAIT_L
#undef PG8_BAR
#undef PG8_SCHED
}
}

#define GAS __attribute__((address_space(1)))
#define LAS __attribute__((address_space(3)))
typedef unsigned short bf16;
typedef short bf16x8 __attribute__((ext_vector_type(8)));
typedef short s16x4 __attribute__((ext_vector_type(4)));
typedef float f32x2 __attribute__((ext_vector_type(2)));
typedef float f32x4 __attribute__((ext_vector_type(4)));
typedef float f32x16 __attribute__((ext_vector_type(16)));
typedef unsigned u32x2 __attribute__((ext_vector_type(2)));
typedef unsigned u32x4 __attribute__((ext_vector_type(4)));
typedef __bf16 bf16x2_t __attribute__((ext_vector_type(2)));

constexpr int NP = 16384, ND = 256, NTOK = NP + ND;
constexpr int SEQ = 4096, NBATCH = 4, DBATCH = 32, DSEQ = 8, PAST = 16384;
constexpr int DM = 1024, NPR = 3840, PROJW = 3864;
constexpr int NPOS = SEQ + DSEQ;
constexpr float C2 = 0.125f * 1.4426950408889634f;
constexpr float RMS_EPS = 1e-6f, GN_EPS = 1e-5f;
constexpr float NEGBIG = -1e30f, MINIT = -1e4f;

constexpr size_t O_Y = 0;
constexpr size_t O_RETP = (size_t)NTOK * 1024;
constexpr size_t O_CMPK_P = O_RETP + 4 * 4 * 128 * 128;
constexpr size_t O_CMPV_P = O_CMPK_P + (size_t)NP * 128;
constexpr size_t O_SLCK_P = O_CMPV_P + (size_t)NP * 128;
constexpr size_t O_SLCV_P = O_SLCK_P + (size_t)NP * 128;
constexpr size_t O_WINK_P = O_SLCV_P + (size_t)NP * 128;
constexpr size_t O_WINV_P = O_WINK_P + 4 * 512 * 128;
constexpr size_t O_RETS = O_WINV_P + 4 * 512 * 128;
constexpr size_t O_CMPK_S = O_RETS + (size_t)32 * 4 * 128 * 128;
constexpr size_t O_CMPV_S = O_CMPK_S + ND * 128;
constexpr size_t O_SLCK_S = O_CMPV_S + ND * 128;
constexpr size_t O_SLCV_S = O_SLCK_S + ND * 128;
constexpr size_t O_WINK_S = O_SLCV_S + ND * 128;
constexpr size_t O_WINV_S = O_WINK_S + (size_t)32 * 512 * 128;
constexpr size_t O_END = O_WINV_S + (size_t)32 * 512 * 128;
static_assert(O_END == 32636928, "output size");

enum { I_XP = 0, I_XS, I_CCK, I_CCV, I_CSK, I_CSV, I_SWK, I_SWV, I_SRET, I_PT, I_PP, I_PS, I_NMIX, I_WIN, I_GNG, I_GNB, I_PEK, I_W1K, I_W2K, I_PEV, I_W1V, I_W2V, I_WOUT, I_NPLE, I_WG, I_WPLE, I_NF, N_IN };

constexpr size_t MiB = 1u << 20;
constexpr size_t WS_CTL = 0, CTL_ZERO_BYTES = 1 * MiB;
constexpr size_t WS_COSR = 1 * MiB;
constexpr size_t WS_SINR = WS_COSR + (size_t)NPOS * 64 * 4;
constexpr size_t WS_COSN = WS_SINR + (size_t)NPOS * 64 * 4;
constexpr size_t WS_SINN = WS_COSN + (size_t)NPOS * 32 * 4;
constexpr size_t WS_CBIAS = 5 * MiB;
constexpr size_t WS_W2T = WS_CBIAS + 65536;
constexpr size_t WS_W1T = 6 * MiB;
constexpr size_t WS_WINT = 8 * MiB;
constexpr size_t WS_WNGLT = 16 * MiB;
constexpr size_t WS_WOUTT = 17 * MiB;
constexpr size_t WS_WGT = 19 * MiB;
constexpr size_t WS_WPLET = 21 * MiB;
constexpr size_t WS_H = 24 * MiB;
constexpr size_t WS_PB = 57 * MiB;
constexpr size_t WS_QR = 66 * MiB, WS_KR = 83 * MiB, WS_VR = 100 * MiB, WS_RG = 117 * MiB, WS_QN = 134 * MiB, WS_QROT = 151 * MiB, WS_NG = 168 * MiB;
constexpr size_t WS_KS = 185 * MiB, WS_VS = 190 * MiB, WS_KW = 195 * MiB, WS_VW = 200 * MiB;
constexpr size_t WS_GL = 205 * MiB;
constexpr size_t WS_KCP = 208 * MiB, WS_VCP = WS_KCP + 131072;
constexpr size_t WS_KCS = 209 * MiB, WS_VCS = 217 * MiB;
constexpr size_t WS_KVT = 225 * MiB;
constexpr size_t WS_ST = 257 * MiB;
constexpr size_t WS_YMIX = 273 * MiB;
constexpr size_t WS_X1 = 306 * MiB;
constexpr size_t WS_X1B = 371 * MiB;
constexpr size_t WS_PPO = 404 * MiB;
constexpr size_t WS_SS1 = 469 * MiB;
constexpr size_t WS_SS2 = 471 * MiB;
constexpr size_t WS_SS1D = 473 * MiB, WS_SS2D = WS_SS1D + 65536;
constexpr size_t WS_END = 474 * MiB;
constexpr int CW_BAR = 4096;

constexpr int LDS_BYTES = 147456;
constexpr int MISC_OFF = LDS_BYTES - 256;

#define CM(col, row) (((size_t)((col) >> 3) * NTOK + (size_t)(row)) * 8 + ((col) & 7))
struct Args { const void* in[N_IN]; float* out; unsigned char* ws; int ph_lo, ph_hi, rep, pad; };

__device__ __forceinline__ unsigned f2bf(float f) { unsigned u = __builtin_bit_cast(unsigned, f); return (u + 0x7fffu + ((u >> 16) & 1u)) >> 16; }
__device__ __forceinline__ unsigned pk2(float lo, float hi) { f32x2 v = {lo, hi}; bf16x2_t b = __builtin_convertvector(v, bf16x2_t); return __builtin_bit_cast(unsigned, b); }
__device__ __forceinline__ float bflo(unsigned u) { return __builtin_bit_cast(float, u << 16); }
__device__ __forceinline__ float bfhi(unsigned u) { return __builtin_bit_cast(float, u & 0xffff0000u); }
__device__ __forceinline__ float bf2f(bf16 h) { return __builtin_bit_cast(float, (unsigned)h << 16); }
__device__ __forceinline__ u32x4 pack8(const float* v) { u32x4 w; w.x = pk2(v[0], v[1]); w.y = pk2(v[2], v[3]); w.z = pk2(v[4], v[5]); w.w = pk2(v[6], v[7]); return w; }
__device__ __forceinline__ float wave_sum(float v) {
#pragma unroll
    for (int o = 1; o < 64; o <<= 1) v += __shfl_xor(v, o);
    return v;
}
__device__ __forceinline__ float wave_max(float v) {
#pragma unroll
    for (int o = 1; o < 64; o <<= 1) v = fmaxf(v, __shfl_xor(v, o));
    return v;
}
__device__ __forceinline__ void swap32(float& a, float& b) { asm volatile("s_nop 1\n\tv_permlane32_swap_b32 %0, %1\n\ts_nop 1" : "+v"(a), "+v"(b)); }
__device__ __forceinline__ float xor32_sum(float x) { float a = x, b = x; swap32(a, b); return a + b; }
__device__ __forceinline__ float xor32_max(float x) { float a = x, b = x; swap32(a, b); return fmaxf(a, b); }
__device__ __forceinline__ float sigmoidf_(float x) { return __builtin_amdgcn_rcpf(1.f + __builtin_amdgcn_exp2f(-1.4426950408889634f * x)); }
__device__ __forceinline__ float siluf_(float x) { return x * __builtin_amdgcn_rcpf(1.f + __builtin_amdgcn_exp2f(-1.4426950408889634f * x)); }
__device__ __forceinline__ float gelu_tanh(float x) { const float u = 0.7978845608028654f * (x + 0.044715f * x * x * x); const float e = __expf(2.f * u); const float t = 1.f - 2.f / (e + 1.f); return 0.5f * x * (1.f + t); }
__device__ __forceinline__ int crow(int r, int hi) { return (r & 3) + 8 * (r >> 2) + 4 * hi; }
#define LDS_WAIT() asm volatile("s_waitcnt lgkmcnt(0)" ::: "memory")
#define MFMA32(a, b, c) __builtin_amdgcn_mfma_f32_32x32x16_bf16((a), (b), (c), 0, 0, 0)
typedef short v4i16_t __attribute__((ext_vector_type(4)));
__device__ __forceinline__ s16x4 ds_tr(LAS const unsigned char* p) { return __builtin_bit_cast(s16x4, __builtin_amdgcn_ds_read_tr16_b64_v4i16((LAS v4i16_t*)p)); }
__device__ __forceinline__ bf16x8 cat8(s16x4 a, s16x4 b) { return (bf16x8){a[0], a[1], a[2], a[3], b[0], b[1], b[2], b[3]}; }
__device__ __forceinline__ bf16x8 pack_frag(const f32x16& p, int base) {
    u32x4 w; w.x = pk2(p[base + 0], p[base + 1]); w.y = pk2(p[base + 2], p[base + 3]); w.z = pk2(p[base + 4], p[base + 5]); w.w = pk2(p[base + 6], p[base + 7]);
    return __builtin_bit_cast(bf16x8, w);
}
__device__ __forceinline__ float log2g(int h) { return h == 0 ? -0.04580368961312479f : h == 1 ? -0.02272007650008353f : h == 2 ? -0.011315313227834146f : -0.005646563141142063f; }

__device__ __forceinline__ void sincos_d(double a, double& s, double& c) {
    const double q = __builtin_rint(a * 0.63661977236758134308);
    double y = __builtin_fma(-q, 1.57079632679489655800e+00, a); y = __builtin_fma(-q, 6.12323399573676603587e-17, y);
    const int quad = ((int)q) & 3; const double y2 = y * y;
    double sp = -1.0 / 1307674368000.0; sp = sp * y2 + 1.0 / 6227020800.0; sp = sp * y2 - 1.0 / 39916800.0; sp = sp * y2 + 1.0 / 362880.0; sp = sp * y2 - 1.0 / 5040.0; sp = sp * y2 + 1.0 / 120.0; sp = sp * y2 - 1.0 / 6.0; sp = sp * y2 + 1.0; sp *= y;
    double cp = 1.0 / 20922789888000.0; cp = cp * y2 - 1.0 / 87178291200.0; cp = cp * y2 + 1.0 / 479001600.0; cp = cp * y2 - 1.0 / 3628800.0; cp = cp * y2 + 1.0 / 40320.0; cp = cp * y2 - 1.0 / 720.0; cp = cp * y2 + 1.0 / 24.0; cp = cp * y2 - 0.5; cp = cp * y2 + 1.0;
    s = (quad == 0) ? sp : (quad == 1) ? cp : (quad == 2) ? -sp : -cp;
    c = (quad == 0) ? cp : (quad == 1) ? -sp : (quad == 2) ? -cp : sp;
}
__device__ __forceinline__ double ipow_d(double r, int n) { double acc = 1.0;
#pragma unroll
    for (int b = 0; b < 6; ++b) { if (n & (1 << b)) acc *= r; r *= r; } return acc; }

__device__ __forceinline__ int orig_base32(int g32) {
    const int tile = g32 >> 3, gi = g32 & 7, bj = gi >> 2, wq = gi & 3;
    if (tile < 2)  return (2 * tile + (wq >> 1)) * 128 + (wq & 1) * 32 + 64 * bj;
    if (tile < 4)  return 512 + (2 * (tile - 2) + (wq >> 1)) * 128 + (wq & 1) * 32 + 64 * bj;
    if (tile < 6)  return 1024 + (tile - 4) * 256 + gi * 32;
    if (tile < 8)  return 1536 + (tile - 6) * 256 + gi * 32;
    if (tile < 10) return 2048 + (4 * (tile - 8) + wq) * 64 + 32 * bj;
    if (tile == 10) return 2560 + gi * 32;
    if (tile == 11) return ((wq >> 1) ? 3072 : 2816) + (wq & 1) * 64 + 32 * bj;
    if (tile == 12) return (bj ? 3200 : 2944) + wq * 32;
    return 3352 + (tile - 13) * 256 + gi * 32;
}
#define XB_TMO      128
#define XB_XCNT(j)  (256  + 64 * (j))
#define XB_XSUB(j)  (1280 + 64 * (j))
#define XB_XGEN(j)  (2304 + 64 * (j))
#define XB_TOP      3328
#define XB_TOPGEN   3392
#define XCD_BAR_WORDS 3456
#define XB_SPIN_CAP (1u << 18)
#define LAS __attribute__((address_space(3)))

__device__ __forceinline__ unsigned xb_ld(unsigned* p)              { return __hip_atomic_load(p, __ATOMIC_RELAXED, __HIP_MEMORY_SCOPE_AGENT); }
__device__ __forceinline__ unsigned xb_add(unsigned* p, unsigned v) { return __hip_atomic_fetch_add(p, v, __ATOMIC_RELAXED, __HIP_MEMORY_SCOPE_AGENT); }
__device__ __forceinline__ unsigned xb_xcc_id() { return (unsigned)__builtin_amdgcn_s_getreg((3 << 11) | 20) & 0xFu; }
#define XB_SPIN(cond, bar) do { unsigned _sp = 0; while (cond) { __builtin_amdgcn_s_sleep(1); \
    if ((++_sp & 255u) == 0u) { if (xb_ld(&(bar)[XB_TMO])) break; if (_sp > XB_SPIN_CAP) { atomicAdd(&(bar)[XB_TMO], 1u); break; } } } } while (0)

struct XcdBarrier {
    unsigned* bar; unsigned x;
    volatile LAS unsigned* st;
};

__device__ __forceinline__ XcdBarrier xcd_barrier_post(unsigned* bar, volatile LAS unsigned* st) {
    XcdBarrier b; b.bar = bar; b.x = xb_xcc_id(); b.st = st;
    if (threadIdx.x == 0) (void)xb_add(&bar[XB_XCNT(b.x)], 1u);
    return b;
}
__device__ __forceinline__ void xcd_barrier_complete(unsigned* bar, unsigned x, unsigned& nloc, unsigned& nx) {
    const unsigned G = gridDim.x * gridDim.y * gridDim.z;
    unsigned sum, cnt, mine, sp = 0u;
    for (;;) {
        sum = 0u; cnt = 0u; mine = 0u;
#pragma unroll
        for (unsigned j = 0; j < 16; ++j) { const unsigned c = xb_ld(&bar[XB_XCNT(j)]); sum += c; cnt += (c > 0u) ? 1u : 0u; mine = (j == x) ? c : mine; }
        if (sum == G) break;
        __builtin_amdgcn_s_sleep(1);
        if ((++sp & 255u) == 0u) { if (xb_ld(&bar[XB_TMO])) break; if (sp > XB_SPIN_CAP) { atomicAdd(&bar[XB_TMO], 1u); break; } }
    }
    nloc = mine > 0u ? mine : 1u; nx = cnt > 0u ? cnt : 1u;
}

__device__ __forceinline__ void xcd_barrier(const XcdBarrier& b) {
    asm volatile("s_waitcnt vmcnt(0)" ::: "memory");
    __syncthreads();
    if (threadIdx.x == 0) {
        unsigned* bar = b.bar;
        __builtin_amdgcn_s_waitcnt(0);
        unsigned nloc = b.st[0], nx = b.st[1];
        if (nloc == 0u) { xcd_barrier_complete(bar, b.x, nloc, nx); b.st[0] = nloc; b.st[1] = nx; }
        const unsigned old = xb_add(&bar[XB_XSUB(b.x)], 1u);
        const unsigned gen = old / nloc;
        if (old + 1u == (gen + 1u) * nloc) {
            __builtin_amdgcn_fence(__ATOMIC_RELEASE, "agent");
            asm volatile("s_waitcnt vmcnt(0)" ::: "memory");
            const unsigned og = xb_add(&bar[XB_TOP], 1u);
            const unsigned tg = og / nx;
            if (og + 1u == (tg + 1u) * nx) xb_add(&bar[XB_TOPGEN], 1u);
            else XB_SPIN(xb_ld(&bar[XB_TOPGEN]) == tg, bar);
            __builtin_amdgcn_fence(__ATOMIC_ACQUIRE, "agent");
            xb_add(&bar[XB_XGEN(b.x)], 1u);
            asm volatile("s_waitcnt vmcnt(0)" ::: "memory");
        } else {
            XB_SPIN(xb_ld(&bar[XB_XGEN(b.x)]) == gen, bar);
            __builtin_amdgcn_fence(__ATOMIC_ACQUIRE, "agent");
            asm volatile("s_waitcnt vmcnt(0)" ::: "memory");
        }
    }
    __syncthreads();
}

template <bool FRAG = false>
__device__ __forceinline__ void transpose_item(const float* W, int ldw, int k0, int n0, int nvalid, const float* kscale, bf16* WT, int ldt, int drow0, LAS float* scr, int lane) {
    float tv[32];
#pragma unroll
    for (int i = 0; i < 32; ++i) { const int kk = 2 * i + (lane >> 5), c = lane & 31; tv[i] = W[(size_t)(k0 + kk) * ldw + n0 + ((c < nvalid) ? c : 0)]; }
#pragma unroll
    for (int i = 0; i < 32; ++i) { const int kk = 2 * i + (lane >> 5), c = lane & 31; float v = (c < nvalid) ? tv[i] : 0.f; if (kscale) v *= kscale[k0 + kk]; scr[kk * 33 + c] = v; }
    LDS_WAIT(); asm volatile("" ::: "memory");
    const int c8 = lane & 7;
#pragma unroll
    for (int j = 0; j < 4; ++j) { const int n = (lane >> 3) + 8 * j; const LAS float* s = scr + (8 * c8) * 33 + n;
        u32x4 o; o.x = pk2(s[0 * 33], s[1 * 33]); o.y = pk2(s[2 * 33], s[3 * 33]); o.z = pk2(s[4 * 33], s[5 * 33]); o.w = pk2(s[6 * 33], s[7 * 33]);
        if (FRAG) { const int e = drow0 + n, k8 = (k0 >> 3) + c8;
            *(u32x4*)(WT + (size_t)((((k8 >> 4) * 2 + (e >> 5)) * 8 + ((k8 >> 1) & 7)) * 64 + (e & 31) + 32 * (k8 & 1)) * 8) = o; }
        else *(u32x4*)(WT + (size_t)(drow0 + n) * ldt + k0 + 8 * c8) = o; }
    LDS_WAIT(); asm volatile("" ::: "memory");
}

__device__ __forceinline__ void phase0(const Args& A, LAS unsigned char* lds, int tid, int lane, int wave) {
    unsigned char* ws = A.ws;
    const int gw = blockIdx.x * 8 + wave, NGW = gridDim.x * 8;
    const int gt = blockIdx.x * 512 + tid, NGT = gridDim.x * 512;
    LAS float* scr = (LAS float*)(lds + wave * 16384);
    constexpr int I_IN = 16 * 120, I_NGL = 16, I_OUT = 16 * 32, I_G = 16 * 32, I_PLE = 4 * 32, I_W1 = 4 * 64, I_W2 = 4 * 2;
    constexpr int NITEMS = I_IN + I_NGL + I_OUT + I_G + I_PLE + I_W1 + I_W2;
    for (int it = gw; it < NITEMS; it += NGW) {
        int r = it;
        if (r < I_IN) { const int kb = r / 120, g32 = r % 120; transpose_item((const float*)A.in[I_WIN], PROJW, 64 * kb, orig_base32(g32), 32, nullptr, (bf16*)(ws + WS_WINT), 1024, 32 * g32, scr, lane); continue; } r -= I_IN;
        if (r < I_NGL) { transpose_item((const float*)A.in[I_WIN], PROJW, 64 * r, 3328, 24, nullptr, (bf16*)(ws + WS_WNGLT), 1024, 0, scr, lane); continue; } r -= I_NGL;
        if (r < I_OUT) { const int kb = r / 32, nb = r % 32; transpose_item((const float*)A.in[I_WOUT], 1024, 64 * kb, 32 * nb, 32, nullptr, (bf16*)(ws + WS_WOUTT), 1024, 32 * nb, scr, lane); continue; } r -= I_OUT;
        if (r < I_G) { const int kb = r / 32, nb = r % 32; transpose_item((const float*)A.in[I_WG], 1024, 64 * kb, 32 * nb, 32, (const float*)A.in[I_NPLE], (bf16*)(ws + WS_WGT), 1024, 32 * nb, scr, lane); continue; } r -= I_G;
        if (r < I_PLE) { const int kb = r / 32, nb = r % 32; transpose_item((const float*)A.in[I_WPLE], 1024, 64 * kb, 32 * nb, 32, nullptr, (bf16*)(ws + WS_WPLET), 256, 32 * nb, scr, lane); continue; } r -= I_PLE;
        if (r < I_W1) { const int m = r >> 6, q = r & 63, kb = q >> 1, nb = q & 1;
            const float* W = (const float*)A.in[(m >> 1) ? I_W1V : I_W1K] + (size_t)(m & 1) * 2048 * 64;
            transpose_item<true>(W, 64, 64 * kb, 32 * nb, 32, nullptr, (bf16*)(ws + WS_W1T) + (size_t)m * 64 * 2048, 2048, 32 * nb, scr, lane); continue; } r -= I_W1;
        { const int m = r >> 1, nb = r & 1;
            const float* W = (const float*)A.in[(m >> 1) ? I_W2V : I_W2K] + (size_t)(m & 1) * 64 * 64;
            transpose_item(W, 64, 0, 32 * nb, 32, nullptr, (bf16*)(ws + WS_W2T) + (size_t)m * 64 * 64, 64, 32 * nb, scr, lane); }
    }
    {
        const f32x4* gm = (const f32x4*)A.in[I_NMIX];
        f32x4 g[4];
#pragma unroll
        for (int j = 0; j < 4; ++j) g[j] = gm[64 * j + lane];
        for (int m0 = gw; m0 < NTOK; m0 += 4 * NGW) {
            f32x4 v[4][4];
#pragma unroll
            for (int r = 0; r < 4; ++r) { const int mm = m0 + r * NGW, m = (mm < NTOK) ? mm : m0;
                const float* xrow = (m < NP) ? (const float*)A.in[I_XP] + (size_t)m * DM : (const float*)A.in[I_XS] + (size_t)(m - NP) * DM;
                const f32x4* xr = (const f32x4*)xrow + lane;
#pragma unroll
                for (int j = 0; j < 4; ++j) v[r][j] = xr[64 * j]; }
#pragma unroll
            for (int r = 0; r < 4; ++r) { const int m = m0 + r * NGW;
                float s = 0.f;
#pragma unroll
                for (int j = 0; j < 4; ++j) s += (v[r][j].x * v[r][j].x + v[r][j].y * v[r][j].y) + (v[r][j].z * v[r][j].z + v[r][j].w * v[r][j].w);
                const float rstd = 1.f / sqrtf(wave_sum(s) * (1.f / DM) + RMS_EPS);
                if (m < NTOK) {
                    u32x2* o8 = (u32x2*)((bf16*)(ws + WS_H) + (size_t)m * DM) + lane;
#pragma unroll
                    for (int j = 0; j < 4; ++j) { u32x2 o; o.x = pk2(v[r][j].x * rstd * g[j].x, v[r][j].y * rstd * g[j].y); o.y = pk2(v[r][j].z * rstd * g[j].z, v[r][j].w * rstd * g[j].w); o8[64 * j] = o; }
                } }
        }
    }
    for (int i0 = gt; i0 < NTOK * 64; i0 += 8 * NGT) {
        f32x4 v[8];
#pragma unroll
        for (int u = 0; u < 8; ++u) { const int ii = i0 + u * NGT, i = (ii < NTOK * 64) ? ii : i0; const int row = i >> 6, c4 = i & 63;
            v[u] = (row < NP) ? ((const f32x4*)A.in[I_PP])[(size_t)row * 64 + c4] : ((const f32x4*)A.in[I_PS])[(size_t)(row - NP) * 64 + c4]; }
#pragma unroll
        for (int u = 0; u < 8; ++u) { const int i = i0 + u * NGT;
            if (i < NTOK * 64) { u32x2 o; o.x = pk2(v[u].x, v[u].y); o.y = pk2(v[u].z, v[u].w); ((u32x2*)(ws + WS_PB))[i] = o; } }
    }
    for (int i = gt; i < NPOS * 96; i += NGT) {
        const int pi = i / 96, k = i % 96;
        const double pos = (pi < SEQ) ? (double)pi : (double)(PAST + pi - SEQ);
        double s, c;
        if (k < 64) { sincos_d(pos * ipow_d(0.86596432336006535235, k), s, c); ((float*)(ws + WS_COSR))[pi * 64 + k] = (float)c; ((float*)(ws + WS_SINR))[pi * 64 + k] = (float)s; }
        else { const int kk = k - 64; sincos_d(pos * ipow_d(0.74989420933245582730, kk), s, c); ((float*)(ws + WS_COSN))[pi * 32 + kk] = (float)c; ((float*)(ws + WS_SINN))[pi * 32 + kk] = (float)s; }
    }
    for (int it = blockIdx.x; it < 4 * 32; it += gridDim.x) {
        const int m = it >> 5, part = it & 31, kv = m >> 1, kvh = m & 1;
        const float* pe = (const float*)A.in[kv ? I_PEV : I_PEK];
        const float* w1 = (const float*)A.in[kv ? I_W1V : I_W1K] + (size_t)kvh * 2048 * 64;
        float pv[8], wv8[8];
#pragma unroll
        for (int q = 0; q < 8; ++q) { const int jd = part * 64 + 8 * wave + q, j = jd >> 6, d = jd & 63; pv[q] = pe[(j * 2 + kvh) * 64 + d]; wv8[q] = w1[(size_t)jd * 64 + lane]; }
        float acc = 0.f;
#pragma unroll
        for (int q = 0; q < 8; ++q) acc += pv[q] * wv8[q];
        LAS float* cb = (LAS float*)lds;
        __syncthreads();
        cb[wave * 64 + lane] = acc;
        __syncthreads();
        if (wave == 0) { float t = 0.f;
#pragma unroll
            for (int w = 0; w < 8; ++w) t += cb[w * 64 + lane];
            ((float*)(ws + WS_CBIAS))[(m * 32 + part) * 64 + lane] = t; }
    }
    for (int i0 = gt; i0 < 2 * 32 * 504 * 32; i0 += 8 * NGT) {
        f32x4 v[8];
#pragma unroll
        for (int u = 0; u < 8; ++u) { const int ii = i0 + u * NGT, i = (ii < 2 * 32 * 504 * 32) ? ii : i0;
            const int kv = i / (32 * 504 * 32), r = i % (32 * 504 * 32), b = r / (504 * 32), q = r % (504 * 32);
            v[u] = ((const f32x4*)A.in[kv ? I_SWV : I_SWK])[(size_t)b * 512 * 32 + 8 * 32 + q]; }
#pragma unroll
        for (int u = 0; u < 8; ++u) { const int i = i0 + u * NGT;
            if (i < 2 * 32 * 504 * 32) { const int kv = i / (32 * 504 * 32), r = i % (32 * 504 * 32), b = r / (504 * 32), q = r % (504 * 32);
                ((f32x4*)(A.out + (kv ? O_WINV_S : O_WINK_S)))[(size_t)b * 512 * 32 + q] = v[u]; } }
    }
}

struct EpiInProj {
    static constexpr bool PERM = true, AFTER_DRAIN = false;
    unsigned char* ws; float* out;
    __device__ __forceinline__ void operator()(const pg8::f32x4 (&acc)[2][2][4][2], const pg8::Unit& u, int wr, int wc, int fr, int fq) const {
        const int pn = u.pn;
        asm volatile("" : "+v"(fr), "+v"(fq));
        const int lc = wc * 32 + 8 * fq;
        const bool rope = pn < 4 || pn == 8 || pn == 9 || pn == 11;
        f32x4 tb[2][4];
        auto ldtab = [&](int ai_, int m_, f32x4 (&t)[4]) {
            const int row_ = u.pm * 256 + ai_ * 128 + wr * 64 + m_ * 16 + fr;
            const int pidx_ = (row_ >= NP) ? (SEQ + ((row_ - NP) & 7)) : (row_ & (SEQ - 1));
            const bool big = pn < 4; const int nd = big ? 64 : 32, dl = big ? ((wc & 1) * 32 + 8 * fq) : 8 * fq;
            const float* ct = (const float*)(ws + (big ? WS_COSR : WS_COSN)) + pidx_ * nd + dl; const float* st = (const float*)(ws + (big ? WS_SINR : WS_SINN)) + pidx_ * nd + dl;
            t[0] = *(const f32x4*)ct; t[1] = *(const f32x4*)(ct + 4); t[2] = *(const f32x4*)st; t[3] = *(const f32x4*)(st + 4); };
        if (rope) ldtab(0, 0, tb[0]);
#pragma unroll
        for (int ai = 0; ai < 2; ++ai)
#pragma unroll
            for (int m = 0; m < 4; ++m) {
                const int row = u.pm * 256 + ai * 128 + wr * 64 + m * 16 + fr;
                const bool dec = row >= NP;
                const int pidx = dec ? (SEQ + ((row - NP) & 7)) : (row & (SEQ - 1));
                float cc[8], ss[8];
                if (rope) {
                    const int idx = ai * 4 + m;
                    if (idx + 1 < 8) ldtab((idx + 1) >> 2, (idx + 1) & 3, tb[(idx + 1) & 1]);
#pragma unroll
                    for (int e = 0; e < 8; ++e) { cc[e] = e < 4 ? tb[idx & 1][0][e & 3] : tb[idx & 1][1][e & 3]; ss[e] = e < 4 ? tb[idx & 1][2][e & 3] : tb[idx & 1][3][e & 3]; }
                }
                float v0[8], v1[8];
#pragma unroll
                for (int e = 0; e < 4; ++e) { v0[e] = acc[ai][0][m][0][e]; v0[4 + e] = acc[ai][0][m][1][e]; v1[e] = acc[ai][1][m][0][e]; v1[4 + e] = acc[ai][1][m][1][e]; }
                if (pn < 4) {
                    const int t2 = pn & 1, head = 2 * t2 + (wc >> 1), dlo = (wc & 1) * 32 + 8 * fq;
                    const float sc = (pn >= 2) ? 0.08838834764831845f : 1.f;
                    float o0[8], o1[8];
#pragma unroll
                    for (int e = 0; e < 8; ++e) { const float c = cc[e], s = ss[e]; o0[e] = (v0[e] * c - v1[e] * s) * sc; o1[e] = (v1[e] * c + v0[e] * s) * sc; }
                    bf16* dst = (bf16*)(ws + (pn >= 2 ? WS_KR : WS_QR));
                    *(u32x4*)(dst + CM(head * 128 + dlo, row)) = pack8(o0); *(u32x4*)(dst + CM(head * 128 + 64 + dlo, row)) = pack8(o1);
                } else if (pn < 8) {
                    const int cb = ((pn - 4) & 1) * 256 + lc;
                    if (pn >= 6) {
#pragma unroll
                        for (int e = 0; e < 8; ++e) { v0[e] = siluf_(v0[e]); v1[e] = siluf_(v1[e]); } }
                    bf16* dst = (bf16*)(ws + (pn >= 6 ? WS_RG : WS_VR));
                    *(u32x4*)(dst + CM(cb, row)) = pack8(v0); *(u32x4*)(dst + CM(cb + 128, row)) = pack8(v1);
                } else if (pn < 10) {
                    const int head = 4 * (pn - 8) + wc, dlo = 8 * fq;
                    float o0[8], o1[8], r0[8], r1[8];
#pragma unroll
                    for (int e = 0; e < 8; ++e) { const float c = cc[e], s = ss[e]; o0[e] = (v0[e] * c - v1[e] * s) * C2; o1[e] = (v1[e] * c + v0[e] * s) * C2; r0[e] = v0[e] * C2; r1[e] = v1[e] * C2; }
                    bf16* dq = (bf16*)(ws + WS_QN); bf16* dr = (bf16*)(ws + WS_QROT); const size_t c0_ = CM(head * 64 + dlo, row), c1_ = CM(head * 64 + 32 + dlo, row);
                    *(u32x4*)(dq + c0_) = pack8(r0); *(u32x4*)(dq + c1_) = pack8(r1); *(u32x4*)(dr + c0_) = pack8(o0); *(u32x4*)(dr + c1_) = pack8(o1);
                } else if (pn == 10) {
                    float* dk = out + (dec ? O_CMPK_S + (size_t)(row - NP) * 128 : O_CMPK_P + (size_t)row * 128) + lc;
                    float* dv = out + (dec ? O_CMPV_S + (size_t)(row - NP) * 128 : O_CMPV_P + (size_t)row * 128) + lc;
                    *(f32x4*)dk = (f32x4){v0[0], v0[1], v0[2], v0[3]}; *(f32x4*)(dk + 4) = (f32x4){v0[4], v0[5], v0[6], v0[7]};
                    *(f32x4*)dv = (f32x4){v1[0], v1[1], v1[2], v1[3]}; *(f32x4*)(dv + 4) = (f32x4){v1[4], v1[5], v1[6], v1[7]};
                } else if (pn == 11) {
                    const int which = wc >> 1, kvh = wc & 1, dlo = 8 * fq, col = kvh * 64 + dlo;
                    float o0[8], o1[8];
#pragma unroll
                    for (int e = 0; e < 8; ++e) { const float c = cc[e], s = ss[e]; o0[e] = v0[e] * c - v1[e] * s; o1[e] = v1[e] * c + v0[e] * s; }
                    bf16* db = (bf16*)(ws + (which ? WS_KW : WS_KS));
                    *(u32x4*)(db + CM(col, row)) = pack8(o0); *(u32x4*)(db + CM(col + 32, row)) = pack8(o1);
                    float* df = nullptr;
                    if (which == 0) df = out + (dec ? O_SLCK_S + (size_t)(row - NP) * 128 : O_SLCK_P + (size_t)row * 128) + col;
                    else if (dec) { const int b = (row - NP) >> 3, tt = (row - NP) & 7; df = out + O_WINK_S + ((size_t)b * 512 + 504 + tt) * 128 + col; }
                    else { const int b = row >> 12, t = row & 4095; if (t >= SEQ - 512) df = out + O_WINK_P + ((size_t)b * 512 + (t - (SEQ - 512))) * 128 + col; }
                    if (df) { *(f32x4*)df = (f32x4){o0[0], o0[1], o0[2], o0[3]}; *(f32x4*)(df + 4) = (f32x4){o0[4], o0[5], o0[6], o0[7]};
                              *(f32x4*)(df + 32) = (f32x4){o1[0], o1[1], o1[2], o1[3]}; *(f32x4*)(df + 36) = (f32x4){o1[4], o1[5], o1[6], o1[7]}; }
                } else if (pn == 12) {
                    *(u32x4*)((bf16*)(ws + WS_VS) + CM(lc, row)) = pack8(v0); *(u32x4*)((bf16*)(ws + WS_VW) + CM(lc, row)) = pack8(v1);
                    float* fs = out + (dec ? O_SLCV_S + (size_t)(row - NP) * 128 : O_SLCV_P + (size_t)row * 128) + lc;
                    *(f32x4*)fs = (f32x4){v0[0], v0[1], v0[2], v0[3]}; *(f32x4*)(fs + 4) = (f32x4){v0[4], v0[5], v0[6], v0[7]};
                    float* fw = nullptr;
                    if (dec) { const int b = (row - NP) >> 3, tt = (row - NP) & 7; fw = out + O_WINV_S + ((size_t)b * 512 + 504 + tt) * 128 + lc; }
                    else { const int b = row >> 12, t = row & 4095; if (t >= SEQ - 512) fw = out + O_WINV_P + ((size_t)b * 512 + (t - (SEQ - 512))) * 128 + lc; }
                    if (fw) { *(f32x4*)fw = (f32x4){v1[0], v1[1], v1[2], v1[3]}; *(f32x4*)(fw + 4) = (f32x4){v1[4], v1[5], v1[6], v1[7]}; }
                } else {
                    const int cb = (pn - 13) * 256 + lc;
#pragma unroll
                    for (int e = 0; e < 8; ++e) { v0[e] = siluf_(v0[e]); v1[e] = siluf_(v1[e]); }
                    bf16* dst = (bf16*)(ws + WS_NG);
                    *(u32x4*)(dst + CM(cb, row)) = pack8(v0); *(u32x4*)(dst + CM(cb + 128, row)) = pack8(v1);
                }
            }
    }
};

__device__ __forceinline__ void ngl_unit(unsigned char* ws, int unit, int lane, int wave) {
    const int row0 = unit * 128 + wave * 16, fr = lane & 15, fq = lane >> 4;
    const bf16* a = (const bf16*)(ws + WS_H) + (size_t)(row0 + fr) * DM + 8 * fq;
    const bf16* b0 = (const bf16*)(ws + WS_WNGLT) + (size_t)fr * DM + 8 * fq;
    const bf16* b1 = b0 + 16 * DM;
    f32x4 c0 = {0.f, 0.f, 0.f, 0.f}, c1 = {0.f, 0.f, 0.f, 0.f};
#pragma unroll 8
    for (int s = 0; s < 32; ++s) {
        const bf16x8 av = *(const bf16x8*)(a + 32 * s), bv0 = *(const bf16x8*)(b0 + 32 * s), bv1 = *(const bf16x8*)(b1 + 32 * s);
        c0 = __builtin_amdgcn_mfma_f32_16x16x32_bf16(av, bv0, c0, 0, 0, 0);
        c1 = __builtin_amdgcn_mfma_f32_16x16x32_bf16(av, bv1, c1, 0, 0, 0);
    }
    float* gl = (float*)(ws + WS_GL);
#pragma unroll
    for (int i = 0; i < 4; ++i) { const int r = row0 + 4 * fq + i; gl[(size_t)r * 32 + fr] = sigmoidf_(c0[i]); gl[(size_t)r * 32 + 16 + fr] = sigmoidf_(c1[i]); }
}

template <bool DEC>
__device__ __forceinline__ void compress_unit(const Args& A, LAS unsigned char* lds, int unit, int tid, int lane, int wave) {
    unsigned char* ws = A.ws;
    asm volatile("" : "+v"(tid), "+v"(lane));
    const int kv = DEC ? (unit >> 8) : (unit >> 3), b = DEC ? ((unit >> 3) & 31) : ((unit >> 1) & 3), part = DEC ? (unit & 7) : (unit & 1);
    const int r32 = lane & 31, hi = lane >> 5, kvh = wave >> 2, bt = (wave >> 1) & 1, et = wave & 1, m = kv * 2 + kvh;
    constexpr int AP = 528;
    LAS unsigned char* bufA = lds;
    LAS float* biasL = (LAS float*)(lds + 2 * 64 * AP);
    LAS float* xch = (LAS float*)(lds + 2 * 64 * AP + 512);
    __syncthreads();
    unsigned offs[8];
    const float* src;
    if (DEC) { src = (const float*)A.in[kv ? I_CCV : I_CCK]; const int* pt = (const int*)A.in[I_PT] + b * 128 + part * 16;
#pragma unroll
        for (int i = 0; i < 8; ++i) { const int blk = (tid >> 6) + 8 * i; offs[i] = ((unsigned)pt[blk >> 2] * 128u + (unsigned)(blk & 3) * 32u) * 128u + 4u * (tid & 63); } }
    else { src = A.out + (kv ? O_CMPV_P : O_CMPK_P) + (size_t)b * SEQ * 128 + (size_t)part * 64 * 32 * 128;
#pragma unroll
        for (int i = 0; i < 8; ++i) { const int blk = (tid >> 6) + 8 * i; offs[i] = (unsigned)(blk * 32) * 128u + 4u * (tid & 63); } }
#define GLD16(dst, ptr) asm volatile("global_load_dwordx4 %0, %1, off" : "=v"(dst) : "v"(ptr) : "memory")
#define GLD16NT(dst, ptr) asm volatile("global_load_dwordx4 %0, %1, off nt" : "=v"(dst) : "v"(ptr) : "memory")
#define WAIT8(N, a) asm volatile("s_waitcnt vmcnt(" #N ")" : "+v"(a[0]), "+v"(a[1]), "+v"(a[2]), "+v"(a[3]), "+v"(a[4]), "+v"(a[5]), "+v"(a[6]), "+v"(a[7]) :: "memory")
    const unsigned rot = DEC ? (unsigned)(unit & 15) : 0u;
    f32x4 preA[8], preB[8];
    bf16x8 wA[8], wB[8];
    f32x16 acc = f32x16{};
    const bf16* w1t = (const bf16*)(ws + WS_W1T) + (size_t)m * 64 * 2048 + (size_t)(et * 512 + lane) * 8;
#define LD_ROWS(PRE, S) do { const unsigned s2_ = ((((S) < 16) ? (unsigned)(S) : 15u) + rot) & 15u; _Pragma("unroll") for (int i = 0; i < 8; ++i) { const float* p_ = src + offs[i] + s2_ * 256u; if (DEC) GLD16NT(PRE[i], p_); else GLD16(PRE[i], p_); } } while (0)
#define LD_W1(W, S) do { const int sn_ = (int)(((((S) < 16) ? (unsigned)(S) : 15u) + rot) & 15u); _Pragma("unroll") for (int q = 0; q < 8; ++q) { const bf16* p_ = w1t + sn_ * 8192 + 512 * q; GLD16(W[q], p_); } } while (0)
    LD_ROWS(preA, 0); LD_W1(wA, 0); LD_ROWS(preB, 1);
    if (tid < 128) { const int k2 = tid >> 6, e = tid & 63; const float* cb = (const float*)(ws + WS_CBIAS) + ((kv * 2 + k2) * 32) * 64 + e; float bp[32];
#pragma unroll
        for (int p = 0; p < 32; ++p) bp[p] = cb[p * 64];
        float s = 0.f;
#pragma unroll
        for (int p = 0; p < 32; ++p) s += bp[p];
        biasL[tid] = s; }
#define CMP_STEP(PRE, WC, WN, S) do { \
        LAS unsigned char* buf = bufA + ((S) & 1) * 64 * AP; \
        WAIT8(16, PRE); \
        _Pragma("unroll") for (int i = 0; i < 8; ++i) { const int blk = (tid >> 6) + 8 * i; u32x2 o; o.x = pk2(PRE[i].x, PRE[i].y); o.y = pk2(PRE[i].z, PRE[i].w); *(LAS u32x2*)(buf + blk * AP + (tid & 63) * 8) = o; } \
        LD_W1(WN, (S) + 1); LD_ROWS(PRE, (S) + 2); \
        __syncthreads(); \
        WAIT8(24, WC); \
        _Pragma("unroll") for (int q = 0; q < 8; ++q) { \
            const bf16x8 bf = *(LAS const bf16x8*)(buf + (32 * bt + r32) * AP + ((q >> 2) * 128 + kvh * 64 + 16 * (q & 3) + 8 * hi) * 2); \
            acc = MFMA32(WC[q], bf, acc); } } while (0)
#pragma unroll 1
    for (int s = 0; s < 16; s += 2) { CMP_STEP(preA, wA, wB, s); CMP_STEP(preB, wB, wA, s + 1); }
    asm volatile("s_waitcnt vmcnt(0)" ::: "memory");
#undef CMP_STEP
#undef LD_ROWS
#undef LD_W1
#undef GLD16
#undef GLD16NT
#undef WAIT8
#pragma unroll
    for (int r = 0; r < 16; ++r) acc[r] = gelu_tanh(acc[r] + biasL[kvh * 64 + 32 * et + crow(r, hi)]);
    const bf16* w2t = (const bf16*)(ws + WS_W2T) + (size_t)m * 64 * 64;
    f32x16 oacc[2]; oacc[0] = f32x16{}; oacc[1] = f32x16{};
#pragma unroll
    for (int s2 = 0; s2 < 2; ++s2) {
        const bf16x8 pb = pack_frag(acc, 8 * s2);
#pragma unroll
        for (int ft = 0; ft < 2; ++ft) {
            const bf16* wp = w2t + (32 * ft + r32) * 64 + 32 * et + 16 * s2 + 4 * hi;
            const s16x4 lo = *(const s16x4*)wp, hh = *(const s16x4*)(wp + 8);
            oacc[ft] = MFMA32(cat8(lo, hh), pb, oacc[ft]);
        }
    }
    LAS float* xp = xch + ((kvh * 2 + bt) * 32) * 64 + lane;
    if (et == 1) {
#pragma unroll
        for (int ft = 0; ft < 2; ++ft)
#pragma unroll
            for (int r = 0; r < 16; ++r) xp[(ft * 16 + r) * 64] = oacc[ft][r];
    }
    __syncthreads();
    if (et == 0) {
        const int blk = 32 * bt + r32;
#pragma unroll
        for (int ft = 0; ft < 2; ++ft)
#pragma unroll
            for (int q = 0; q < 4; ++q) {
                const int f = 32 * ft + 8 * q + 4 * hi;
                const float v0 = oacc[ft][4 * q] + xp[(ft * 16 + 4 * q) * 64], v1 = oacc[ft][4 * q + 1] + xp[(ft * 16 + 4 * q + 1) * 64];
                const float v2 = oacc[ft][4 * q + 2] + xp[(ft * 16 + 4 * q + 2) * 64], v3 = oacc[ft][4 * q + 3] + xp[(ft * 16 + 4 * q + 3) * 64];
                if (DEC) { float* d = (float*)(ws + (kv ? WS_VCS : WS_KCS)) + (((size_t)b * 512 + part * 64 + blk) * 2 + kvh) * 64 + f; *(f32x4*)d = (f32x4){v0, v1, v2, v3}; }
                else { bf16* d = (bf16*)(ws + (kv ? WS_VCP : WS_KCP)) + (((size_t)b * 128 + part * 64 + blk) * 2 + kvh) * 64 + f;
                    u32x2 o; o.x = pk2(v0, v1); o.y = pk2(v2, v3); *(u32x2*)d = o; }
            }
    }
}

__device__ __forceinline__ int tr_off(int lane, int pitch) { return ((lane & 15) >> 2) * pitch + (16 * ((lane >> 4) & 1) + 4 * (lane & 3)) * 2; }

__device__ __forceinline__ void ret_pass1_unit(unsigned char* ws, LAS unsigned char* lds, int unit, int tid, int lane, int wave) {
    const int bh = unit >> 5, c = unit & 31, b = bh >> 2, h = bh & 3;
    constexpr int TP = 320;
    LAS unsigned char* Kt = lds; LAS unsigned char* Vt = lds + 128 * TP;
    const size_t row0 = (size_t)b * SEQ + c * 128;
    const float lg = log2g(h);
    __syncthreads();
#pragma unroll
    for (int i = 0; i < 4; ++i) {
        const int row = tid & 127, ch = (tid >> 7) + 4 * i;
        const u32x4 kx = *(const u32x4*)((const bf16*)(ws + WS_KR) + CM(h * 128 + ch * 8, row0 + row));
        const u32x4 vx = *(const u32x4*)((const bf16*)(ws + WS_VR) + CM(h * 128 + ch * 8, row0 + row));
        const float dc = exp2f((float)(127 - row) * lg);
        u32x4 ko; ko.x = pk2(bflo(kx.x) * dc, bfhi(kx.x) * dc); ko.y = pk2(bflo(kx.y) * dc, bfhi(kx.y) * dc); ko.z = pk2(bflo(kx.z) * dc, bfhi(kx.z) * dc); ko.w = pk2(bflo(kx.w) * dc, bfhi(kx.w) * dc);
        *(LAS u32x4*)(Kt + row * TP + ch * 16) = ko; *(LAS u32x4*)(Vt + row * TP + ch * 16) = vx;
    }
    __syncthreads();
    const int r32 = lane & 31, hi = lane >> 5, dvb = wave & 3, dkh = wave >> 2, tro = tr_off(lane, TP);
    f32x16 acc[2]; acc[0] = f32x16{}; acc[1] = f32x16{};
#pragma unroll
    for (int s = 0; s < 8; ++s) {
        const int t0 = 16 * s + 8 * hi;
        const bf16x8 af = cat8(ds_tr(Vt + t0 * TP + 64 * dvb + tro), ds_tr(Vt + (t0 + 4) * TP + 64 * dvb + tro));
#pragma unroll
        for (int n = 0; n < 2; ++n) {
            const int cb = 64 * (2 * dkh + n);
            const bf16x8 bfr = cat8(ds_tr(Kt + t0 * TP + cb + tro), ds_tr(Kt + (t0 + 4) * TP + cb + tro));
            acc[n] = MFMA32(af, bfr, acc[n]);
        }
    }
    float* dst = (float*)(ws + WS_KVT) + (size_t)unit * 16384;
#pragma unroll
    for (int n = 0; n < 2; ++n)
#pragma unroll
        for (int r = 0; r < 16; ++r) dst[(32 * dvb + crow(r, hi)) * 128 + 32 * (2 * dkh + n) + r32] = acc[n][r];
}

__device__ __forceinline__ void ret_pass2(const Args& A, int tid) {
    unsigned char* ws = A.ws;
    for (int e = blockIdx.x * 512 + tid; e < 16 * 16384; e += gridDim.x * 512) {
        const int bh = e >> 14, q = e & 16383, dv = q >> 7, dk = q & 127;
        const float gC = exp2f(128.f * log2g(bh & 3));
        const float* kv = (const float*)(ws + WS_KVT) + (size_t)bh * 32 * 16384 + q;
        bf16* st = (bf16*)(ws + WS_ST) + (size_t)bh * 32 * 16384 + (size_t)(((((dv >> 6) * 2 + ((dv >> 5) & 1)) * 8 + (dk >> 4)) * 64 + (dv & 31) + 32 * ((dk >> 3) & 1)) * 8 + (dk & 7));
        float kvr[32];
#pragma unroll
        for (int c = 0; c < 32; ++c) kvr[c] = kv[(size_t)c * 16384];
        float S = 0.f;
#pragma unroll
        for (int c = 0; c < 32; ++c) { st[(size_t)c * 16384] = (bf16)f2bf(S); S = gC * S + kvr[c]; }
        A.out[O_RETP + (size_t)bh * 16384 + dk * 128 + dv] = S;
    }
}

__device__ __forceinline__ void ret_pass3_unit(const Args& A, LAS unsigned char* lds, int unit, int tid, int lane, int wave) {
    unsigned char* ws = A.ws;
    const int bh = unit >> 5, c = unit & 31, b = bh >> 2, h = bh & 3;
    constexpr int KP = 272, VP = 320;
    LAS unsigned char* Kt = lds; LAS unsigned char* Vt = lds + 128 * KP; LAS float* red = (LAS float*)(lds + 128 * KP + 128 * VP);
    const size_t row0 = (size_t)b * SEQ + c * 128;
    const float lg = log2g(h);
    __syncthreads();
#pragma unroll
    for (int i = 0; i < 4; ++i) {
        const int row = tid & 127, ch = (tid >> 7) + 4 * i;
        *(LAS u32x4*)(Kt + row * KP + ch * 16) = *(const u32x4*)((const bf16*)(ws + WS_KR) + CM(h * 128 + ch * 8, row0 + row));
        *(LAS u32x4*)(Vt + row * VP + ch * 16) = *(const u32x4*)((const bf16*)(ws + WS_VR) + CM(h * 128 + ch * 8, row0 + row));
    }
    const int r32 = lane & 31, hi = lane >> 5, ib = wave & 3, dh = wave >> 2, tro = tr_off(lane, VP);
    const int il = 32 * ib + r32;
    bf16x8 qf[8];
    { const bf16* qp = (const bf16*)(ws + WS_QR) + CM(h * 128 + 8 * hi, row0 + il);
#pragma unroll
      for (int s = 0; s < 8; ++s) qf[s] = *(const bf16x8*)(qp + (size_t)s * (2 * NTOK * 8)); }
    __syncthreads();
    f32x16 oacc[2]; oacc[0] = f32x16{}; oacc[1] = f32x16{};
    for (int jb = 0; jb <= ib; ++jb) {
        f32x16 sT = f32x16{};
#pragma unroll
        for (int s = 0; s < 8; ++s) { const bf16x8 kf = *(LAS const bf16x8*)(Kt + (32 * jb + r32) * KP + (16 * s + 8 * hi) * 2); sT = MFMA32(kf, qf[s], sT); }
#pragma unroll
        for (int r = 0; r < 16; ++r) { const int j = 32 * jb + crow(r, hi); const float d = exp2f((float)(il - j) * lg); sT[r] = (j <= il) ? sT[r] * d : 0.f; }
#pragma unroll
        for (int s2 = 0; s2 < 2; ++s2) {
            const bf16x8 pb = pack_frag(sT, 8 * s2);
            const int j0 = 32 * jb + 16 * s2 + 4 * hi;
#pragma unroll
            for (int dvb = 0; dvb < 2; ++dvb) {
                const int cb = 64 * (2 * dh + dvb);
                const bf16x8 vf = cat8(ds_tr(Vt + j0 * VP + cb + tro), ds_tr(Vt + (j0 + 8) * VP + cb + tro));
                oacc[dvb] = MFMA32(vf, pb, oacc[dvb]);
            }
        }
    }
    f32x16 cacc[2]; cacc[0] = f32x16{}; cacc[1] = f32x16{};
    { const bf16* sp = (const bf16*)(ws + WS_ST) + (size_t)unit * 16384 + (size_t)(dh * 2 * 8 * 64 + lane) * 8;
#pragma unroll
      for (int s = 0; s < 8; ++s) {
          const bf16x8 a0 = *(const bf16x8*)(sp + s * 512), a1 = *(const bf16x8*)(sp + 8 * 512 + s * 512);
          cacc[0] = MFMA32(a0, qf[s], cacc[0]); cacc[1] = MFMA32(a1, qf[s], cacc[1]);
      } }
    const float qd = exp2f((float)(il + 1) * lg);
    float s1 = 0.f, s2 = 0.f;
#pragma unroll
    for (int dvb = 0; dvb < 2; ++dvb)
#pragma unroll
        for (int r = 0; r < 16; ++r) { const float o = oacc[dvb][r] + qd * cacc[dvb][r]; oacc[dvb][r] = o; s1 += o; s2 += o * o; }
    s1 = xor32_sum(s1); s2 = xor32_sum(s2);
    if (hi == 0) { red[(dh * 128 + il) * 2] = s1; red[(dh * 128 + il) * 2 + 1] = s2; }
    __syncthreads();
    const float t1 = red[il * 2] + red[(128 + il) * 2], t2 = red[il * 2 + 1] + red[(128 + il) * 2 + 1];
    const float mu = t1 * (1.f / 128.f), var = fmaxf(t2 * (1.f / 128.f) - mu * mu, 0.f), rstd = 1.f / sqrtf(var + GN_EPS);
    const float* gg = (const float*)A.in[I_GNG] + h * 128; const float* gb = (const float*)A.in[I_GNB] + h * 128;
    const bf16* rgp = (const bf16*)(ws + WS_RG);
    bf16* yp = (bf16*)(ws + WS_YMIX) + (row0 + il) * 1024 + h * 128;
    u32x2 rgv[2][4];
#pragma unroll
    for (int dvb = 0; dvb < 2; ++dvb)
#pragma unroll
        for (int q = 0; q < 4; ++q) rgv[dvb][q] = *(const u32x2*)(rgp + CM(h * 128 + 32 * (2 * dh + dvb) + 8 * q + 4 * hi, row0 + il));
#pragma unroll
    for (int dvb = 0; dvb < 2; ++dvb)
#pragma unroll
        for (int q = 0; q < 4; ++q) {
            const int dv = 32 * (2 * dh + dvb) + 8 * q + 4 * hi;
            const f32x4 g4 = *(const f32x4*)(gg + dv), b4 = *(const f32x4*)(gb + dv);
            const u32x2 rg = rgv[dvb][q];
            const float y0 = ((oacc[dvb][4 * q] - mu) * rstd * g4.x + b4.x) * bflo(rg.x), y1 = ((oacc[dvb][4 * q + 1] - mu) * rstd * g4.y + b4.y) * bfhi(rg.x);
            const float y2 = ((oacc[dvb][4 * q + 2] - mu) * rstd * g4.z + b4.z) * bflo(rg.y), y3 = ((oacc[dvb][4 * q + 3] - mu) * rstd * g4.w + b4.w) * bfhi(rg.y);
            u32x2 o; o.x = pk2(y0, y1); o.y = pk2(y2, y3); *(u32x2*)(yp + dv) = o;
        }
}

__device__ __forceinline__ void ret_decode_unit(const Args& A, LAS unsigned char* lds, int unit, int tid, int lane, int wave) {
    unsigned char* ws = A.ws;
    const int b = unit >> 2, h = unit & 3;
    LAS float* qL = (LAS float*)lds; LAS float* kL = qL + 1024; LAS float* vL = kL + 1024; LAS float* sL = vL + 1024;
    LAS float* red = sL + 64;
    const float lg = log2g(h);
    __syncthreads();
    { bf16 t6[6];
#pragma unroll
      for (int u = 0; u < 6; ++u) { const int i = tid + 512 * u, w = i >> 10, q = i & 1023, j = q >> 7, d = q & 127;
          t6[u] = *((const bf16*)(ws + (w == 0 ? WS_QR : w == 1 ? WS_KR : WS_VR)) + CM(h * 128 + d, NP + b * 8 + j)); }
#pragma unroll
      for (int u = 0; u < 6; ++u) qL[tid + 512 * u] = bf2f(t6[u]); }
    __syncthreads();
    {
        const int i = wave, j = lane & 7, sl = lane >> 3; float a = 0.f;
#pragma unroll
        for (int d = 0; d < 16; ++d) a += qL[i * 128 + sl * 16 + d] * kL[j * 128 + sl * 16 + d];
        a += __shfl_xor(a, 8); a += __shfl_xor(a, 16); a += __shfl_xor(a, 32);
        if (lane < 8) sL[i * 8 + j] = (j <= i) ? a * exp2f((float)(i - j) * lg) : 0.f;
    }
    const int dv = tid & 127, dkq = tid >> 7;
    float vj[8], cr[8];
#pragma unroll
    for (int j = 0; j < 8; ++j) { vj[j] = vL[j * 128 + dv] * exp2f((float)(7 - j) * lg); cr[j] = 0.f; }
    const float g8 = exp2f(8.f * lg);
    const float* stp = (const float*)A.in[I_SRET] + (size_t)unit * 16384 + dv;
    float* nsp = A.out + O_RETS + (size_t)unit * 16384 + dv;
    float stv[32];
#pragma unroll
    for (int k = 0; k < 32; ++k) stv[k] = stp[(32 * dkq + k) * 128];
#pragma unroll
    for (int k = 0; k < 32; ++k) { const int dk = 32 * dkq + k;
        const float st = stv[k]; float ns = g8 * st;
#pragma unroll
        for (int j = 0; j < 8; ++j) { cr[j] += qL[j * 128 + dk] * st; ns += kL[j * 128 + dk] * vj[j]; }
        nsp[dk * 128] = ns;
    }
#pragma unroll
    for (int j = 0; j < 8; ++j) red[(dkq * 8 + j) * 128 + dv] = cr[j];
    __syncthreads();
    {
        const int i = wave; const float qd = exp2f((float)(i + 1) * lg);
        float o[2], s1 = 0.f, s2 = 0.f;
#pragma unroll
        for (int k = 0; k < 2; ++k) { const int d = lane + 64 * k;
            float x = (red[(0 * 8 + i) * 128 + d] + red[(1 * 8 + i) * 128 + d]) + (red[(2 * 8 + i) * 128 + d] + red[(3 * 8 + i) * 128 + d]);
            x *= qd;
#pragma unroll
            for (int j = 0; j < 8; ++j) x += sL[i * 8 + j] * vL[j * 128 + d];
            o[k] = x; s1 += x; s2 += x * x; }
        s1 = wave_sum(s1); s2 = wave_sum(s2);
        const float mu = s1 * (1.f / 128.f), var = fmaxf(s2 * (1.f / 128.f) - mu * mu, 0.f), rstd = 1.f / sqrtf(var + GN_EPS);
        const size_t row = (size_t)NP + b * 8 + i;
#pragma unroll
        for (int k = 0; k < 2; ++k) { const int d = lane + 64 * k;
            const float y = ((o[k] - mu) * rstd * ((const float*)A.in[I_GNG])[h * 128 + d] + ((const float*)A.in[I_GNB])[h * 128 + d]) * bf2f(((const bf16*)(ws + WS_RG))[CM(h * 128 + d, row)]);
            ((bf16*)(ws + WS_YMIX))[row * 1024 + h * 128 + d] = (bf16)f2bf(y); }
    }
}

constexpr int NSA_KP = 144, NSA_VP = 192;
constexpr int NSA_SLOT = 8192;
constexpr int NSA_KT = 0, NSA_VT = 3 * NSA_SLOT, NSA_IMP = NSA_VT + 4 * NSA_SLOT,
     NSA_SEL = NSA_IMP + 4 * 64 * 65 * 4, NSA_IMPF = NSA_SEL + 64 * 8, NSA_GLS = NSA_IMPF + 4 * 64 * 4, NSA_END = NSA_GLS + 3 * 512 * 4;
static_assert(NSA_END <= MISC_OFF && 128 * NSA_KP <= 3 * NSA_SLOT && 128 * NSA_VP <= 4 * NSA_SLOT, "nsa lds");
__device__ __forceinline__ void glds16(const void* g, unsigned lds_base) {
    unsigned sv; asm volatile("s_mov_b32 %0, m0\n\ts_mov_b32 m0, %2\n\ts_nop 0\n\tglobal_load_lds_dwordx4 %1, off\n\ts_mov_b32 m0, %0" : "=&s"(sv) : "v"(g), "s"(lds_base) : "memory"); }

__device__ __forceinline__ float max3f(float a, float b, float c) { float r; asm("v_max3_f32 %0, %1, %2, %3" : "=v"(r) : "v"(a), "v"(b), "v"(c)); return r; }
__device__ __forceinline__ float max2f(float a, float b) { float r; asm("v_max_f32_e32 %0, %1, %2" : "=v"(r) : "v"(a), "v"(b)); return r; }
constexpr float NSA_THR = 8.f;
__device__ __forceinline__ void nsa_qk(f32x16& p0, f32x16& p1, const f32x16& negm, const bf16x8 (&q)[4], LAS const unsigned char* Kt, int r32, int hi, int tl, bool on, int mode) {
    f32x16 c0;
#pragma unroll
    for (int r = 0; r < 16; ++r) c0[r] = on ? negm[r] : NEGBIG;
    bf16x8 kf[8];
#pragma unroll
    for (int d0 = 0; d0 < 4; ++d0) { kf[2 * d0] = *(LAS const bf16x8*)(Kt + d0 * 2048 + hi * 1024 + r32 * 16); kf[2 * d0 + 1] = *(LAS const bf16x8*)(Kt + d0 * 2048 + hi * 1024 + 512 + r32 * 16); }
    __builtin_amdgcn_sched_barrier(0);
#pragma unroll
    for (int d0 = 0; d0 < 4; ++d0) {
        if (d0 == 0) { p0 = MFMA32(kf[0], q[0], c0); p1 = MFMA32(kf[1], q[0], c0); } else { p0 = MFMA32(kf[2 * d0], q[d0], p0); p1 = MFMA32(kf[2 * d0 + 1], q[d0], p1); }
    }
    if (mode != 0) {
        asm volatile("" : "+v"(tl));
        const int lo = (mode == 2) ? tl : 0, hb = (mode == 1) ? tl : 63;
#pragma unroll
        for (int r = 0; r < 16; ++r) { const int kk = crow(r, hi);
            p0[r] = (kk >= lo && kk <= hb) ? p0[r] : NEGBIG; p1[r] = (kk + 32 >= lo && kk + 32 <= hb) ? p1[r] : NEGBIG; }
    }
}
__device__ __forceinline__ void nsa_sv(f32x16 (&o)[2], f32x16& negm, float& m, float& l, f32x16& p0, f32x16& p1, LAS const unsigned char* Vt, int hi, int vb) {
    float mx = max3f(p0[0], p0[1], p1[0]), mb = max3f(p0[2], p0[3], p1[1]); mx = max3f(mx, p1[2], p1[3]);
#pragma unroll
    for (int r = 4; r < 16; r += 4) { mx = max3f(mx, p0[r], p0[r + 1]); mb = max3f(mb, p0[r + 2], p0[r + 3]); mx = max3f(mx, p1[r], p1[r + 1]); mb = max3f(mb, p1[r + 2], p1[r + 3]); }
    mx = xor32_max(max2f(mx, mb));
    if (__any(mx > NSA_THR)) {
        const float d = fmaxf(mx, 0.f), alpha = __builtin_amdgcn_exp2f(-d);
        m += d; l *= alpha;
#pragma unroll
        for (int r = 0; r < 16; ++r) { p0[r] -= d; p1[r] -= d; o[0][r] *= alpha; o[1][r] *= alpha; negm[r] = -m; }
    }
    f32x2 rs0 = {0.f, 0.f}, rs1 = {0.f, 0.f};
#pragma unroll
    for (int r = 0; r < 16; r += 2) {
        p0[r] = __builtin_amdgcn_exp2f(p0[r]); p0[r + 1] = __builtin_amdgcn_exp2f(p0[r + 1]); p1[r] = __builtin_amdgcn_exp2f(p1[r]); p1[r + 1] = __builtin_amdgcn_exp2f(p1[r + 1]);
        rs0 += (f32x2){p0[r], p0[r + 1]}; rs1 += (f32x2){p1[r], p1[r + 1]};
    }
    l += (rs0.x + rs0.y) + (rs1.x + rs1.y);
#pragma unroll
    for (int s = 0; s < 4; ++s) {
        const bf16x8 pb = pack_frag(s < 2 ? p0 : p1, 8 * (s & 1));
#pragma unroll
        for (int db = 0; db < 2; ++db) {
            const bf16x8 vf = cat8(ds_tr(Vt + db * 4096 + s * 1024 + vb), ds_tr(Vt + db * 4096 + s * 1024 + 512 + vb));
            o[db] = MFMA32(vf, pb, o[db]);
        }
    }
}

__device__ __forceinline__ void nsa_prompt_unit(const Args& A, LAS unsigned char* lds, int b, int kvh, int qb, int tid, int lane, int wave) {
    unsigned char* ws = A.ws;
    asm volatile("" : "+v"(tid), "+v"(lane));
    const int r32 = lane & 31, hi = lane >> 5, g = wave & 3, qs = wave >> 2, hq = kvh * 4 + g, tl = 32 * qs + r32, q0 = 64 * qb, t = q0 + tl;
    const size_t rowb = (size_t)b * SEQ, row = rowb + t;
    const int tro = tr_off(lane, NSA_VP);
    LAS unsigned char* KT = lds + NSA_KT; LAS unsigned char* VT = lds + NSA_VT;
    LAS float* IMP = (LAS float*)(lds + NSA_IMP); LAS unsigned long long* SEL = (LAS unsigned long long*)(lds + NSA_SEL); LAS float* IMPF = (LAS float*)(lds + NSA_IMPF); LAS float* GLS = (LAS float*)(lds + NSA_GLS);
    const int lrow = tid & 63, lch = tid >> 6;
    __syncthreads();
    {
        const bf16* kc = (const bf16*)(ws + WS_KCP) + ((size_t)b * 128) * 128 + kvh * 64 + lch * 8; const bf16* vc = (const bf16*)(ws + WS_VCP) + ((size_t)b * 128) * 128 + kvh * 64 + lch * 8;
#pragma unroll
        for (int i = 0; i < 2; ++i) { const int rr = lrow + 64 * i;
            *(LAS u32x4*)(KT + rr * NSA_KP + lch * 16) = *(const u32x4*)(kc + (size_t)rr * 128);
            *(LAS u32x4*)(VT + rr * NSA_VP + lch * 16) = *(const u32x4*)(vc + (size_t)rr * 128); }
    }
    bf16x8 qr[4];
    f32x16 otot[2];
    const float* glp = (const float*)(ws + WS_GL) + row * 32 + hq;
    {
        bf16x8 qn[4];
        const bf16* qp = (const bf16*)(ws + WS_QN) + CM(hq * 64 + 8 * hi, row);
#pragma unroll
        for (int d0 = 0; d0 < 4; ++d0) qn[d0] = *(const bf16x8*)(qp + (size_t)d0 * (2 * NTOK * 8));
        { const float ga = glp[0], gb = glp[8], gc = glp[16]; GLS[tid] = ga; GLS[512 + tid] = gb; GLS[1024 + tid] = gc; }
        __syncthreads();
        const int ntile = (qb >= 31) ? 2 : 1, nvalid = (t + 1) >> 5;
        float mx = MINIT;
#pragma unroll 1
        for (int pt = 0; pt < 2 * ntile; ++pt) {
            f32x16 p = f32x16{};
#pragma unroll
            for (int d0 = 0; d0 < 4; ++d0) { const bf16x8 kf = *(LAS const bf16x8*)(KT + (32 * pt + r32) * NSA_KP + (16 * d0 + 8 * hi) * 2); p = MFMA32(kf, qn[d0], p); }
#pragma unroll
            for (int r = 0; r < 16; ++r) { const int cidx = 32 * pt + crow(r, hi); mx = fmaxf(mx, (cidx < nvalid) ? p[r] : NEGBIG); }
        }
        mx = xor32_max(mx);
        float ls = 0.f;
        f32x16 oc[2]; oc[0] = f32x16{}; oc[1] = f32x16{};
        LAS float* ip = IMP + (g * 64 + tl) * 65;
#pragma unroll 1
        for (int pt = 0; pt < 4; ++pt) {
            f32x16 p = f32x16{};
            if (pt < 2 * ntile) {
#pragma unroll
                for (int d0 = 0; d0 < 4; ++d0) { const bf16x8 kf = *(LAS const bf16x8*)(KT + (32 * pt + r32) * NSA_KP + (16 * d0 + 8 * hi) * 2); p = MFMA32(kf, qn[d0], p); }
            }
#pragma unroll
            for (int r = 0; r < 16; ++r) { const int cidx = 32 * pt + crow(r, hi); p[r] = (cidx < nvalid) ? __builtin_amdgcn_exp2f(p[r] - mx) : 0.f; ls += p[r]; }
#pragma unroll
            for (int r = 1; r < 16; r += 2) ip[16 * pt + (crow(r - 1, hi) >> 1)] = p[r - 1] + p[r];
            if (pt < 2 * ntile) {
#pragma unroll
                for (int s2 = 0; s2 < 2; ++s2) {
                    const bf16x8 pb = pack_frag(p, 8 * s2);
                    const int j0 = 32 * pt + 16 * s2 + 4 * hi;
#pragma unroll
                    for (int db = 0; db < 2; ++db) { const bf16x8 vf = cat8(ds_tr(VT + j0 * NSA_VP + 64 * db + tro), ds_tr(VT + (j0 + 8) * NSA_VP + 64 * db + tro)); oc[db] = MFMA32(vf, pb, oc[db]); }
                }
            }
        }
        ls = xor32_sum(ls);
        const float inv = ls > 0.f ? 1.f / ls : 0.f;
        if (hi == 0) IMPF[g * 64 + tl] = inv;
#pragma unroll
        for (int r = 0; r < 16; ++r) { oc[0][r] *= inv; oc[1][r] *= inv; }
        const float g0 = GLS[tid];
#pragma unroll
        for (int r = 0; r < 16; ++r) { otot[0][r] = g0 * oc[0][r]; otot[1][r] = g0 * oc[1][r]; }
    }
    __syncthreads();
#pragma unroll 1
    for (int q4 = 0; q4 < 8; q4 += 4) {
        unsigned key[4], thr[4];
#pragma unroll
        for (int u = 0; u < 4; ++u) {
            const int tq = 8 * wave + q4 + u;
            const float imp = (IMP[(0 * 64 + tq) * 65 + lane] * IMPF[tq] + IMP[(1 * 64 + tq) * 65 + lane] * IMPF[64 + tq]) + (IMP[(2 * 64 + tq) * 65 + lane] * IMPF[128 + tq] + IMP[(3 * 64 + tq) * 65 + lane] * IMPF[192 + tq]);
            const bool forced = (lane == 0) || (lane == qb), valid = lane <= qb;
            key[u] = forced ? 0xFFFFFFFFu : (valid ? (__builtin_bit_cast(unsigned, imp) | 0x80000000u) : 0u);
            thr[u] = 0u;
        }
#pragma unroll 2
        for (int bit = 31; bit >= 0; --bit) {
#pragma unroll
            for (int u = 0; u < 4; ++u) { const unsigned cand = thr[u] | (1u << bit); if (__popcll(__ballot(key[u] >= cand)) >= 16) thr[u] = cand; }
        }
#pragma unroll
        for (int u = 0; u < 4; ++u) {
            const int tq = 8 * wave + q4 + u;
            const unsigned long long mgt = __ballot(key[u] > thr[u]), meq = __ballot(key[u] == thr[u]);
            const int need = 16 - __popcll(mgt);
            const int below = __builtin_amdgcn_mbcnt_hi((unsigned)(meq >> 32), __builtin_amdgcn_mbcnt_lo((unsigned)meq, 0u));
            const unsigned long long mask = mgt | __ballot(key[u] == thr[u] && below < need);
            if (lane == 0) SEL[tq] = mask;
        }
    }
    __syncthreads();
    LAS float* park = IMP + tid;
#pragma unroll
    for (int r = 0; r < 16; ++r) { park[r * 512] = otot[0][r]; park[(16 + r) * 512] = otot[1][r]; }
    { const bf16* qp2 = (const bf16*)(ws + WS_QROT) + CM(hq * 64 + 8 * hi, row);
#pragma unroll
      for (int d0 = 0; d0 < 4; ++d0) qr[d0] = *(const bf16x8*)(qp2 + (size_t)d0 * (2 * NTOK * 8)); }
    const unsigned long long sel = SEL[tl];
    const int jw0 = qb > 8 ? qb - 8 : 0, nB = qb + 1, NT = nB + (qb - jw0 + 1);
    const int wv = __builtin_amdgcn_readfirstlane(wave);
    const size_t kso = CM(kvh * 64 + wv * 8, rowb + lane), vso = CM(kvh * 64 + (wv >> 2) * 32 + (lane & 3) * 8, rowb + 16 * (wv & 3) + (lane >> 2));
    const bf16* ksb = (const bf16*)(ws + WS_KS) + kso; const bf16* vsb = (const bf16*)(ws + WS_VS) + vso;
    const bf16* kwb = (const bf16*)(ws + WS_KW) + kso; const bf16* vwb = (const bf16*)(ws + WS_VW) + vso;
    const unsigned kdst = (unsigned)(size_t)(lds + NSA_KT) + wv * 1024, vdst = (unsigned)(size_t)(lds + NSA_VT) + wv * 1024;
    const int vb = ((lane >> 4) & 1) * 32 + (lane & 3) * 8 + (4 * hi + ((lane & 15) >> 2)) * 64;
    f32x16 o[2]; o[0] = f32x16{}; o[1] = f32x16{};
    f32x16 negm = f32x16{};
    float m = 0.f, l = 0.f;
    const bool trail = qs != 0;
    f32x16 p0, p1; bool pend = false; int pend_v = 0, ks = 0;
#define NSA_DMA(T, KSL) do { const int t_ = ((T) < NT) ? (T) : NT - 1; const bool sl_ = t_ < nB; const int j_ = sl_ ? t_ : jw0 + (t_ - nB); \
        glds16((sl_ ? ksb : kwb) + (size_t)j_ * 512, (unsigned)__builtin_amdgcn_readfirstlane(kdst + (KSL) * NSA_SLOT)); \
        glds16((sl_ ? vsb : vwb) + (size_t)j_ * 512, (unsigned)__builtin_amdgcn_readfirstlane(vdst + ((T) & 3) * NSA_SLOT)); } while (0)
    asm volatile("" : "+v"(qr[0]), "+v"(qr[1]), "+v"(qr[2]), "+v"(qr[3]));
    NSA_DMA(0, 0); NSA_DMA(1, 1);
    if (trail) __builtin_amdgcn_s_setprio(1);
#pragma unroll 1
    for (int n = 0; n < NT; ++n) {
        asm volatile("s_waitcnt vmcnt(2) lgkmcnt(0)\n\ts_barrier" ::: "memory");
        const int ks2 = (ks == 0) ? 2 : ks - 1;
        NSA_DMA(n + 2, ks2);
        LAS unsigned char* kt = KT + ks * NSA_SLOT; LAS unsigned char* vt = VT + (n & 3) * NSA_SLOT;
        if (pend) { nsa_sv(o, negm, m, l, p0, p1, VT + pend_v, hi, vb); pend = false; }
        if (n == nB) {
            const float lt = xor32_sum(l), sc = GLS[512 + tid] / lt;
#pragma unroll
            for (int r = 0; r < 16; ++r) { park[r * 512] += sc * o[0][r]; park[(16 + r) * 512] += sc * o[1][r]; }
            o[0] = f32x16{}; o[1] = f32x16{}; negm = f32x16{}; m = 0.f; l = 0.f;
        }
        const bool slc = n < nB; const int j = slc ? n : jw0 + (n - nB);
        const bool on = slc ? (bool)((sel >> n) & 1ull) : true;
        const bool act = __any(on);
        const int mode = (j == qb) ? 1 : ((!slc && j == qb - 8) ? 2 : 0);
        if (act) nsa_qk(p0, p1, negm, qr, kt, r32, hi, tl, on, mode);
        if (trail) { pend = act; pend_v = (n & 3) * NSA_SLOT; }
        else if (act) nsa_sv(o, negm, m, l, p0, p1, vt, hi, vb);
        ks = (ks == 2) ? 0 : ks + 1;
    }
#undef NSA_DMA
    __builtin_amdgcn_s_setprio(0);
    asm volatile("s_waitcnt vmcnt(0)" ::: "memory");
    if (pend) nsa_sv(o, negm, m, l, p0, p1, VT + pend_v, hi, vb);
    {
        const float lt = xor32_sum(l), sc = GLS[1024 + tid] / lt;
#pragma unroll
        for (int r = 0; r < 16; ++r) { otot[0][r] = park[r * 512] + sc * o[0][r]; otot[1][r] = park[(16 + r) * 512] + sc * o[1][r]; }
    }
    const bf16* ngp = (const bf16*)(ws + WS_NG); bf16* yp = (bf16*)(ws + WS_YMIX) + row * 1024 + 512 + hq * 64;
    u32x2 ngv[2][4];
#pragma unroll
    for (int db = 0; db < 2; ++db)
#pragma unroll
        for (int q = 0; q < 4; ++q) ngv[db][q] = *(const u32x2*)(ngp + CM(hq * 64 + 32 * db + 8 * q + 4 * hi, row));
#pragma unroll
    for (int db = 0; db < 2; ++db)
#pragma unroll
        for (int q = 0; q < 4; ++q) {
            const int d = 32 * db + 8 * q + 4 * hi;
            const u32x2 ng = ngv[db][q];
            u32x2 ov; ov.x = pk2(otot[db][4 * q] * bflo(ng.x), otot[db][4 * q + 1] * bfhi(ng.x)); ov.y = pk2(otot[db][4 * q + 2] * bflo(ng.y), otot[db][4 * q + 3] * bfhi(ng.y));
            *(u32x2*)(yp + d) = ov;
        }
}

template <int CTRL> __device__ __forceinline__ float dpp_add(float v) { return v + __builtin_bit_cast(float, __builtin_amdgcn_update_dpp(0, __builtin_bit_cast(int, v), CTRL, 0xf, 0xf, true)); }
__device__ __forceinline__ float red16(float v) { v = dpp_add<0xB1>(v); v = dpp_add<0x4E>(v); v = dpp_add<0x141>(v); v = dpp_add<0x140>(v); return v; }
__device__ __forceinline__ float dot4(const f32x4 a, const f32x4 b) { return (a.x * b.x + a.y * b.y) + (a.z * b.z + a.w * b.w); }

__device__ __forceinline__ void dec_block(float (&m)[4], float (&l)[4], f32x4 (&o)[4], const f32x4 (&q)[4], const float* Kb, const float* Vb, int lo, int hi_, int kk) {
#pragma unroll 1
    for (int hb = 0; hb < 2; ++hb) {
        if (32 * hb >= hi_ || 32 * hb + 32 <= lo) continue;
        f32x4 kr[8], vr[8]; float s[8][4];
#pragma unroll
        for (int it = 0; it < 8; ++it) { const int key = 32 * hb + 4 * it + kk; const int kc = (key >= lo && key < hi_) ? key : lo; kr[it] = *(const f32x4*)(Kb + (size_t)kc * 128); }
#pragma unroll
        for (int it = 0; it < 8; ++it) { const int key = 32 * hb + 4 * it + kk; const bool valid = key >= lo && key < hi_; const int kc = valid ? key : lo;
            vr[it] = *(const f32x4*)(Vb + (size_t)kc * 128);
#pragma unroll
            for (int g = 0; g < 4; ++g) { const float d = red16(dot4(q[g], kr[it])); s[it][g] = valid ? d : NEGBIG; } }
#pragma unroll
        for (int g = 0; g < 4; ++g) {
            float mx = s[0][g];
#pragma unroll
            for (int it = 1; it < 8; ++it) mx = fmaxf(mx, s[it][g]);
            mx = fmaxf(mx, __shfl_xor(mx, 16)); mx = fmaxf(mx, __shfl_xor(mx, 32));
            const float mn = fmaxf(m[g], mx), alpha = __builtin_amdgcn_exp2f(m[g] - mn);
            m[g] = mn; l[g] *= alpha; o[g] = o[g] * alpha;
#pragma unroll
            for (int it = 0; it < 8; ++it) { const float p = __builtin_amdgcn_exp2f(s[it][g] - mn); l[g] += p; o[g] = o[g] + vr[it] * p; }
        }
    }
}
__device__ __forceinline__ void dec_publish(const float (&m)[4], float (&l)[4], f32x4 (&o)[4], LAS float* st, LAS float* ob, int wave, int lane) {
#pragma unroll
    for (int g = 0; g < 4; ++g) {
        l[g] += __shfl_xor(l[g], 16); l[g] += __shfl_xor(l[g], 32);
#pragma unroll
        for (int e = 0; e < 4; ++e) { float x = o[g][e]; x += __shfl_xor(x, 16); x += __shfl_xor(x, 32); o[g][e] = x; }
        if (lane < 16) *(LAS f32x4*)(ob + (wave * 4 + g) * 64 + 4 * lane) = o[g];
        if (lane == 0) { st[(wave * 4 + g) * 2] = m[g]; st[(wave * 4 + g) * 2 + 1] = l[g]; }
    }
}
__device__ __forceinline__ float dec_combine(LAS const float* st, LAS const float* ob, int g, int d) {
    float M = NEGBIG;
#pragma unroll
    for (int w = 0; w < 8; ++w) M = fmaxf(M, st[(w * 4 + g) * 2]);
    float L = 0.f, O = 0.f;
#pragma unroll
    for (int w = 0; w < 8; ++w) { const float f = exp2f(st[(w * 4 + g) * 2] - M); L += f * st[(w * 4 + g) * 2 + 1]; O += f * ob[(w * 4 + g) * 64 + d]; }
    return L > 0.f ? O / L : 0.f;
}

__device__ __forceinline__ void nsa_decode_unit(const Args& A, LAS unsigned char* lds, int unit, int tid, int lane, int wave) {
    unsigned char* ws = A.ws;
    const int b = unit >> 4, kvh = (unit >> 3) & 1, t = unit & 7, kk = lane >> 4, dq = lane & 15;
    const size_t row = (size_t)NP + b * 8 + t;
    LAS float* sc = (LAS float*)lds;
    LAS float* scr = sc + 2048;
    LAS int* selL = (LAS int*)(scr + 260);
    LAS float* ocmp = (LAS float*)(selL + 16);
    LAS float* st1 = ocmp + 2048; LAS float* ob1 = st1 + 64;
    LAS float* st2 = ob1 + 2048; LAS float* ob2 = st2 + 64;
    f32x4 qn[4], qr[4];
#pragma unroll
    for (int g = 0; g < 4; ++g) {
        const u32x2 a = *(const u32x2*)((const bf16*)(ws + WS_QN) + CM((kvh * 4 + g) * 64 + 4 * dq, row)), c = *(const u32x2*)((const bf16*)(ws + WS_QROT) + CM((kvh * 4 + g) * 64 + 4 * dq, row));
        qn[g] = (f32x4){bflo(a.x), bfhi(a.x), bflo(a.y), bfhi(a.y)}; qr[g] = (f32x4){bflo(c.x), bfhi(c.x), bflo(c.y), bfhi(c.y)};
    }
    __syncthreads();
    const float* kcs = (const float*)(ws + WS_KCS) + ((size_t)b * 512 * 2 + kvh) * 64 + 4 * dq; const float* vcs = (const float*)(ws + WS_VCS) + ((size_t)b * 512 * 2 + kvh) * 64 + 4 * dq;
    f32x4 krr[16];
#pragma unroll
    for (int it = 0; it < 16; ++it) krr[it] = *(const f32x4*)(kcs + (size_t)(64 * wave + 4 * it + kk) * 128);
#pragma unroll
    for (int it = 0; it < 16; ++it) {
        const int key = 64 * wave + 4 * it + kk;
        const f32x4 kr = krr[it];
        const float s0 = red16(dot4(qn[0], kr)), s1 = red16(dot4(qn[1], kr)), s2 = red16(dot4(qn[2], kr)), s3 = red16(dot4(qn[3], kr));
        if (dq < 4) sc[dq * 512 + key] = dq == 0 ? s0 : dq == 1 ? s1 : dq == 2 ? s2 : s3;
    }
    __syncthreads();
    if (wave < 4) {
        float v[8], mx = NEGBIG;
#pragma unroll
        for (int i = 0; i < 8; ++i) { v[i] = sc[wave * 512 + lane + 64 * i]; mx = fmaxf(mx, v[i]); }
        mx = wave_max(mx); float sm = 0.f;
#pragma unroll
        for (int i = 0; i < 8; ++i) { v[i] = __builtin_amdgcn_exp2f(v[i] - mx); sm += v[i]; }
        sm = wave_sum(sm); const float inv = 1.f / sm;
#pragma unroll
        for (int i = 0; i < 8; ++i) sc[wave * 512 + lane + 64 * i] = v[i] * inv;
    }
    __syncthreads();
    if (tid < 256) { float s = -1.f; if (tid > 0) s = (sc[2 * tid] + sc[2 * tid + 1]) + (sc[512 + 2 * tid] + sc[512 + 2 * tid + 1]) + ((sc[1024 + 2 * tid] + sc[1024 + 2 * tid + 1]) + (sc[1536 + 2 * tid] + sc[1536 + 2 * tid + 1])); scr[tid] = s; }
    {
        f32x4 oc[4]; oc[0] = oc[1] = oc[2] = oc[3] = (f32x4){0.f, 0.f, 0.f, 0.f};
        f32x4 vrr[16];
#pragma unroll
        for (int it = 0; it < 16; ++it) vrr[it] = *(const f32x4*)(vcs + (size_t)(64 * wave + 4 * it + kk) * 128);
#pragma unroll
        for (int it = 0; it < 16; ++it) {
            const int key = 64 * wave + 4 * it + kk;
            const f32x4 vr = vrr[it];
#pragma unroll
            for (int g = 0; g < 4; ++g) oc[g] = oc[g] + vr * sc[g * 512 + key];
        }
#pragma unroll
        for (int g = 0; g < 4; ++g) {
#pragma unroll
            for (int e = 0; e < 4; ++e) { float x = oc[g][e]; x += __shfl_xor(x, 16); x += __shfl_xor(x, 32); oc[g][e] = x; }
            if (lane < 16) *(LAS f32x4*)(ocmp + (wave * 4 + g) * 64 + 4 * lane) = oc[g];
        }
    }
    __syncthreads();
    {
        LAS int* rk = (LAS int*)ob1;
        const int c = tid & 255, half = tid >> 8; const float s = scr[c]; int rank = 0;
#pragma unroll 8
        for (int j4 = 0; j4 < 32; ++j4) { const f32x4 v = *(LAS const f32x4*)(scr + 128 * half + 4 * j4);
#pragma unroll
            for (int e = 0; e < 4; ++e) { const int j = 128 * half + 4 * j4 + e; rank += (v[e] > s || (v[e] == s && j < c)) ? 1 : 0; } }
        rk[tid] = rank;
        __syncthreads();
        if (tid > 0 && tid < 256) { const int r2 = rk[tid] + rk[tid + 256]; if (r2 < 14) selL[2 + r2] = tid; }
        if (tid == 0) { selL[0] = 0; selL[1] = 256; }
    }
    __syncthreads();
    {
        float m[4], l[4]; f32x4 o[4];
#pragma unroll
        for (int g = 0; g < 4; ++g) { m[g] = MINIT; l[g] = 0.f; o[g] = (f32x4){0.f, 0.f, 0.f, 0.f}; }
        const int bb0 = selL[2 * wave], bb1 = selL[2 * wave + 1];
        const int pg0 = ((const int*)A.in[I_PT])[b * 128 + ((bb0 < 256 ? bb0 : 0) >> 1)], pg1 = ((const int*)A.in[I_PT])[b * 128 + ((bb1 < 256 ? bb1 : 0) >> 1)];
#pragma unroll 1
        for (int i = 0; i < 2; ++i) {
            const int bb = i ? bb1 : bb0, pg = i ? pg1 : pg0;
            const bool past = bb < 256;
            const size_t base = past ? ((size_t)pg * 128 + (bb & 1) * 64) * 128 + kvh * 64 + 4 * dq : ((size_t)b * 8) * 128 + kvh * 64 + 4 * dq;
            const float* Kb = (past ? (const float*)A.in[I_CSK] : (const float*)(A.out + O_SLCK_S)) + base;
            const float* Vb = (past ? (const float*)A.in[I_CSV] : (const float*)(A.out + O_SLCV_S)) + base;
            dec_block(m, l, o, qr, Kb, Vb, 0, past ? 64 : t + 1, kk);
        }
        dec_publish(m, l, o, st1, ob1, wave, lane);
    }
    {
        float m[4], l[4]; f32x4 o[4];
#pragma unroll
        for (int g = 0; g < 4; ++g) { m[g] = MINIT; l[g] = 0.f; o[g] = (f32x4){0.f, 0.f, 0.f, 0.f}; }
#pragma unroll 1
        for (int i = 0; i < ((wave == 0) ? 2 : 1); ++i) {
            const size_t base = ((size_t)b * 512 + (i ? 504 : 64 * wave)) * 128 + kvh * 64 + 4 * dq;
            const float* Kb = (i ? (const float*)(A.out + O_WINK_S) : (const float*)A.in[I_SWK]) + base;
            const float* Vb = (i ? (const float*)(A.out + O_WINV_S) : (const float*)A.in[I_SWV]) + base;
            const int lo = i ? 0 : ((t > 64 * wave) ? (t - 64 * wave) : 0);
            dec_block(m, l, o, qr, Kb, Vb, lo, i ? t + 1 : 64, kk);
        }
        dec_publish(m, l, o, st2, ob2, wave, lane);
    }
    __syncthreads();
    if (tid < 256) {
        const int g = tid >> 6, d = tid & 63, hq = kvh * 4 + g;
        float oc = 0.f;
#pragma unroll
        for (int w = 0; w < 8; ++w) oc += ocmp[(w * 4 + g) * 64 + d];
        const float os = dec_combine(st1, ob1, g, d), ow = dec_combine(st2, ob2, g, d);
        const float* glp = (const float*)(ws + WS_GL) + row * 32 + hq;
        const float y = (glp[0] * oc + glp[8] * os + glp[16] * ow) * bf2f(((const bf16*)(ws + WS_NG))[CM(hq * 64 + d, row)]);
        ((bf16*)(ws + WS_YMIX))[row * 1024 + 512 + hq * 64 + d] = (bf16)f2bf(y);
    }
    __syncthreads();
}

struct EpiPle {
    static constexpr bool PERM = true, AFTER_DRAIN = false;
    unsigned char* ws;
    __device__ __forceinline__ void operator()(const pg8::f32x4 (&acc)[2][2][4][2], const pg8::Unit& u, int wr, int wc, int fr, int fq) const {
        asm volatile("" : "+v"(fr), "+v"(fq));
#pragma unroll
        for (int ai = 0; ai < 2; ++ai)
#pragma unroll
            for (int m = 0; m < 4; ++m) {
                const size_t row = (size_t)u.pm * 256 + ai * 128 + wr * 64 + m * 16 + fr;
#pragma unroll
                for (int bj = 0; bj < 2; ++bj) { bf16* d = (bf16*)(ws + WS_PPO) + row * 1024 + u.pn * 256 + bj * 128 + wc * 32 + 8 * fq;
                    const f32x4 a = acc[ai][bj][m][0], c = acc[ai][bj][m][1];
                    u32x4 w; w.x = pk2(a.x, a.y); w.y = pk2(a.z, a.w); w.z = pk2(c.x, c.y); w.w = pk2(c.z, c.w); *(u32x4*)d = w; }
            }
    }
};
struct EpiOut {
    static constexpr bool PERM = true, AFTER_DRAIN = false;
    unsigned char* ws; const float* xp; const float* xs;
    __device__ __forceinline__ void operator()(const pg8::f32x4 (&acc)[2][2][4][2], const pg8::Unit& u, int wr, int wc, int fr, int fq) const {
        asm volatile("" : "+v"(fr), "+v"(fq));
#pragma unroll
        for (int ai = 0; ai < 2; ++ai)
#pragma unroll
            for (int m = 0; m < 4; ++m) {
                const size_t row = (size_t)u.pm * 256 + ai * 128 + wr * 64 + m * 16 + fr;
                const float* xrow = (row < NP) ? xp + row * 1024 : xs + (row - NP) * 1024;
                float ss = 0.f;
#pragma unroll
                for (int bj = 0; bj < 2; ++bj) { const int col = u.pn * 256 + bj * 128 + wc * 32 + 8 * fq;
                    const f32x4 a = *(const f32x4*)(xrow + col) + acc[ai][bj][m][0], c = *(const f32x4*)(xrow + col + 4) + acc[ai][bj][m][1];
                    u32x4 w; w.x = pk2(a.x, a.y); w.y = pk2(a.z, a.w); w.z = pk2(c.x, c.y); w.w = pk2(c.z, c.w);
                    *(u32x4*)((bf16*)(ws + WS_X1B) + row * 1024 + col) = w;
                    ss += (a.x * a.x + a.y * a.y) + (a.z * a.z + a.w * a.w) + (c.x * c.x + c.y * c.y) + (c.z * c.z + c.w * c.w); }
                ss += __shfl_xor(ss, 16); ss += __shfl_xor(ss, 32);
                if (fq == 0) ((float*)(ws + WS_SS1))[row * 16 + u.pn * 4 + wc] = ss;
            }
    }
};
__device__ __forceinline__ void panel_meet(unsigned* cnt, unsigned expect, int tid) {
    asm volatile("s_waitcnt vmcnt(0)" ::: "memory");
    __syncthreads();
    if (tid == 0) {
        __hip_atomic_fetch_add(cnt, 1u, __ATOMIC_RELAXED, __HIP_MEMORY_SCOPE_AGENT);
        unsigned sp = 0;
        while (__hip_atomic_load(cnt, __ATOMIC_RELAXED, __HIP_MEMORY_SCOPE_AGENT) < expect) { __builtin_amdgcn_s_sleep(1); if (++sp > (1u << 22)) break; }
    }
    __syncthreads();
}
struct EpiGateNorm {
    static constexpr bool PERM = true, AFTER_DRAIN = false;
    unsigned char* ws; float* out; const float* nf;
    __device__ __forceinline__ void operator()(const pg8::f32x4 (&acc_)[2][2][4][2], const pg8::Unit& u, int wr, int wc, int fr, int fq) const {
        pg8::f32x4 (&acc)[2][2][4][2] = const_cast<pg8::f32x4 (&)[2][2][4][2]>(acc_);
        asm volatile("" : "+v"(fr), "+v"(fq));
#pragma unroll
        for (int ai = 0; ai < 2; ++ai)
#pragma unroll
            for (int m = 0; m < 4; ++m) {
                const size_t row = (size_t)u.pm * 256 + ai * 128 + wr * 64 + m * 16 + fr;
                const f32x4* sp = (const f32x4*)((const float*)(ws + WS_SS1) + row * 16);
                const f32x4 s0 = sp[0], s1 = sp[1], s2 = sp[2], s3 = sp[3];
                const float tot = ((s0.x + s0.y) + (s0.z + s0.w)) + ((s1.x + s1.y) + (s1.z + s1.w)) + (((s2.x + s2.y) + (s2.z + s2.w)) + ((s3.x + s3.y) + (s3.z + s3.w)));
                const float rstd = 1.f / sqrtf(tot * (1.f / 1024.f) + RMS_EPS);
                float ss = 0.f;
#pragma unroll
                for (int bj = 0; bj < 2; ++bj) { const int col = u.pn * 256 + bj * 128 + wc * 32 + 8 * fq;
                    const u32x4 xb = *(const u32x4*)((const bf16*)(ws + WS_X1B) + row * 1024 + col), pb = *(const u32x4*)((const bf16*)(ws + WS_PPO) + row * 1024 + col);
                    f32x4 a = {bflo(xb.x), bfhi(xb.x), bflo(xb.y), bfhi(xb.y)}, c = {bflo(xb.z), bfhi(xb.z), bflo(xb.w), bfhi(xb.w)};
                    const f32x4 pa = {bflo(pb.x), bfhi(pb.x), bflo(pb.y), bfhi(pb.y)}, pc = {bflo(pb.z), bfhi(pb.z), bflo(pb.w), bfhi(pb.w)};
#pragma unroll
                    for (int e = 0; e < 4; ++e) { a[e] += sigmoidf_(rstd * acc[ai][bj][m][0][e]) * pa[e]; c[e] += sigmoidf_(rstd * acc[ai][bj][m][1][e]) * pc[e]; }
                    acc[ai][bj][m][0] = a; acc[ai][bj][m][1] = c;
                    ss += (a.x * a.x + a.y * a.y) + (a.z * a.z + a.w * a.w) + (c.x * c.x + c.y * c.y) + (c.z * c.z + c.w * c.w); }
                ss += __shfl_xor(ss, 16); ss += __shfl_xor(ss, 32);
                if (fq == 0) __hip_atomic_store((float*)(ws + WS_SS2) + row * 16 + u.pn * 4 + wc, ss, __ATOMIC_RELAXED, __HIP_MEMORY_SCOPE_AGENT);
            }
        panel_meet((unsigned*)(ws + WS_CTL) + 16384 + 64 * u.pm, 4u, (int)threadIdx.x);
#pragma unroll
        for (int ai = 0; ai < 2; ++ai)
#pragma unroll
            for (int m = 0; m < 4; ++m) {
                const size_t row = (size_t)u.pm * 256 + ai * 128 + wr * 64 + m * 16 + fr;
                float* sp = (float*)(ws + WS_SS2) + row * 16 + 4 * fq;
                float tot = (__hip_atomic_load(sp, __ATOMIC_RELAXED, __HIP_MEMORY_SCOPE_AGENT) + __hip_atomic_load(sp + 1, __ATOMIC_RELAXED, __HIP_MEMORY_SCOPE_AGENT))
                          + (__hip_atomic_load(sp + 2, __ATOMIC_RELAXED, __HIP_MEMORY_SCOPE_AGENT) + __hip_atomic_load(sp + 3, __ATOMIC_RELAXED, __HIP_MEMORY_SCOPE_AGENT));
                tot += __shfl_xor(tot, 16); tot += __shfl_xor(tot, 32);
                const float rstd2 = 1.f / sqrtf(tot * (1.f / 1024.f) + RMS_EPS);
#pragma unroll
                for (int bj = 0; bj < 2; ++bj) { const int col = u.pn * 256 + bj * 128 + wc * 32 + 8 * fq;
                    const f32x4 g0 = *(const f32x4*)(nf + col), g1 = *(const f32x4*)(nf + col + 4);
                    float* d = out + O_Y + row * 1024 + col; *(f32x4*)d = acc[ai][bj][m][0] * rstd2 * g0; *(f32x4*)(d + 4) = acc[ai][bj][m][1] * rstd2 * g1; }
            }
    }
};
__device__ __forceinline__ void final_norm(const Args& A, int lane, int wave) {
    const int gw = blockIdx.x * 8 + wave, NGW = gridDim.x * 8;
    const f32x4* nf = (const f32x4*)A.in[I_NF];
    f32x4 g[4];
#pragma unroll
    for (int j = 0; j < 4; ++j) g[j] = nf[64 * j + lane];
    for (int row = gw; row < NTOK; row += NGW) {
        float tot = 0.f;
        if (row < NP) { const float* sp = (const float*)(A.ws + WS_SS2) + (size_t)row * 16;
#pragma unroll
            for (int i = 0; i < 16; ++i) tot += sp[i]; }
        else tot = wave_sum(lane < 32 ? ((const float*)(A.ws + WS_SS2D))[(size_t)(row - NP) * 32 + lane] : 0.f);
        const float rstd = 1.f / sqrtf(tot * (1.f / 1024.f) + RMS_EPS);
        f32x4* y = (f32x4*)(A.out + O_Y + (size_t)row * 1024) + lane;
#pragma unroll
        for (int j = 0; j < 4; ++j) { f32x4 v = y[64 * j]; v = v * rstd * g[j]; y[64 * j] = v; }
    }
}

template <int K, class Epi>
__device__ __forceinline__ void mini_gemm_unit(LAS unsigned char* lds, const bf16* A, int lda, const bf16* Bt, int rowblk, int colblk, const Epi& E, int tid, int lane, int wave) {
    const int row0 = rowblk * 128 + wave * 16, fr = lane & 15, fq = lane >> 4, col0 = colblk * 32;
    constexpr int BP = K * 2 + 16, CPR = K / 8;
    __syncthreads();
#pragma unroll
    for (int i = 0; i < 32 * CPR / 512; ++i) { const int q = tid + 512 * i, c = q / CPR, ch = q % CPR;
        *(LAS u32x4*)(lds + c * BP + ch * 16) = *(const u32x4*)(Bt + (size_t)(col0 + c) * K + ch * 8); }
    const bf16* a = A + (size_t)(row0 + fr) * lda + 8 * fq;
    LAS const unsigned char* b0 = lds + fr * BP + 16 * fq;
    __syncthreads();
    f32x4 c0 = {0.f, 0.f, 0.f, 0.f}, c1 = {0.f, 0.f, 0.f, 0.f};
#pragma unroll 8
    for (int s = 0; s < K / 32; ++s) {
        const bf16x8 av = *(const bf16x8*)(a + 32 * s), bv0 = *(LAS const bf16x8*)(b0 + 64 * s), bv1 = *(LAS const bf16x8*)(b0 + 16 * BP + 64 * s);
        c0 = __builtin_amdgcn_mfma_f32_16x16x32_bf16(av, bv0, c0, 0, 0, 0);
        c1 = __builtin_amdgcn_mfma_f32_16x16x32_bf16(av, bv1, c1, 0, 0, 0);
    }
    E(row0 + 4 * fq, col0 + fr, colblk, c0, c1, fr);
}
struct EpiNgl { unsigned char* ws;
    __device__ __forceinline__ void operator()(int r0, int col, int cb, const f32x4& c0, const f32x4& c1, int fr) const {
        float* gl = (float*)(ws + WS_GL);
#pragma unroll
        for (int i = 0; i < 4; ++i) { gl[(size_t)(r0 + i) * 32 + col] = sigmoidf_(c0[i]); gl[(size_t)(r0 + i) * 32 + col + 16] = sigmoidf_(c1[i]); } } };
struct DEpiPle { unsigned char* ws;
    __device__ __forceinline__ void operator()(int r0, int col, int cb, const f32x4& c0, const f32x4& c1, int fr) const {
#pragma unroll
        for (int i = 0; i < 4; ++i) { bf16* d = (bf16*)(ws + WS_PPO) + (size_t)(NP + r0 + i) * 1024 + col; d[0] = (bf16)f2bf(c0[i]); d[16] = (bf16)f2bf(c1[i]); } } };
struct DEpiOut { unsigned char* ws; const float* xs;
    __device__ __forceinline__ void operator()(int r0, int col, int cb, const f32x4& c0, const f32x4& c1, int fr) const {
#pragma unroll
        for (int i = 0; i < 4; ++i) { const size_t rd = r0 + i, row = NP + rd;
            const float a = xs[rd * 1024 + col] + c0[i], c = xs[rd * 1024 + col + 16] + c1[i];
            bf16* db = (bf16*)(ws + WS_X1B) + row * 1024 + col; db[0] = (bf16)f2bf(a); db[16] = (bf16)f2bf(c);
            const float ss = red16(a * a + c * c);
            if (fr == 0) ((float*)(ws + WS_SS1D))[rd * 32 + cb] = ss; } } };
struct DEpiGate { unsigned char* ws; float* out; const float* nf;
    __device__ __forceinline__ void operator()(int r0, int col, int cb, const f32x4& c0, const f32x4& c1, int fr) const {
        float va[4], vc[4];
#pragma unroll
        for (int i = 0; i < 4; ++i) { const size_t rd = r0 + i, row = NP + rd;
            const float* sp = (const float*)(ws + WS_SS1D) + rd * 32;
            const float tot = red16(sp[fr] + sp[16 + fr]), rstd = 1.f / sqrtf(tot * (1.f / 1024.f) + RMS_EPS);
            const bf16* x1 = (const bf16*)(ws + WS_X1B) + row * 1024 + col; const bf16* pp = (const bf16*)(ws + WS_PPO) + row * 1024 + col;
            va[i] = bf2f(x1[0]) + sigmoidf_(rstd * c0[i]) * bf2f(pp[0]); vc[i] = bf2f(x1[16]) + sigmoidf_(rstd * c1[i]) * bf2f(pp[16]);
            const float ss = red16(va[i] * va[i] + vc[i] * vc[i]);
            if (fr == 0) __hip_atomic_store((float*)(ws + WS_SS2D) + rd * 32 + cb, ss, __ATOMIC_RELAXED, __HIP_MEMORY_SCOPE_AGENT); }
        panel_meet((unsigned*)(ws + WS_CTL) + 32768 + 64 * (r0 >> 7), 32u, (int)threadIdx.x);
#pragma unroll
        for (int i = 0; i < 4; ++i) { const size_t rd = r0 + i, row = NP + rd;
            float* sp = (float*)(ws + WS_SS2D) + rd * 32;
            const float tot = red16(__hip_atomic_load(sp + fr, __ATOMIC_RELAXED, __HIP_MEMORY_SCOPE_AGENT) + __hip_atomic_load(sp + 16 + fr, __ATOMIC_RELAXED, __HIP_MEMORY_SCOPE_AGENT));
            const float rstd2 = 1.f / sqrtf(tot * (1.f / 1024.f) + RMS_EPS);
            float* d = out + O_Y + row * 1024 + col; d[0] = va[i] * rstd2 * nf[col]; d[16] = vc[i] * rstd2 * nf[col + 16]; } } };

constexpr int N_PHASES = 7;
#ifndef REP_PHASE
#define REP_PHASE -1
#endif
#ifndef MK_SINGLE
#define MK_SINGLE 1
#endif
__global__ void __launch_bounds__(512, 2) mega_fwd(Args args) {
    extern __shared__ __attribute__((aligned(16))) unsigned char lds_raw[];
    LAS unsigned char* lds = (LAS unsigned char*)lds_raw;
    const int tid = threadIdx.x, lane = tid & 63, wave = __builtin_amdgcn_readfirstlane(tid >> 6);
    volatile LAS unsigned* MISC = (volatile LAS unsigned*)(lds + MISC_OFF);
    if (tid < 64) MISC[tid] = 0u;
    {
        unsigned long long pc0; unsigned clen;
        asm volatile("mk_code_start:\n\ts_getpc_b64 %0\n\ts_mov_b32 %1, mk_code_end-mk_code_start" : "=s"(pc0), "=s"(clen));
        const unsigned char* cbase = (const unsigned char*)pc0;
        f32x4 wacc = {0.f, 0.f, 0.f, 0.f};
        for (unsigned off = (unsigned)((blockIdx.x >> 3) * 512 + tid) * 16u; off + 16u <= clen; off += ((gridDim.x + 7u) >> 3) * 512u * 16u) wacc += *(const volatile f32x4*)(cbase + off);
        if (wacc.x == 1.2345678e30f) MISC[63] = 1u;
    }
    __syncthreads();
    const int lo = args.ph_lo, hi = args.ph_hi;
    XcdBarrier bar; bar.bar = (unsigned*)(args.ws + WS_CTL) + CW_BAR; bar.x = 0; bar.st = nullptr;
    if (hi - lo > 1) bar = xcd_barrier_post((unsigned*)(args.ws + WS_CTL) + CW_BAR, MISC + 8);
#ifndef PH_MASK
#define PH_MASK 0xFF
#endif
#define IN(k) (((PH_MASK >> (k)) & 1) && lo <= (k) && (k) < hi)
#define SEAM(k) do { if (IN(k) && IN((k) + 1)) xcd_barrier(bar); } while (0)
    unsigned char* ws = args.ws;
    const int G = gridDim.x, bx = blockIdx.x;
#ifndef STAMP_A
#define STAMP_A -1
#define STAMP_B -1
#endif
#define STAMP(k) do { if (STAMP_A >= 0 && tid == 0) { const unsigned long long t_ = __builtin_amdgcn_s_memrealtime(); MISC[16 + 2 * (k)] = (unsigned)t_; MISC[17 + 2 * (k)] = (unsigned)(t_ >> 32); } } while (0)
    STAMP(0);

    if (IN(0)) { phase0(args, lds, tid, lane, wave); }
    SEAM(0); STAMP(1);
    if (IN(1)) {
#ifndef P1_REP_PARTS
#define P1_REP_PARTS 7
#endif
        const int p1m = args.rep ? P1_REP_PARTS : 7;
        const bool cfirst = (bx & 1) != 0;
        if (cfirst) { if (p1m & 4) for (int u = bx; u < 512; u += G) compress_unit<true>(args, lds, u, tid, lane, wave); }
        __syncthreads();
        if (p1m & 1) { pg8::Gemm g{(const pg8::bf16_t*)(ws + WS_H), (const pg8::bf16_t*)(ws + WS_WINT), NTOK, NPR, DM}; pg8::StaticOrder S; S.init(NTOK, NPR, G, bx);
          EpiInProj E{ws, args.out};
          pg8::gemm_phase<EpiInProj, pg8::StaticOrder, true, true>(lds, g, S, E); }
        if (p1m & 2) {
            const int nun = (NTOK / 256) * (NPR / 256), fl = (nun % G) ? (nun % G) : 0, nl = G - fl;
            if (bx >= fl) for (int u = bx - fl; u < NTOK / 128; u += nl) { EpiNgl E{ws}; mini_gemm_unit<1024>(lds, (const bf16*)(ws + WS_H), 1024, (const bf16*)(ws + WS_WNGLT), u, 0, E, tid, lane, wave); } }
        if (!cfirst) { if (p1m & 4) for (int u = bx; u < 512; u += G) compress_unit<true>(args, lds, u, tid, lane, wave); }
    }
    SEAM(1); STAMP(2);
    if (IN(2)) {
#ifndef P2_REP_PARTS
#define P2_REP_PARTS 15
#endif
        const int p2m = args.rep ? P2_REP_PARTS : 15;
        const int GW = (G > 32) ? G - 16 : G; const bool worker = bx < GW;
        if ((p2m & 1) && worker) { int kple = 256; asm volatile("" : "+s"(kple));
          pg8::Gemm g{(const pg8::bf16_t*)(ws + WS_PB), (const pg8::bf16_t*)(ws + WS_WPLET), NP, 1024, kple}; pg8::StaticOrder S; S.init(NP, 1024, GW, (bx + GW - 128) % GW);
          EpiPle E{ws};
          pg8::gemm_phase<EpiPle, pg8::StaticOrder, true, true>(lds, g, S, E); }
        for (int u = G - 17 - bx; u >= 0 && u < 64; u += G) { DEpiPle E{ws}; mini_gemm_unit<256>(lds, (const bf16*)(ws + WS_PB) + (size_t)NP * 256, 256, (const bf16*)(ws + WS_WPLET), u >> 5, u & 31, E, tid, lane, wave); }
        if (p2m & 2) for (int u = G - 1 - bx; u < 16; u += G) compress_unit<false>(args, lds, u, tid, lane, wave);
        if ((p2m & 4) && worker) for (int u = (bx + GW - 144) % GW; u < 512; u += GW) ret_pass1_unit(ws, lds, u, tid, lane, wave);
        if (p2m & 8) for (int u = bx; u < 128; u += G) ret_decode_unit(args, lds, u, tid, lane, wave);
    }
    SEAM(2); STAMP(3);
    if (IN(3)) {
#ifndef P3_REP_PARTS
#define P3_REP_PARTS 7
#endif
        const int p3m = args.rep ? P3_REP_PARTS : 7;
        if (p3m & 1) ret_pass2(args, tid);
        const bool dfirst = ((bx >> 5) & 1) != 0;
        if (dfirst && (p3m & 4)) for (int u = bx; u < 512; u += G) { const int w = u & 255, grp = (w & 7) + 8 * (w >> 5), tt = 2 * ((w >> 3) & 3) + (u >> 8);
            nsa_decode_unit(args, lds, grp * 8 + tt, tid, lane, wave); }
        if (p3m & 2) for (int pi = bx; pi < 512; pi += G) { const int pr = pi & 255, b = (pr & 7) >> 1, kvh = pr & 1, s = pr >> 3;
            nsa_prompt_unit(args, lds, b, kvh, (pi >= 256) ? s : 63 - s, tid, lane, wave); }
        if (!dfirst && (p3m & 4)) for (int u = bx; u < 512; u += G) { const int w = u & 255, grp = (w & 7) + 8 * (w >> 5), tt = 2 * ((w >> 3) & 3) + (u >> 8);
            nsa_decode_unit(args, lds, grp * 8 + tt, tid, lane, wave); }
    }
    SEAM(3); STAMP(4);
    if (IN(4)) {
        for (int u = bx; u < 512; u += G) ret_pass3_unit(args, lds, u, tid, lane, wave);
        for (int u = G - 1 - bx; u < 64; u += G) { DEpiOut E{ws, (const float*)args.in[I_XS]}; mini_gemm_unit<1024>(lds, (const bf16*)(ws + WS_YMIX) + (size_t)NP * 1024, 1024, (const bf16*)(ws + WS_WOUTT), u >> 5, u & 31, E, tid, lane, wave); }
    }
    SEAM(4); STAMP(5);
    if (IN(5)) {
        pg8::Gemm g{(const pg8::bf16_t*)(ws + WS_YMIX), (const pg8::bf16_t*)(ws + WS_WOUTT), NP, 1024, 1024}; pg8::StaticOrder S; S.init(NP, 1024, G, bx);
        EpiOut E{ws, (const float*)args.in[I_XP], (const float*)args.in[I_XS]};
        pg8::gemm_phase<EpiOut, pg8::StaticOrder, true, true>(lds, g, S, E);
        for (int u = G - 1 - bx; u < 64; u += G) { DEpiGate E2{ws, args.out, (const float*)args.in[I_NF]}; mini_gemm_unit<1024>(lds, (const bf16*)(ws + WS_X1B) + (size_t)NP * 1024, 1024, (const bf16*)(ws + WS_WGT), u >> 5, u & 31, E2, tid, lane, wave); }
    }
    SEAM(5); STAMP(6);
    if (IN(6)) {
        pg8::Gemm g{(const pg8::bf16_t*)(ws + WS_X1B), (const pg8::bf16_t*)(ws + WS_WGT), NP, 1024, 1024}; pg8::StaticOrder S; S.init(NP, 1024, G, bx);
        EpiGateNorm E{ws, args.out, (const float*)args.in[I_NF]};
        pg8::gemm_phase<EpiGateNorm, pg8::StaticOrder, true, true>(lds, g, S, E);
    }
    if (STAMP_A >= 0) { STAMP(8); if (bx == 0 && tid == 0) {
        const unsigned a0 = MISC[16 + 2 * STAMP_A], a1 = MISC[16 + 2 * (STAMP_A + 1)], b0 = MISC[16 + 2 * STAMP_B], b1 = MISC[16 + 2 * (STAMP_B + 1)];
        __builtin_amdgcn_s_waitcnt(0);
        args.out[O_Y] = 10.f * (float)(a1 - a0); args.out[O_Y + (size_t)NP * 1024] = 10.f * (float)(b1 - b0); } }
#undef IN
#undef SEAM
    asm volatile("mk_code_end:");
}

extern "C" void kernel_launch(void* const* d_in, const int* in_sizes, int n_in, void* d_out, int out_size, void* d_ws, size_t ws_size, hipStream_t stream) {
    static int grid = 0;
    if (grid == 0) {
        if (n_in != N_IN || out_size != (int)O_END || ws_size < WS_END) { fprintf(stderr, "kernel_launch: unexpected shapes (n_in %d, out %d, ws %zu); nothing launched\n", n_in, out_size, ws_size); grid = -1; return; }
        int dev = 0, cus = 0, per_cu = 0;
        if (hipGetDevice(&dev) != hipSuccess || hipDeviceGetAttribute(&cus, hipDeviceAttributeMultiprocessorCount, dev) != hipSuccess) { grid = -1; return; }
        if (hipFuncSetAttribute((const void*)mega_fwd, hipFuncAttributeMaxDynamicSharedMemorySize, LDS_BYTES) != hipSuccess) { fprintf(stderr, "kernel_launch: hipFuncSetAttribute failed\n"); grid = -1; return; }
        if (hipOccupancyMaxActiveBlocksPerMultiprocessor(&per_cu, (const void*)mega_fwd, 512, LDS_BYTES) != hipSuccess || per_cu < 1) { fprintf(stderr, "kernel_launch: occupancy query says %d blocks per CU\n", per_cu); }
        (void)hipGetLastError();
        grid = cus;
    }
    if (grid < 0) return;
    (void)hipMemsetAsync((char*)d_ws + WS_CTL, 0, CTL_ZERO_BYTES, stream);
    Args a{};
    for (int i = 0; i < N_IN; ++i) a.in[i] = d_in[i];
    a.out = (float*)d_out; a.ws = (unsigned char*)d_ws;
    a.rep = 0; a.pad = 0;
#if MK_SINGLE
    a.ph_lo = 0; a.ph_hi = N_PHASES;
    hipLaunchKernelGGL(mega_fwd, dim3(grid), dim3(512), LDS_BYTES, stream, a);
#else
    for (int p = 0; p < N_PHASES; ++p) { a.ph_lo = p; a.ph_hi = p + 1;
        for (int r = 0; r < ((p == REP_PHASE) ? 2 : 1); ++r) { a.rep = r; hipLaunchKernelGGL(mega_fwd, dim3(grid), dim3(512), LDS_BYTES, stream, a); } }
#endif
}
```

```cpp
#include <hip/hip_runtime.h>
#include <cstdio>
#include <cstdint>
namespace pg8 {
#define PG8_LAS __attribute__((address_space(3)))
typedef unsigned short bf16_t;
typedef short bf16x8 __attribute__((ext_vector_type(8)));
typedef float f32x4 __attribute__((ext_vector_type(4)));
typedef unsigned u32x4 __attribute__((ext_vector_type(4)));
constexpr int BM = 256, BK = 64, HALF = 128, HTB = HALF * BK * 2  , STAGE_BYTES = 8 * HTB, NXCD = 8, WGM = 8;

__host__ __device__ __forceinline__ int lds_byte(int r, int c) { const int st = (r >> 4) * 2 + (c >> 5), rr = r & 15, cc = c & 31, ob = rr * 64 + cc * 2; return st * 1024 + (ob ^ (((ob >> 9) & 1) << 5)); }
__host__ __device__ __forceinline__ void stage_rc(int b, int& R, int& C) { const int st = b / 1024, sb = b % 1024, swz = sb ^ (((sb >> 9) & 1) << 5); R = (st >> 1) * 16 + swz / 64; C = (st & 1) * 32 + (swz % 64) / 2; }
__host__ __device__ __forceinline__ int perm32(int rho) { const int n = rho >> 4, i = rho & 15; return 8 * (i >> 2) + 4 * n + (i & 3); }

struct Unit { int pm, pn; };
struct Gemm { const bf16_t* A; const bf16_t* Bt; int M, N, K; };

struct StaticOrder {
    int nM, nN, nwg, G, c;
    __host__ __device__ void init(int M, int N, int G_, int c_) { nM = M / BM; nN = N / BM; nwg = nM * nN; G = G_; c = c_; }
    __host__ __device__ bool next(int i, Unit& u) const {
        const long L = (long)i * G + c; if (L >= nwg) return false;
        int wgid = (int)L; { const int q = nwg / NXCD, r = nwg % NXCD, xcd = wgid % NXCD, off = wgid / NXCD; wgid = (xcd < r ? xcd * (q + 1) : r * (q + 1) + (xcd - r) * q) + off; }
        const int nig = WGM * nN, gid = wgid / nig, fm = gid * WGM, gsz = (nM - fm) < WGM ? (nM - fm) : WGM;
        u.pm = fm + ((wgid % nig) % gsz); u.pn = (wgid % nig) / gsz; return true;
    }
    __device__ __forceinline__ void a_ready(const Unit&) const {}
    __device__ __forceinline__ void done(const Unit&) const {}
};
template <class Epi, class Sched, bool ALIGN_EPI = false, bool SP2 = false>
__device__ __forceinline__ void gemm_phase(PG8_LAS unsigned char* lds, const Gemm g, const Sched& S, const Epi& E) {
    const int tid = threadIdx.x, wid = __builtin_amdgcn_readfirstlane(tid >> 6), lane = tid & 63, wr = wid >> 2, wc = wid & 3, fr = lane & 15, fq = lane >> 4;
    const int K = g.K, nt = K / BK;
    unsigned voffA[2], voffB[2];
#pragma unroll
    for (int i = 0; i < 2; ++i) { int R, C; stage_rc(tid * 16 + i * 8192, R, C); const int Rb = Epi::PERM ? ((R & ~31) + perm32(R & 31)) : R;
        voffA[i] = (unsigned)(R * K + C) * 2u; voffB[i] = (unsigned)(Rb * K + C) * 2u; }
    const size_t kstep = (size_t)(BK * 2);
    const size_t hstep = (size_t)HALF * K * 2;
    const size_t tstep = 2 * hstep;
    const unsigned ldsw = (unsigned)wid * 1024u;
    const int aoff = lds_byte(wr * 64 + fr, fq * 8), boff = lds_byte(wc * 32 + fr, fq * 8);
#define PG8_SA(b, h) (((b) * 2 + (h)) * HTB)
#define PG8_SB(b, h) ((4 + (b) * 2 + (h)) * HTB)
#define PG8_STAGE(bufoff, gbase, voff) do { _Pragma("unroll") for (int _i = 0; _i < 2; ++_i) \
        __builtin_amdgcn_global_load_lds((const unsigned*)((const char*)(gbase) + (voff)[_i]), (PG8_LAS unsigned*)(lds + (bufoff) + ldsw + _i * 8192), 16, 0, 0); } while (0)
#define PG8_LDA(dst, b, h) do { _Pragma("unroll") for (int m = 0; m < 4; ++m) _Pragma("unroll") for (int k = 0; k < 2; ++k) dst[m][k] = *(const PG8_LAS bf16x8*)(lds + PG8_SA(b, h) + aoff + m * 2048 + k * 1024); } while (0)
#define PG8_LDB(dst, b, h) do { _Pragma("unroll") for (int n = 0; n < 2; ++n) _Pragma("unroll") for (int k = 0; k < 2; ++k) dst[n][k] = *(const PG8_LAS bf16x8*)(lds + PG8_SB(b, h) + boff + n * 2048 + k * 1024); } while (0)
#define PG8_MMA(ai, bj, At, Bt) do { __builtin_amdgcn_s_setprio(1); _Pragma("unroll") for (int m = 0; m < 4; ++m) _Pragma("unroll") for (int n = 0; n < 2; ++n) _Pragma("unroll") for (int k = 0; k < 2; ++k) \
        acc[ai][bj][m][n] = __builtin_amdgcn_mfma_f32_16x16x32_bf16(Bt[n][k], At[m][k], acc[ai][bj][m][n], 0, 0, 0); __builtin_amdgcn_s_setprio(0); } while (0)
#define PG8_WAIT_V(n) asm volatile("s_waitcnt vmcnt(" #n ")" ::: "memory")
#define PG8_WAIT_L(n) asm volatile("s_waitcnt lgkmcnt(" #n ")" ::: "memory")
#define PG8_BAR __builtin_amdgcn_s_barrier()
#define PG8_SCHED __builtin_amdgcn_sched_barrier(0)
    Unit cur, nxt; int ui = 0;
    if (!S.next(0, cur)) return;
    f32x4 acc[2][2][4][2];
#pragma unroll
    for (int a = 0; a < 2; ++a)
#pragma unroll
        for (int b = 0; b < 2; ++b)
#pragma unroll
            for (int m = 0; m < 4; ++m)
#pragma unroll
                for (int n = 0; n < 2; ++n) acc[a][b][m][n] = (f32x4){0.f, 0.f, 0.f, 0.f};
    bf16x8 At[4][2], B0[2][2], B1[2][2];
    const char* cA = (const char*)g.A + (size_t)cur.pm * tstep; const char* cB = (const char*)g.Bt + (size_t)cur.pn * tstep;
    S.a_ready(cur);
    if constexpr (SP2) {
        PG8_STAGE(PG8_SB(0, 0), cB, voffB); PG8_STAGE(PG8_SB(0, 1), cB + hstep, voffB); PG8_STAGE(PG8_SA(0, 0), cA, voffA); PG8_STAGE(PG8_SA(0, 1), cA + hstep, voffA);
        if (wr == 1) PG8_BAR;
        PG8_WAIT_V(2); PG8_BAR;
        PG8_STAGE(PG8_SB(1, 0), cB + kstep, voffB); PG8_STAGE(PG8_SA(1, 0), cA + kstep, voffA); PG8_STAGE(PG8_SB(1, 1), cB + hstep + kstep, voffB);
        PG8_WAIT_V(6); PG8_BAR;
    } else {
        PG8_STAGE(PG8_SB(0, 0), cB, voffB); PG8_STAGE(PG8_SA(0, 0), cA, voffA); PG8_STAGE(PG8_SB(0, 1), cB + hstep, voffB); PG8_STAGE(PG8_SA(0, 1), cA + hstep, voffA);
        if (wr == 1) PG8_BAR;
        PG8_WAIT_V(4); PG8_BAR;
        PG8_STAGE(PG8_SB(1, 0), cB + kstep, voffB); PG8_STAGE(PG8_SA(1, 0), cA + kstep, voffA); PG8_STAGE(PG8_SB(1, 1), cB + hstep + kstep, voffB);
        PG8_WAIT_V(6); PG8_BAR;
    }
    for (;;) {
        const bool has_next = S.next(ui + 1, nxt);
        const char* nA = has_next ? (const char*)g.A + (size_t)nxt.pm * tstep : cA; const char* nB = has_next ? (const char*)g.Bt + (size_t)nxt.pn * tstep : cB;
        for (int t = 0; t < nt; t += 2) {
            const bool last = (t == nt - 2);
            const char* a1 = cA + (size_t)(t + 1) * kstep;
            const char* a2 = last ? nA : cA + (size_t)(t + 2) * kstep; const char* b2 = last ? nB : cB + (size_t)(t + 2) * kstep;
            const char* a3 = a2 + kstep; const char* b3 = b2 + kstep;
            if (last && has_next) S.a_ready(nxt);
            if constexpr (SP2) {
            PG8_LDB(B0, 0, 0); PG8_LDB(B1, 0, 1); PG8_SCHED; PG8_LDA(At, 0, 0); PG8_STAGE(PG8_SA(1, 1), a1 + hstep, voffA);
            PG8_WAIT_V(8); PG8_WAIT_L(0); PG8_BAR; PG8_MMA(0, 0, At, B0); PG8_MMA(0, 1, At, B1); PG8_BAR; PG8_SCHED;
            PG8_LDA(At, 0, 1); PG8_STAGE(PG8_SB(0, 0), b2, voffB); PG8_STAGE(PG8_SB(0, 1), b2 + hstep, voffB); PG8_STAGE(PG8_SA(0, 0), a2, voffA);
            PG8_WAIT_V(8); PG8_WAIT_L(0); PG8_BAR; PG8_MMA(1, 0, At, B0); PG8_MMA(1, 1, At, B1); PG8_BAR; PG8_SCHED;
            PG8_LDB(B0, 1, 0); PG8_LDB(B1, 1, 1); PG8_SCHED; PG8_LDA(At, 1, 0); PG8_STAGE(PG8_SA(0, 1), a2 + hstep, voffA);
            PG8_WAIT_V(8); PG8_WAIT_L(0); PG8_BAR; PG8_MMA(0, 0, At, B0); PG8_MMA(0, 1, At, B1); PG8_BAR; PG8_SCHED;
            PG8_LDA(At, 1, 1); PG8_STAGE(PG8_SB(1, 0), b3, voffB); PG8_STAGE(PG8_SB(1, 1), b3 + hstep, voffB); PG8_STAGE(PG8_SA(1, 0), a3, voffA);
            PG8_WAIT_V(8); PG8_WAIT_L(0); PG8_BAR; PG8_MMA(1, 0, At, B0); PG8_MMA(1, 1, At, B1); PG8_BAR; PG8_SCHED;
            } else {
            PG8_LDB(B0, 0, 0); PG8_SCHED; PG8_LDA(At, 0, 0); PG8_STAGE(PG8_SA(1, 1), a1 + hstep, voffA);
            PG8_WAIT_L(8); PG8_BAR; PG8_WAIT_L(0); PG8_MMA(0, 0, At, B0); PG8_BAR; PG8_SCHED;
            PG8_LDB(B1, 0, 1); PG8_STAGE(PG8_SB(0, 0), b2, voffB);
            PG8_BAR; PG8_WAIT_L(0); PG8_MMA(0, 1, At, B1); PG8_BAR;
            PG8_LDA(At, 0, 1); PG8_STAGE(PG8_SA(0, 0), a2, voffA);
            PG8_BAR; PG8_WAIT_L(0); PG8_MMA(1, 0, At, B0); PG8_BAR; PG8_SCHED;
            PG8_STAGE(PG8_SB(0, 1), b2 + hstep, voffB);
            PG8_WAIT_V(6); PG8_BAR; PG8_MMA(1, 1, At, B1); PG8_BAR;
            PG8_LDB(B0, 1, 0); PG8_SCHED; PG8_LDA(At, 1, 0); PG8_STAGE(PG8_SA(0, 1), a2 + hstep, voffA);
            PG8_WAIT_L(8); PG8_BAR; PG8_WAIT_L(0); PG8_MMA(0, 0, At, B0); PG8_BAR; PG8_SCHED;
            PG8_LDB(B1, 1, 1); PG8_STAGE(PG8_SB(1, 0), b3, voffB);
            PG8_BAR; PG8_WAIT_L(0); PG8_MMA(0, 1, At, B1); PG8_BAR;
            PG8_LDA(At, 1, 1); PG8_STAGE(PG8_SA(1, 0), a3, voffA);
            PG8_BAR; PG8_WAIT_L(0); PG8_MMA(1, 0, At, B0); PG8_BAR; PG8_SCHED;
            PG8_STAGE(PG8_SB(1, 1), b3 + hstep, voffB);
            PG8_WAIT_V(6); PG8_BAR; PG8_MMA(1, 1, At, B1); PG8_BAR;
            }
        }
        if constexpr (ALIGN_EPI) { if (wr == 0) PG8_BAR; }
        if constexpr (!Epi::AFTER_DRAIN) { E(acc, cur, wr, wc, fr, fq); S.done(cur); }
        if (!has_next) break;
#pragma unroll
        for (int a = 0; a < 2; ++a)
#pragma unroll
            for (int b = 0; b < 2; ++b)
#pragma unroll
                for (int m = 0; m < 4; ++m)
#pragma unroll
                    for (int n = 0; n < 2; ++n) acc[a][b][m][n] = (f32x4){0.f, 0.f, 0.f, 0.f};
        cur = nxt; cA = nA; cB = nB; ++ui;
        if constexpr (ALIGN_EPI) { if (wr == 1) PG8_BAR; }
    }
    PG8_WAIT_V(0);
    if constexpr (!ALIGN_EPI) { if (wr == 0) PG8_BAR; }
    PG8_BAR;
    if constexpr (Epi::AFTER_DRAIN) { E.fused(acc, cur, wr, wc, fr, fq, lds, wid, lane); S.done(cur); }
#undef PG8_SA
#undef PG8_SB
#undef PG8_STAGE
#undef PG8_LDA
#undef PG8_LDB
#undef PG8_MMA
#undef PG8_WAIT_V
#undef PG8_WAIT_L
#undef PG8_BAR
#undef PG8_SCHED
}
}

#define GAS __attribute__((address_space(1)))
#define LAS __attribute__((address_space(3)))
typedef unsigned short bf16;
typedef short bf16x8 __attribute__((ext_vector_type(8)));
typedef short s16x4 __attribute__((ext_vector_type(4)));
typedef float f32x2 __attribute__((ext_vector_type(2)));
typedef float f32x4 __attribute__((ext_vector_type(4)));
typedef float f32x16 __attribute__((ext_vector_type(16)));
typedef unsigned u32x2 __attribute__((ext_vector_type(2)));
typedef unsigned u32x4 __attribute__((ext_vector_type(4)));
typedef __bf16 bf16x2_t __attribute__((ext_vector_type(2)));

constexpr int NP = 16384, ND = 256, NTOK = NP + ND;
constexpr int SEQ = 4096, NBATCH = 4, DBATCH = 32, DSEQ = 8, PAST = 16384;
constexpr int DM = 1024, NPR = 3840, PROJW = 3864;
constexpr int NPOS = SEQ + DSEQ;
constexpr float C2 = 0.125f * 1.4426950408889634f;
constexpr float RMS_EPS = 1e-6f, GN_EPS = 1e-5f;
constexpr float NEGBIG = -1e30f, MINIT = -1e4f;

constexpr size_t O_Y = 0;
constexpr size_t O_RETP = (size_t)NTOK * 1024;
constexpr size_t O_CMPK_P = O_RETP + 4 * 4 * 128 * 128;
constexpr size_t O_CMPV_P = O_CMPK_P + (size_t)NP * 128;
constexpr size_t O_SLCK_P = O_CMPV_P + (size_t)NP * 128;
constexpr size_t O_SLCV_P = O_SLCK_P + (size_t)NP * 128;
constexpr size_t O_WINK_P = O_SLCV_P + (size_t)NP * 128;
constexpr size_t O_WINV_P = O_WINK_P + 4 * 512 * 128;
constexpr size_t O_RETS = O_WINV_P + 4 * 512 * 128;
constexpr size_t O_CMPK_S = O_RETS + (size_t)32 * 4 * 128 * 128;
constexpr size_t O_CMPV_S = O_CMPK_S + ND * 128;
constexpr size_t O_SLCK_S = O_CMPV_S + ND * 128;
constexpr size_t O_SLCV_S = O_SLCK_S + ND * 128;
constexpr size_t O_WINK_S = O_SLCV_S + ND * 128;
constexpr size_t O_WINV_S = O_WINK_S + (size_t)32 * 512 * 128;
constexpr size_t O_END = O_WINV_S + (size_t)32 * 512 * 128;
static_assert(O_END == 32636928, "output size");

enum { I_XP = 0, I_XS, I_CCK, I_CCV, I_CSK, I_CSV, I_SWK, I_SWV, I_SRET, I_PT, I_PP, I_PS, I_NMIX, I_WIN, I_GNG, I_GNB, I_PEK, I_W1K, I_W2K, I_PEV, I_W1V, I_W2V, I_WOUT, I_NPLE, I_WG, I_WPLE, I_NF, N_IN };

constexpr size_t MiB = 1u << 20;
constexpr size_t WS_CTL = 0, CTL_ZERO_BYTES = 1 * MiB;
constexpr size_t WS_COSR = 1 * MiB;
constexpr size_t WS_SINR = WS_COSR + (size_t)NPOS * 64 * 4;
constexpr size_t WS_COSN = WS_SINR + (size_t)NPOS * 64 * 4;
constexpr size_t WS_SINN = WS_COSN + (size_t)NPOS * 32 * 4;
constexpr size_t WS_CBIAS = 5 * MiB;
constexpr size_t WS_W2T = WS_CBIAS + 65536;
constexpr size_t WS_W1T = 6 * MiB;
constexpr size_t WS_WINT = 8 * MiB;
constexpr size_t WS_WNGLT = 16 * MiB;
constexpr size_t WS_WOUTT = 17 * MiB;
constexpr size_t WS_WGT = 19 * MiB;
constexpr size_t WS_WPLET = 21 * MiB;
constexpr size_t WS_H = 24 * MiB;
constexpr size_t WS_PB = 57 * MiB;
constexpr size_t WS_QR = 66 * MiB, WS_KR = 83 * MiB, WS_VR = 100 * MiB, WS_RG = 117 * MiB, WS_QN = 134 * MiB, WS_QROT = 151 * MiB, WS_NG = 168 * MiB;
constexpr size_t WS_KS = 185 * MiB, WS_VS = 190 * MiB, WS_KW = 195 * MiB, WS_VW = 200 * MiB;
constexpr size_t WS_GL = 205 * MiB;
constexpr size_t WS_KCP = 208 * MiB, WS_VCP = WS_KCP + 131072;
constexpr size_t WS_KCS = 209 * MiB, WS_VCS = 217 * MiB;
constexpr size_t WS_KVT = 225 * MiB;
constexpr size_t WS_ST = 257 * MiB;
constexpr size_t WS_YMIX = 273 * MiB;
constexpr size_t WS_X1 = 306 * MiB;
constexpr size_t WS_X1B = 371 * MiB;
constexpr size_t WS_PPO = 404 * MiB;
constexpr size_t WS_SS1 = 469 * MiB;
constexpr size_t WS_SS2 = 471 * MiB;
constexpr size_t WS_SS1D = 473 * MiB, WS_SS2D = WS_SS1D + 65536;
constexpr size_t WS_END = 474 * MiB;
constexpr int CW_BAR = 4096;

constexpr int LDS_BYTES = 147456;
constexpr int MISC_OFF = LDS_BYTES - 256;

#define CM(col, row) (((size_t)((col) >> 3) * NTOK + (size_t)(row)) * 8 + ((col) & 7))
struct Args { const void* in[N_IN]; float* out; unsigned char* ws; int ph_lo, ph_hi, rep, pad; };

__device__ __forceinline__ unsigned f2bf(float f) { unsigned u = __builtin_bit_cast(unsigned, f); return (u + 0x7fffu + ((u >> 16) & 1u)) >> 16; }
__device__ __forceinline__ unsigned pk2(float lo, float hi) { f32x2 v = {lo, hi}; bf16x2_t b = __builtin_convertvector(v, bf16x2_t); return __builtin_bit_cast(unsigned, b); }
__device__ __forceinline__ float bflo(unsigned u) { return __builtin_bit_cast(float, u << 16); }
__device__ __forceinline__ float bfhi(unsigned u) { return __builtin_bit_cast(float, u & 0xffff0000u); }
__device__ __forceinline__ float bf2f(bf16 h) { return __builtin_bit_cast(float, (unsigned)h << 16); }
__device__ __forceinline__ u32x4 pack8(const float* v) { u32x4 w; w.x = pk2(v[0], v[1]); w.y = pk2(v[2], v[3]); w.z = pk2(v[4], v[5]); w.w = pk2(v[6], v[7]); return w; }
__device__ __forceinline__ float wave_sum(float v) {
#pragma unroll
    for (int o = 1; o < 64; o <<= 1) v += __shfl_xor(v, o);
    return v;
}
__device__ __forceinline__ float wave_max(float v) {
#pragma unroll
    for (int o = 1; o < 64; o <<= 1) v = fmaxf(v, __shfl_xor(v, o));
    return v;
}
__device__ __forceinline__ void swap32(float& a, float& b) { asm volatile("s_nop 1\n\tv_permlane32_swap_b32 %0, %1\n\ts_nop 1" : "+v"(a), "+v"(b)); }
__device__ __forceinline__ float xor32_sum(float x) { float a = x, b = x; swap32(a, b); return a + b; }
__device__ __forceinline__ float xor32_max(float x) { float a = x, b = x; swap32(a, b); return fmaxf(a, b); }
__device__ __forceinline__ float sigmoidf_(float x) { return __builtin_amdgcn_rcpf(1.f + __builtin_amdgcn_exp2f(-1.4426950408889634f * x)); }
__device__ __forceinline__ float siluf_(float x) { return x * __builtin_amdgcn_rcpf(1.f + __builtin_amdgcn_exp2f(-1.4426950408889634f * x)); }
__device__ __forceinline__ float gelu_tanh(float x) { const float u = 0.7978845608028654f * (x + 0.044715f * x * x * x); const float e = __expf(2.f * u); const float t = 1.f - 2.f / (e + 1.f); return 0.5f * x * (1.f + t); }
__device__ __forceinline__ int crow(int r, int hi) { return (r & 3) + 8 * (r >> 2) + 4 * hi; }
#define LDS_WAIT() asm volatile("s_waitcnt lgkmcnt(0)" ::: "memory")
#define MFMA32(a, b, c) __builtin_amdgcn_mfma_f32_32x32x16_bf16((a), (b), (c), 0, 0, 0)
typedef short v4i16_t __attribute__((ext_vector_type(4)));
__device__ __forceinline__ s16x4 ds_tr(LAS const unsigned char* p) { return __builtin_bit_cast(s16x4, __builtin_amdgcn_ds_read_tr16_b64_v4i16((LAS v4i16_t*)p)); }
__device__ __forceinline__ bf16x8 cat8(s16x4 a, s16x4 b) { return (bf16x8){a[0], a[1], a[2], a[3], b[0], b[1], b[2], b[3]}; }
__device__ __forceinline__ bf16x8 pack_frag(const f32x16& p, int base) {
    u32x4 w; w.x = pk2(p[base + 0], p[base + 1]); w.y = pk2(p[base + 2], p[base + 3]); w.z = pk2(p[base + 4], p[base + 5]); w.w = pk2(p[base + 6], p[base + 7]);
    return __builtin_bit_cast(bf16x8, w);
}
__device__ __forceinline__ float log2g(int h) { return h == 0 ? -0.04580368961312479f : h == 1 ? -0.02272007650008353f : h == 2 ? -0.011315313227834146f : -0.005646563141142063f; }

__device__ __forceinline__ void sincos_d(double a, double& s, double& c) {
    const double q = __builtin_rint(a * 0.63661977236758134308);
    double y = __builtin_fma(-q, 1.57079632679489655800e+00, a); y = __builtin_fma(-q, 6.12323399573676603587e-17, y);
    const int quad = ((int)q) & 3; const double y2 = y * y;
    double sp = -1.0 / 1307674368000.0; sp = sp * y2 + 1.0 / 6227020800.0; sp = sp * y2 - 1.0 / 39916800.0; sp = sp * y2 + 1.0 / 362880.0; sp = sp * y2 - 1.0 / 5040.0; sp = sp * y2 + 1.0 / 120.0; sp = sp * y2 - 1.0 / 6.0; sp = sp * y2 + 1.0; sp *= y;
    double cp = 1.0 / 20922789888000.0; cp = cp * y2 - 1.0 / 87178291200.0; cp = cp * y2 + 1.0 / 479001600.0; cp = cp * y2 - 1.0 / 3628800.0; cp = cp * y2 + 1.0 / 40320.0; cp = cp * y2 - 1.0 / 720.0; cp = cp * y2 + 1.0 / 24.0; cp = cp * y2 - 0.5; cp = cp * y2 + 1.0;
    s = (quad == 0) ? sp : (quad == 1) ? cp : (quad == 2) ? -sp : -cp;
    c = (quad == 0) ? cp : (quad == 1) ? -sp : (quad == 2) ? -cp : sp;
}
__device__ __forceinline__ double ipow_d(double r, int n) { double acc = 1.0;
#pragma unroll
    for (int b = 0; b < 6; ++b) { if (n & (1 << b)) acc *= r; r *= r; } return acc; }

__device__ __forceinline__ int orig_base32(int g32) {
    const int tile = g32 >> 3, gi = g32 & 7, bj = gi >> 2, wq = gi & 3;
    if (tile < 2)  return (2 * tile + (wq >> 1)) * 128 + (wq & 1) * 32 + 64 * bj;
    if (tile < 4)  return 512 + (2 * (tile - 2) + (wq >> 1)) * 128 + (wq & 1) * 32 + 64 * bj;
    if (tile < 6)  return 1024 + (tile - 4) * 256 + gi * 32;
    if (tile < 8)  return 1536 + (tile - 6) * 256 + gi * 32;
    if (tile < 10) return 2048 + (4 * (tile - 8) + wq) * 64 + 32 * bj;
    if (tile == 10) return 2560 + gi * 32;
    if (tile == 11) return ((wq >> 1) ? 3072 : 2816) + (wq & 1) * 64 + 32 * bj;
    if (tile == 12) return (bj ? 3200 : 2944) + wq * 32;
    return 3352 + (tile - 13) * 256 + gi * 32;
}
#define XB_TMO      128
#define XB_XCNT(j)  (256  + 64 * (j))
#define XB_XSUB(j)  (1280 + 64 * (j))
#define XB_XGEN(j)  (2304 + 64 * (j))
#define XB_TOP      3328
#define XB_TOPGEN   3392
#define XCD_BAR_WORDS 3456
#define XB_SPIN_CAP (1u << 18)
#define LAS __attribute__((address_space(3)))

__device__ __forceinline__ unsigned xb_ld(unsigned* p)              { return __hip_atomic_load(p, __ATOMIC_RELAXED, __HIP_MEMORY_SCOPE_AGENT); }
__device__ __forceinline__ unsigned xb_add(unsigned* p, unsigned v) { return __hip_atomic_fetch_add(p, v, __ATOMIC_RELAXED, __HIP_MEMORY_SCOPE_AGENT); }
__device__ __forceinline__ unsigned xb_xcc_id() { return (unsigned)__builtin_amdgcn_s_getreg((3 << 11) | 20) & 0xFu; }
#define XB_SPIN(cond, bar) do { unsigned _sp = 0; while (cond) { __builtin_amdgcn_s_sleep(1); \
    if ((++_sp & 255u) == 0u) { if (xb_ld(&(bar)[XB_TMO])) break; if (_sp > XB_SPIN_CAP) { atomicAdd(&(bar)[XB_TMO], 1u); break; } } } } while (0)

struct XcdBarrier {
    unsigned* bar; unsigned x;
    volatile LAS unsigned* st;
};

__device__ __forceinline__ XcdBarrier xcd_barrier_post(unsigned* bar, volatile LAS unsigned* st) {
    XcdBarrier b; b.bar = bar; b.x = xb_xcc_id(); b.st = st;
    if (threadIdx.x == 0) (void)xb_add(&bar[XB_XCNT(b.x)], 1u);
    return b;
}
__device__ __forceinline__ void xcd_barrier_complete(unsigned* bar, unsigned x, unsigned& nloc, unsigned& nx) {
    const unsigned G = gridDim.x * gridDim.y * gridDim.z;
    unsigned sum, cnt, mine, sp = 0u;
    for (;;) {
        sum = 0u; cnt = 0u; mine = 0u;
#pragma unroll
        for (unsigned j = 0; j < 16; ++j) { const unsigned c = xb_ld(&bar[XB_XCNT(j)]); sum += c; cnt += (c > 0u) ? 1u : 0u; mine = (j == x) ? c : mine; }
        if (sum == G) break;
        __builtin_amdgcn_s_sleep(1);
        if ((++sp & 255u) == 0u) { if (xb_ld(&bar[XB_TMO])) break; if (sp > XB_SPIN_CAP) { atomicAdd(&bar[XB_TMO], 1u); break; } }
    }
    nloc = mine > 0u ? mine : 1u; nx = cnt > 0u ? cnt : 1u;
}

__device__ __forceinline__ void xcd_barrier(const XcdBarrier& b) {
    asm volatile("s_waitcnt vmcnt(0)" ::: "memory");
    __syncthreads();
    if (threadIdx.x == 0) {
        unsigned* bar = b.bar;
        __builtin_amdgcn_s_waitcnt(0);
        unsigned nloc = b.st[0], nx = b.st[1];
        if (nloc == 0u) { xcd_barrier_complete(bar, b.x, nloc, nx); b.st[0] = nloc; b.st[1] = nx; }
        const unsigned old = xb_add(&bar[XB_XSUB(b.x)], 1u);
        const unsigned gen = old / nloc;
        if (old + 1u == (gen + 1u) * nloc) {
            __builtin_amdgcn_fence(__ATOMIC_RELEASE, "agent");
            asm volatile("s_waitcnt vmcnt(0)" ::: "memory");
            const unsigned og = xb_add(&bar[XB_TOP], 1u);
            const unsigned tg = og / nx;
            if (og + 1u == (tg + 1u) * nx) xb_add(&bar[XB_TOPGEN], 1u);
            else XB_SPIN(xb_ld(&bar[XB_TOPGEN]) == tg, bar);
            __builtin_amdgcn_fence(__ATOMIC_ACQUIRE, "agent");
            xb_add(&bar[XB_XGEN(b.x)], 1u);
            asm volatile("s_waitcnt vmcnt(0)" ::: "memory");
        } else {
            XB_SPIN(xb_ld(&bar[XB_XGEN(b.x)]) == gen, bar);
            __builtin_amdgcn_fence(__ATOMIC_ACQUIRE, "agent");
            asm volatile("s_waitcnt vmcnt(0)" ::: "memory");
        }
    }
    __syncthreads();
}

template <bool FRAG = false>
__device__ __forceinline__ void transpose_item(const float* W, int ldw, int k0, int n0, int nvalid, const float* kscale, bf16* WT, int ldt, int drow0, LAS float* scr, int lane) {
    float tv[32];
#pragma unroll
    for (int i = 0; i < 32; ++i) { const int kk = 2 * i + (lane >> 5), c = lane & 31; tv[i] = W[(size_t)(k0 + kk) * ldw + n0 + ((c < nvalid) ? c : 0)]; }
#pragma unroll
    for (int i = 0; i < 32; ++i) { const int kk = 2 * i + (lane >> 5), c = lane & 31; float v = (c < nvalid) ? tv[i] : 0.f; if (kscale) v *= kscale[k0 + kk]; scr[kk * 33 + c] = v; }
    LDS_WAIT(); asm volatile("" ::: "memory");
    const int c8 = lane & 7;
#pragma unroll
    for (int j = 0; j < 4; ++j) { const int n = (lane >> 3) + 8 * j; const LAS float* s = scr + (8 * c8) * 33 + n;
        u32x4 o; o.x = pk2(s[0 * 33], s[1 * 33]); o.y = pk2(s[2 * 33], s[3 * 33]); o.z = pk2(s[4 * 33], s[5 * 33]); o.w = pk2(s[6 * 33], s[7 * 33]);
        if (FRAG) { const int e = drow0 + n, k8 = (k0 >> 3) + c8;
            *(u32x4*)(WT + (size_t)((((k8 >> 4) * 2 + (e >> 5)) * 8 + ((k8 >> 1) & 7)) * 64 + (e & 31) + 32 * (k8 & 1)) * 8) = o; }
        else *(u32x4*)(WT + (size_t)(drow0 + n) * ldt + k0 + 8 * c8) = o; }
    LDS_WAIT(); asm volatile("" ::: "memory");
}

__device__ __forceinline__ void phase0(const Args& A, LAS unsigned char* lds, int tid, int lane, int wave) {
    unsigned char* ws = A.ws;
    const int gw = blockIdx.x * 8 + wave, NGW = gridDim.x * 8;
    const int gt = blockIdx.x * 512 + tid, NGT = gridDim.x * 512;
    LAS float* scr = (LAS float*)(lds + wave * 16384);
    constexpr int I_IN = 16 * 120, I_NGL = 16, I_OUT = 16 * 32, I_G = 16 * 32, I_PLE = 4 * 32, I_W1 = 4 * 64, I_W2 = 4 * 2;
    constexpr int NITEMS = I_IN + I_NGL + I_OUT + I_G + I_PLE + I_W1 + I_W2;
    for (int it = gw; it < NITEMS; it += NGW) {
        int r = it;
        if (r < I_IN) { const int kb = r / 120, g32 = r % 120; transpose_item((const float*)A.in[I_WIN], PROJW, 64 * kb, orig_base32(g32), 32, nullptr, (bf16*)(ws + WS_WINT), 1024, 32 * g32, scr, lane); continue; } r -= I_IN;
        if (r < I_NGL) { transpose_item((const float*)A.in[I_WIN], PROJW, 64 * r, 3328, 24, nullptr, (bf16*)(ws + WS_WNGLT), 1024, 0, scr, lane); continue; } r -= I_NGL;
        if (r < I_OUT) { const int kb = r / 32, nb = r % 32; transpose_item((const float*)A.in[I_WOUT], 1024, 64 * kb, 32 * nb, 32, nullptr, (bf16*)(ws + WS_WOUTT), 1024, 32 * nb, scr, lane); continue; } r -= I_OUT;
        if (r < I_G) { const int kb = r / 32, nb = r % 32; transpose_item((const float*)A.in[I_WG], 1024, 64 * kb, 32 * nb, 32, (const float*)A.in[I_NPLE], (bf16*)(ws + WS_WGT), 1024, 32 * nb, scr, lane); continue; } r -= I_G;
        if (r < I_PLE) { const int kb = r / 32, nb = r % 32; transpose_item((const float*)A.in[I_WPLE], 1024, 64 * kb, 32 * nb, 32, nullptr, (bf16*)(ws + WS_WPLET), 256, 32 * nb, scr, lane); continue; } r -= I_PLE;
        if (r < I_W1) { const int m = r >> 6, q = r & 63, kb = q >> 1, nb = q & 1;
            const float* W = (const float*)A.in[(m >> 1) ? I_W1V : I_W1K] + (size_t)(m & 1) * 2048 * 64;
            transpose_item<true>(W, 64, 64 * kb, 32 * nb, 32, nullptr, (bf16*)(ws + WS_W1T) + (size_t)m * 64 * 2048, 2048, 32 * nb, scr, lane); continue; } r -= I_W1;
        { const int m = r >> 1, nb = r & 1;
            const float* W = (const float*)A.in[(m >> 1) ? I_W2V : I_W2K] + (size_t)(m & 1) * 64 * 64;
            transpose_item(W, 64, 0, 32 * nb, 32, nullptr, (bf16*)(ws + WS_W2T) + (size_t)m * 64 * 64, 64, 32 * nb, scr, lane); }
    }
    {
        const f32x4* gm = (const f32x4*)A.in[I_NMIX];
        f32x4 g[4];
#pragma unroll
        for (int j = 0; j < 4; ++j) g[j] = gm[64 * j + lane];
        for (int m0 = gw; m0 < NTOK; m0 += 4 * NGW) {
            f32x4 v[4][4];
#pragma unroll
            for (int r = 0; r < 4; ++r) { const int mm = m0 + r * NGW, m = (mm < NTOK) ? mm : m0;
                const float* xrow = (m < NP) ? (const float*)A.in[I_XP] + (size_t)m * DM : (const float*)A.in[I_XS] + (size_t)(m - NP) * DM;
                const f32x4* xr = (const f32x4*)xrow + lane;
#pragma unroll
                for (int j = 0; j < 4; ++j) v[r][j] = xr[64 * j]; }
#pragma unroll
            for (int r = 0; r < 4; ++r) { const int m = m0 + r * NGW;
                float s = 0.f;
#pragma unroll
                for (int j = 0; j < 4; ++j) s += (v[r][j].x * v[r][j].x + v[r][j].y * v[r][j].y) + (v[r][j].z * v[r][j].z + v[r][j].w * v[r][j].w);
                const float rstd = 1.f / sqrtf(wave_sum(s) * (1.f / DM) + RMS_EPS);
                if (m < NTOK) {
                    u32x2* o8 = (u32x2*)((bf16*)(ws + WS_H) + (size_t)m * DM) + lane;
#pragma unroll
                    for (int j = 0; j < 4; ++j) { u32x2 o; o.x = pk2(v[r][j].x * rstd * g[j].x, v[r][j].y * rstd * g[j].y); o.y = pk2(v[r][j].z * rstd * g[j].z, v[r][j].w * rstd * g[j].w); o8[64 * j] = o; }
                } }
        }
    }
    for (int i0 = gt; i0 < NTOK * 64; i0 += 8 * NGT) {
        f32x4 v[8];
#pragma unroll
        for (int u = 0; u < 8; ++u) { const int ii = i0 + u * NGT, i = (ii < NTOK * 64) ? ii : i0; const int row = i >> 6, c4 = i & 63;
            v[u] = (row < NP) ? ((const f32x4*)A.in[I_PP])[(size_t)row * 64 + c4] : ((const f32x4*)A.in[I_PS])[(size_t)(row - NP) * 64 + c4]; }
#pragma unroll
        for (int u = 0; u < 8; ++u) { const int i = i0 + u * NGT;
            if (i < NTOK * 64) { u32x2 o; o.x = pk2(v[u].x, v[u].y); o.y = pk2(v[u].z, v[u].w); ((u32x2*)(ws + WS_PB))[i] = o; } }
    }
    for (int i = gt; i < NPOS * 96; i += NGT) {
        const int pi = i / 96, k = i % 96;
        const double pos = (pi < SEQ) ? (double)pi : (double)(PAST + pi - SEQ);
        double s, c;
        if (k < 64) { sincos_d(pos * ipow_d(0.86596432336006535235, k), s, c); ((float*)(ws + WS_COSR))[pi * 64 + k] = (float)c; ((float*)(ws + WS_SINR))[pi * 64 + k] = (float)s; }
        else { const int kk = k - 64; sincos_d(pos * ipow_d(0.74989420933245582730, kk), s, c); ((float*)(ws + WS_COSN))[pi * 32 + kk] = (float)c; ((float*)(ws + WS_SINN))[pi * 32 + kk] = (float)s; }
    }
    for (int it = blockIdx.x; it < 4 * 32; it += gridDim.x) {
        const int m = it >> 5, part = it & 31, kv = m >> 1, kvh = m & 1;
        const float* pe = (const float*)A.in[kv ? I_PEV : I_PEK];
        const float* w1 = (const float*)A.in[kv ? I_W1V : I_W1K] + (size_t)kvh * 2048 * 64;
        float pv[8], wv8[8];
#pragma unroll
        for (int q = 0; q < 8; ++q) { const int jd = part * 64 + 8 * wave + q, j = jd >> 6, d = jd & 63; pv[q] = pe[(j * 2 + kvh) * 64 + d]; wv8[q] = w1[(size_t)jd * 64 + lane]; }
        float acc = 0.f;
#pragma unroll
        for (int q = 0; q < 8; ++q) acc += pv[q] * wv8[q];
        LAS float* cb = (LAS float*)lds;
        __syncthreads();
        cb[wave * 64 + lane] = acc;
        __syncthreads();
        if (wave == 0) { float t = 0.f;
#pragma unroll
            for (int w = 0; w < 8; ++w) t += cb[w * 64 + lane];
            ((float*)(ws + WS_CBIAS))[(m * 32 + part) * 64 + lane] = t; }
    }
}

__device__ __forceinline__ void win_shift(const Args& A, int gt, int NGT) {
    for (int i0 = gt; i0 < 2 * 32 * 504 * 32; i0 += 8 * NGT) {
        f32x4 v[8];
#pragma unroll
        for (int u = 0; u < 8; ++u) { const int ii = i0 + u * NGT, i = (ii < 2 * 32 * 504 * 32) ? ii : i0;
            const int kv = i / (32 * 504 * 32), r = i % (32 * 504 * 32), b = r / (504 * 32), q = r % (504 * 32);
            v[u] = ((const f32x4*)A.in[kv ? I_SWV : I_SWK])[(size_t)b * 512 * 32 + 8 * 32 + q]; }
#pragma unroll
        for (int u = 0; u < 8; ++u) { const int i = i0 + u * NGT;
            if (i < 2 * 32 * 504 * 32) { const int kv = i / (32 * 504 * 32), r = i % (32 * 504 * 32), b = r / (504 * 32), q = r % (504 * 32);
                ((f32x4*)(A.out + (kv ? O_WINV_S : O_WINK_S)))[(size_t)b * 512 * 32 + q] = v[u]; } }
    }
}

struct EpiInProj {
    static constexpr bool PERM = true, AFTER_DRAIN = false;
    unsigned char* ws; float* out;
    __device__ __forceinline__ void operator()(const pg8::f32x4 (&acc)[2][2][4][2], const pg8::Unit& u, int wr, int wc, int fr, int fq) const {
        const int pn = u.pn;
        asm volatile("" : "+v"(fr), "+v"(fq));
        const int lc = wc * 32 + 8 * fq;
        const bool rope = pn < 4 || pn == 8 || pn == 9 || pn == 11;
        f32x4 tb[2][4];
        auto ldtab = [&](int ai_, int m_, f32x4 (&t)[4]) {
            const int row_ = u.pm * 256 + ai_ * 128 + wr * 64 + m_ * 16 + fr;
            const int pidx_ = (row_ >= NP) ? (SEQ + ((row_ - NP) & 7)) : (row_ & (SEQ - 1));
            const bool big = pn < 4; const int nd = big ? 64 : 32, dl = big ? ((wc & 1) * 32 + 8 * fq) : 8 * fq;
            const float* ct = (const float*)(ws + (big ? WS_COSR : WS_COSN)) + pidx_ * nd + dl; const float* st = (const float*)(ws + (big ? WS_SINR : WS_SINN)) + pidx_ * nd + dl;
            t[0] = *(const f32x4*)ct; t[1] = *(const f32x4*)(ct + 4); t[2] = *(const f32x4*)st; t[3] = *(const f32x4*)(st + 4); };
        if (rope) ldtab(0, 0, tb[0]);
#pragma unroll
        for (int ai = 0; ai < 2; ++ai)
#pragma unroll
            for (int m = 0; m < 4; ++m) {
                const int row = u.pm * 256 + ai * 128 + wr * 64 + m * 16 + fr;
                const bool dec = row >= NP;
                const int pidx = dec ? (SEQ + ((row - NP) & 7)) : (row & (SEQ - 1));
                float cc[8], ss[8];
                if (rope) {
                    const int idx = ai * 4 + m;
                    if (idx + 1 < 8) ldtab((idx + 1) >> 2, (idx + 1) & 3, tb[(idx + 1) & 1]);
#pragma unroll
                    for (int e = 0; e < 8; ++e) { cc[e] = e < 4 ? tb[idx & 1][0][e & 3] : tb[idx & 1][1][e & 3]; ss[e] = e < 4 ? tb[idx & 1][2][e & 3] : tb[idx & 1][3][e & 3]; }
                }
                float v0[8], v1[8];
#pragma unroll
                for (int e = 0; e < 4; ++e) { v0[e] = acc[ai][0][m][0][e]; v0[4 + e] = acc[ai][0][m][1][e]; v1[e] = acc[ai][1][m][0][e]; v1[4 + e] = acc[ai][1][m][1][e]; }
                if (pn < 4) {
                    const int t2 = pn & 1, head = 2 * t2 + (wc >> 1), dlo = (wc & 1) * 32 + 8 * fq;
                    const float sc = (pn >= 2) ? 0.08838834764831845f : 1.f;
                    float o0[8], o1[8];
#pragma unroll
                    for (int e = 0; e < 8; ++e) { const float c = cc[e], s = ss[e]; o0[e] = (v0[e] * c - v1[e] * s) * sc; o1[e] = (v1[e] * c + v0[e] * s) * sc; }
                    bf16* dst = (bf16*)(ws + (pn >= 2 ? WS_KR : WS_QR));
                    *(u32x4*)(dst + CM(head * 128 + dlo, row)) = pack8(o0); *(u32x4*)(dst + CM(head * 128 + 64 + dlo, row)) = pack8(o1);
                } else if (pn < 8) {
                    const int cb = ((pn - 4) & 1) * 256 + lc;
                    if (pn >= 6) {
#pragma unroll
                        for (int e = 0; e < 8; ++e) { v0[e] = siluf_(v0[e]); v1[e] = siluf_(v1[e]); } }
                    bf16* dst = (bf16*)(ws + (pn >= 6 ? WS_RG : WS_VR));
                    *(u32x4*)(dst + CM(cb, row)) = pack8(v0); *(u32x4*)(dst + CM(cb + 128, row)) = pack8(v1);
                } else if (pn < 10) {
                    const int head = 4 * (pn - 8) + wc, dlo = 8 * fq;
                    float o0[8], o1[8], r0[8], r1[8];
#pragma unroll
                    for (int e = 0; e < 8; ++e) { const float c = cc[e], s = ss[e]; o0[e] = (v0[e] * c - v1[e] * s) * C2; o1[e] = (v1[e] * c + v0[e] * s) * C2; r0[e] = v0[e] * C2; r1[e] = v1[e] * C2; }
                    bf16* dq = (bf16*)(ws + WS_QN); bf16* dr = (bf16*)(ws + WS_QROT); const size_t c0_ = CM(head * 64 + dlo, row), c1_ = CM(head * 64 + 32 + dlo, row);
                    *(u32x4*)(dq + c0_) = pack8(r0); *(u32x4*)(dq + c1_) = pack8(r1); *(u32x4*)(dr + c0_) = pack8(o0); *(u32x4*)(dr + c1_) = pack8(o1);
                } else if (pn == 10) {
                    float* dk = out + (dec ? O_CMPK_S + (size_t)(row - NP) * 128 : O_CMPK_P + (size_t)row * 128) + lc;
                    float* dv = out + (dec ? O_CMPV_S + (size_t)(row - NP) * 128 : O_CMPV_P + (size_t)row * 128) + lc;
                    *(f32x4*)dk = (f32x4){v0[0], v0[1], v0[2], v0[3]}; *(f32x4*)(dk + 4) = (f32x4){v0[4], v0[5], v0[6], v0[7]};
                    *(f32x4*)dv = (f32x4){v1[0], v1[1], v1[2], v1[3]}; *(f32x4*)(dv + 4) = (f32x4){v1[4], v1[5], v1[6], v1[7]};
                } else if (pn == 11) {
                    const int which = wc >> 1, kvh = wc & 1, dlo = 8 * fq, col = kvh * 64 + dlo;
                    float o0[8], o1[8];
#pragma unroll
                    for (int e = 0; e < 8; ++e) { const float c = cc[e], s = ss[e]; o0[e] = v0[e] * c - v1[e] * s; o1[e] = v1[e] * c + v0[e] * s; }
                    bf16* db = (bf16*)(ws + (which ? WS_KW : WS_KS));
                    *(u32x4*)(db + CM(col, row)) = pack8(o0); *(u32x4*)(db + CM(col + 32, row)) = pack8(o1);
                    float* df = nullptr;
                    if (which == 0) df = out + (dec ? O_SLCK_S + (size_t)(row - NP) * 128 : O_SLCK_P + (size_t)row * 128) + col;
                    else if (dec) { const int b = (row - NP) >> 3, tt = (row - NP) & 7; df = out + O_WINK_S + ((size_t)b * 512 + 504 + tt) * 128 + col; }
                    else { const int b = row >> 12, t = row & 4095; if (t >= SEQ - 512) df = out + O_WINK_P + ((size_t)b * 512 + (t - (SEQ - 512))) * 128 + col; }
                    if (df) { *(f32x4*)df = (f32x4){o0[0], o0[1], o0[2], o0[3]}; *(f32x4*)(df + 4) = (f32x4){o0[4], o0[5], o0[6], o0[7]};
                              *(f32x4*)(df + 32) = (f32x4){o1[0], o1[1], o1[2], o1[3]}; *(f32x4*)(df + 36) = (f32x4){o1[4], o1[5], o1[6], o1[7]}; }
                } else if (pn == 12) {
                    *(u32x4*)((bf16*)(ws + WS_VS) + CM(lc, row)) = pack8(v0); *(u32x4*)((bf16*)(ws + WS_VW) + CM(lc, row)) = pack8(v1);
                    float* fs = out + (dec ? O_SLCV_S + (size_t)(row - NP) * 128 : O_SLCV_P + (size_t)row * 128) + lc;
                    *(f32x4*)fs = (f32x4){v0[0], v0[1], v0[2], v0[3]}; *(f32x4*)(fs + 4) = (f32x4){v0[4], v0[5], v0[6], v0[7]};
                    float* fw = nullptr;
                    if (dec) { const int b = (row - NP) >> 3, tt = (row - NP) & 7; fw = out + O_WINV_S + ((size_t)b * 512 + 504 + tt) * 128 + lc; }
                    else { const int b = row >> 12, t = row & 4095; if (t >= SEQ - 512) fw = out + O_WINV_P + ((size_t)b * 512 + (t - (SEQ - 512))) * 128 + lc; }
                    if (fw) { *(f32x4*)fw = (f32x4){v1[0], v1[1], v1[2], v1[3]}; *(f32x4*)(fw + 4) = (f32x4){v1[4], v1[5], v1[6], v1[7]}; }
                } else {
                    const int cb = (pn - 13) * 256 + lc;
#pragma unroll
                    for (int e = 0; e < 8; ++e) { v0[e] = siluf_(v0[e]); v1[e] = siluf_(v1[e]); }
                    bf16* dst = (bf16*)(ws + WS_NG);
                    *(u32x4*)(dst + CM(cb, row)) = pack8(v0); *(u32x4*)(dst + CM(cb + 128, row)) = pack8(v1);
                }
            }
    }
};

__device__ __forceinline__ void ngl_unit(unsigned char* ws, int unit, int lane, int wave) {
    const int row0 = unit * 128 + wave * 16, fr = lane & 15, fq = lane >> 4;
    const bf16* a = (const bf16*)(ws + WS_H) + (size_t)(row0 + fr) * DM + 8 * fq;
    const bf16* b0 = (const bf16*)(ws + WS_WNGLT) + (size_t)fr * DM + 8 * fq;
    const bf16* b1 = b0 + 16 * DM;
    f32x4 c0 = {0.f, 0.f, 0.f, 0.f}, c1 = {0.f, 0.f, 0.f, 0.f};
#pragma unroll 8
    for (int s = 0; s < 32; ++s) {
        const bf16x8 av = *(const bf16x8*)(a + 32 * s), bv0 = *(const bf16x8*)(b0 + 32 * s), bv1 = *(const bf16x8*)(b1 + 32 * s);
        c0 = __builtin_amdgcn_mfma_f32_16x16x32_bf16(av, bv0, c0, 0, 0, 0);
        c1 = __builtin_amdgcn_mfma_f32_16x16x32_bf16(av, bv1, c1, 0, 0, 0);
    }
    float* gl = (float*)(ws + WS_GL);
#pragma unroll
    for (int i = 0; i < 4; ++i) { const int r = row0 + 4 * fq + i; gl[(size_t)r * 32 + fr] = sigmoidf_(c0[i]); gl[(size_t)r * 32 + 16 + fr] = sigmoidf_(c1[i]); }
}

template <bool DEC>
__device__ __forceinline__ void compress_unit(const Args& A, LAS unsigned char* lds, int unit, int tid, int lane, int wave) {
    unsigned char* ws = A.ws;
    asm volatile("" : "+v"(tid), "+v"(lane));
    const int kv = DEC ? (unit >> 8) : (unit >> 3), b = DEC ? ((unit >> 3) & 31) : ((unit >> 1) & 3), part = DEC ? (unit & 7) : (unit & 1);
    const int r32 = lane & 31, hi = lane >> 5, kvh = wave >> 2, bt = (wave >> 1) & 1, et = wave & 1, m = kv * 2 + kvh;
    constexpr int AP = 528;
    LAS unsigned char* bufA = lds;
    LAS float* biasL = (LAS float*)(lds + 2 * 64 * AP);
    LAS float* xch = (LAS float*)(lds + 2 * 64 * AP + 512);
    __syncthreads();
    unsigned offs[8];
    const float* src;
    if (DEC) { src = (const float*)A.in[kv ? I_CCV : I_CCK]; const int* pt = (const int*)A.in[I_PT] + b * 128 + part * 16;
#pragma unroll
        for (int i = 0; i < 8; ++i) { const int blk = (tid >> 6) + 8 * i; offs[i] = ((unsigned)pt[blk >> 2] * 128u + (unsigned)(blk & 3) * 32u) * 128u + 4u * (tid & 63); } }
    else { src = A.out + (kv ? O_CMPV_P : O_CMPK_P) + (size_t)b * SEQ * 128 + (size_t)part * 64 * 32 * 128;
#pragma unroll
        for (int i = 0; i < 8; ++i) { const int blk = (tid >> 6) + 8 * i; offs[i] = (unsigned)(blk * 32) * 128u + 4u * (tid & 63); } }
#define GLD16(dst, ptr) asm volatile("global_load_dwordx4 %0, %1, off" : "=v"(dst) : "v"(ptr) : "memory")
#define GLD16NT(dst, ptr) asm volatile("global_load_dwordx4 %0, %1, off nt" : "=v"(dst) : "v"(ptr) : "memory")
#define WAIT8(N, a) asm volatile("s_waitcnt vmcnt(" #N ")" : "+v"(a[0]), "+v"(a[1]), "+v"(a[2]), "+v"(a[3]), "+v"(a[4]), "+v"(a[5]), "+v"(a[6]), "+v"(a[7]) :: "memory")
    const unsigned rot = DEC ? (unsigned)(unit & 15) : 0u;
    f32x4 preA[8], preB[8];
    bf16x8 wA[8], wB[8];
    f32x16 acc = f32x16{};
    const bf16* w1t = (const bf16*)(ws + WS_W1T) + (size_t)m * 64 * 2048 + (size_t)(et * 512 + lane) * 8;
#define LD_ROWS(PRE, S) do { const unsigned s2_ = ((((S) < 16) ? (unsigned)(S) : 15u) + rot) & 15u; _Pragma("unroll") for (int i = 0; i < 8; ++i) { const float* p_ = src + offs[i] + s2_ * 256u; if (DEC) GLD16NT(PRE[i], p_); else GLD16(PRE[i], p_); } } while (0)
#define LD_W1(W, S) do { const int sn_ = (int)(((((S) < 16) ? (unsigned)(S) : 15u) + rot) & 15u); _Pragma("unroll") for (int q = 0; q < 8; ++q) { const bf16* p_ = w1t + sn_ * 8192 + 512 * q; GLD16(W[q], p_); } } while (0)
    LD_ROWS(preA, 0); LD_W1(wA, 0); LD_ROWS(preB, 1);
    if (tid < 128) { const int k2 = tid >> 6, e = tid & 63; const float* cb = (const float*)(ws + WS_CBIAS) + ((kv * 2 + k2) * 32) * 64 + e; float bp[32];
#pragma unroll
        for (int p = 0; p < 32; ++p) bp[p] = cb[p * 64];
        float s = 0.f;
#pragma unroll
        for (int p = 0; p < 32; ++p) s += bp[p];
        biasL[tid] = s; }
#define CMP_STEP(PRE, WC, WN, S) do { \
        LAS unsigned char* buf = bufA + ((S) & 1) * 64 * AP; \
        WAIT8(16, PRE); \
        _Pragma("unroll") for (int i = 0; i < 8; ++i) { const int blk = (tid >> 6) + 8 * i; u32x2 o; o.x = pk2(PRE[i].x, PRE[i].y); o.y = pk2(PRE[i].z, PRE[i].w); *(LAS u32x2*)(buf + blk * AP + (tid & 63) * 8) = o; } \
        LD_W1(WN, (S) + 1); LD_ROWS(PRE, (S) + 2); \
        __syncthreads(); \
        WAIT8(24, WC); \
        _Pragma("unroll") for (int q = 0; q < 8; ++q) { \
            const bf16x8 bf = *(LAS const bf16x8*)(buf + (32 * bt + r32) * AP + ((q >> 2) * 128 + kvh * 64 + 16 * (q & 3) + 8 * hi) * 2); \
            acc = MFMA32(WC[q], bf, acc); } } while (0)
#pragma unroll 1
    for (int s = 0; s < 16; s += 2) { CMP_STEP(preA, wA, wB, s); CMP_STEP(preB, wB, wA, s + 1); }
    asm volatile("s_waitcnt vmcnt(0)" ::: "memory");
#undef CMP_STEP
#undef LD_ROWS
#undef LD_W1
#undef GLD16
#undef GLD16NT
#undef WAIT8
#pragma unroll
    for (int r = 0; r < 16; ++r) acc[r] = gelu_tanh(acc[r] + biasL[kvh * 64 + 32 * et + crow(r, hi)]);
    const bf16* w2t = (const bf16*)(ws + WS_W2T) + (size_t)m * 64 * 64;
    f32x16 oacc[2]; oacc[0] = f32x16{}; oacc[1] = f32x16{};
#pragma unroll
    for (int s2 = 0; s2 < 2; ++s2) {
        const bf16x8 pb = pack_frag(acc, 8 * s2);
#pragma unroll
        for (int ft = 0; ft < 2; ++ft) {
            const bf16* wp = w2t + (32 * ft + r32) * 64 + 32 * et + 16 * s2 + 4 * hi;
            const s16x4 lo = *(const s16x4*)wp, hh = *(const s16x4*)(wp + 8);
            oacc[ft] = MFMA32(cat8(lo, hh), pb, oacc[ft]);
        }
    }
    LAS float* xp = xch + ((kvh * 2 + bt) * 32) * 64 + lane;
    if (et == 1) {
#pragma unroll
        for (int ft = 0; ft < 2; ++ft)
#pragma unroll
            for (int r = 0; r < 16; ++r) xp[(ft * 16 + r) * 64] = oacc[ft][r];
    }
    __syncthreads();
    if (et == 0) {
        const int blk = 32 * bt + r32;
#pragma unroll
        for (int ft = 0; ft < 2; ++ft)
#pragma unroll
            for (int q = 0; q < 4; ++q) {
                const int f = 32 * ft + 8 * q + 4 * hi;
                const float v0 = oacc[ft][4 * q] + xp[(ft * 16 + 4 * q) * 64], v1 = oacc[ft][4 * q + 1] + xp[(ft * 16 + 4 * q + 1) * 64];
                const float v2 = oacc[ft][4 * q + 2] + xp[(ft * 16 + 4 * q + 2) * 64], v3 = oacc[ft][4 * q + 3] + xp[(ft * 16 + 4 * q + 3) * 64];
                if (DEC) { float* d = (float*)(ws + (kv ? WS_VCS : WS_KCS)) + (((size_t)b * 512 + part * 64 + blk) * 2 + kvh) * 64 + f; *(f32x4*)d = (f32x4){v0, v1, v2, v3}; }
                else { bf16* d = (bf16*)(ws + (kv ? WS_VCP : WS_KCP)) + (((size_t)b * 128 + part * 64 + blk) * 2 + kvh) * 64 + f;
                    u32x2 o; o.x = pk2(v0, v1); o.y = pk2(v2, v3); *(u32x2*)d = o; }
            }
    }
}

__device__ __forceinline__ int tr_off(int lane, int pitch) { return ((lane & 15) >> 2) * pitch + (16 * ((lane >> 4) & 1) + 4 * (lane & 3)) * 2; }

__device__ __forceinline__ void ret_pass1_unit(unsigned char* ws, LAS unsigned char* lds, int unit, int tid, int lane, int wave) {
    const int bh = unit >> 5, c = unit & 31, b = bh >> 2, h = bh & 3;
    constexpr int TP = 320;
    LAS unsigned char* Kt = lds; LAS unsigned char* Vt = lds + 128 * TP;
    const size_t row0 = (size_t)b * SEQ + c * 128;
    const float lg = log2g(h);
    __syncthreads();
#pragma unroll
    for (int i = 0; i < 4; ++i) {
        const int row = tid & 127, ch = (tid >> 7) + 4 * i;
        const u32x4 kx = *(const u32x4*)((const bf16*)(ws + WS_KR) + CM(h * 128 + ch * 8, row0 + row));
        const u32x4 vx = *(const u32x4*)((const bf16*)(ws + WS_VR) + CM(h * 128 + ch * 8, row0 + row));
        const float dc = exp2f((float)(127 - row) * lg);
        u32x4 ko; ko.x = pk2(bflo(kx.x) * dc, bfhi(kx.x) * dc); ko.y = pk2(bflo(kx.y) * dc, bfhi(kx.y) * dc); ko.z = pk2(bflo(kx.z) * dc, bfhi(kx.z) * dc); ko.w = pk2(bflo(kx.w) * dc, bfhi(kx.w) * dc);
        *(LAS u32x4*)(Kt + row * TP + ch * 16) = ko; *(LAS u32x4*)(Vt + row * TP + ch * 16) = vx;
    }
    __syncthreads();
    const int r32 = lane & 31, hi = lane >> 5, dvb = wave & 3, dkh = wave >> 2, tro = tr_off(lane, TP);
    f32x16 acc[2]; acc[0] = f32x16{}; acc[1] = f32x16{};
#pragma unroll
    for (int s = 0; s < 8; ++s) {
        const int t0 = 16 * s + 8 * hi;
        const bf16x8 af = cat8(ds_tr(Vt + t0 * TP + 64 * dvb + tro), ds_tr(Vt + (t0 + 4) * TP + 64 * dvb + tro));
#pragma unroll
        for (int n = 0; n < 2; ++n) {
            const int cb = 64 * (2 * dkh + n);
            const bf16x8 bfr = cat8(ds_tr(Kt + t0 * TP + cb + tro), ds_tr(Kt + (t0 + 4) * TP + cb + tro));
            acc[n] = MFMA32(af, bfr, acc[n]);
        }
    }
    float* dst = (float*)(ws + WS_KVT) + (size_t)unit * 16384;
#pragma unroll
    for (int n = 0; n < 2; ++n)
#pragma unroll
        for (int r = 0; r < 16; ++r) dst[(32 * dvb + crow(r, hi)) * 128 + 32 * (2 * dkh + n) + r32] = acc[n][r];
}

__device__ __forceinline__ void ret_pass2(const Args& A, int tid) {
    unsigned char* ws = A.ws;
    for (int e = blockIdx.x * 512 + tid; e < 16 * 16384; e += gridDim.x * 512) {
        const int bh = e >> 14, q = e & 16383, dv = q >> 7, dk = q & 127;
        const float gC = exp2f(128.f * log2g(bh & 3));
        const float* kv = (const float*)(ws + WS_KVT) + (size_t)bh * 32 * 16384 + q;
        bf16* st = (bf16*)(ws + WS_ST) + (size_t)bh * 32 * 16384 + (size_t)(((((dv >> 6) * 2 + ((dv >> 5) & 1)) * 8 + (dk >> 4)) * 64 + (dv & 31) + 32 * ((dk >> 3) & 1)) * 8 + (dk & 7));
        float kvr[32];
#pragma unroll
        for (int c = 0; c < 32; ++c) kvr[c] = kv[(size_t)c * 16384];
        float S = 0.f;
#pragma unroll
        for (int c = 0; c < 32; ++c) { st[(size_t)c * 16384] = (bf16)f2bf(S); S = gC * S + kvr[c]; }
        A.out[O_RETP + (size_t)bh * 16384 + dk * 128 + dv] = S;
    }
}

__device__ __forceinline__ void ret_pass3_unit(const Args& A, LAS unsigned char* lds, int unit, int tid, int lane, int wave) {
    unsigned char* ws = A.ws;
    const int bh = unit >> 5, c = unit & 31, b = bh >> 2, h = bh & 3;
    constexpr int KP = 272, VP = 320;
    LAS unsigned char* Kt = lds; LAS unsigned char* Vt = lds + 128 * KP; LAS float* red = (LAS float*)(lds + 128 * KP + 128 * VP);
    const size_t row0 = (size_t)b * SEQ + c * 128;
    const float lg = log2g(h);
    __syncthreads();
#pragma unroll
    for (int i = 0; i < 4; ++i) {
        const int row = tid & 127, ch = (tid >> 7) + 4 * i;
        *(LAS u32x4*)(Kt + row * KP + ch * 16) = *(const u32x4*)((const bf16*)(ws + WS_KR) + CM(h * 128 + ch * 8, row0 + row));
        *(LAS u32x4*)(Vt + row * VP + ch * 16) = *(const u32x4*)((const bf16*)(ws + WS_VR) + CM(h * 128 + ch * 8, row0 + row));
    }
    const int r32 = lane & 31, hi = lane >> 5, ib = wave & 3, dh = wave >> 2, tro = tr_off(lane, VP);
    const int il = 32 * ib + r32;
    bf16x8 qf[8];
    { const bf16* qp = (const bf16*)(ws + WS_QR) + CM(h * 128 + 8 * hi, row0 + il);
#pragma unroll
      for (int s = 0; s < 8; ++s) qf[s] = *(const bf16x8*)(qp + (size_t)s * (2 * NTOK * 8)); }
    __syncthreads();
    f32x16 oacc[2]; oacc[0] = f32x16{}; oacc[1] = f32x16{};
    for (int jb = 0; jb <= ib; ++jb) {
        f32x16 sT = f32x16{};
#pragma unroll
        for (int s = 0; s < 8; ++s) { const bf16x8 kf = *(LAS const bf16x8*)(Kt + (32 * jb + r32) * KP + (16 * s + 8 * hi) * 2); sT = MFMA32(kf, qf[s], sT); }
#pragma unroll
        for (int r = 0; r < 16; ++r) { const int j = 32 * jb + crow(r, hi); const float d = exp2f((float)(il - j) * lg); sT[r] = (j <= il) ? sT[r] * d : 0.f; }
#pragma unroll
        for (int s2 = 0; s2 < 2; ++s2) {
            const bf16x8 pb = pack_frag(sT, 8 * s2);
            const int j0 = 32 * jb + 16 * s2 + 4 * hi;
#pragma unroll
            for (int dvb = 0; dvb < 2; ++dvb) {
                const int cb = 64 * (2 * dh + dvb);
                const bf16x8 vf = cat8(ds_tr(Vt + j0 * VP + cb + tro), ds_tr(Vt + (j0 + 8) * VP + cb + tro));
                oacc[dvb] = MFMA32(vf, pb, oacc[dvb]);
            }
        }
    }
    f32x16 cacc[2]; cacc[0] = f32x16{}; cacc[1] = f32x16{};
    { const bf16* sp = (const bf16*)(ws + WS_ST) + (size_t)unit * 16384 + (size_t)(dh * 2 * 8 * 64 + lane) * 8;
#pragma unroll
      for (int s = 0; s < 8; ++s) {
          const bf16x8 a0 = *(const bf16x8*)(sp + s * 512), a1 = *(const bf16x8*)(sp + 8 * 512 + s * 512);
          cacc[0] = MFMA32(a0, qf[s], cacc[0]); cacc[1] = MFMA32(a1, qf[s], cacc[1]);
      } }
    const float qd = exp2f((float)(il + 1) * lg);
    float s1 = 0.f, s2 = 0.f;
#pragma unroll
    for (int dvb = 0; dvb < 2; ++dvb)
#pragma unroll
        for (int r = 0; r < 16; ++r) { const float o = oacc[dvb][r] + qd * cacc[dvb][r]; oacc[dvb][r] = o; s1 += o; s2 += o * o; }
    s1 = xor32_sum(s1); s2 = xor32_sum(s2);
    if (hi == 0) { red[(dh * 128 + il) * 2] = s1; red[(dh * 128 + il) * 2 + 1] = s2; }
    __syncthreads();
    const float t1 = red[il * 2] + red[(128 + il) * 2], t2 = red[il * 2 + 1] + red[(128 + il) * 2 + 1];
    const float mu = t1 * (1.f / 128.f), var = fmaxf(t2 * (1.f / 128.f) - mu * mu, 0.f), rstd = 1.f / sqrtf(var + GN_EPS);
    const float* gg = (const float*)A.in[I_GNG] + h * 128; const float* gb = (const float*)A.in[I_GNB] + h * 128;
    const bf16* rgp = (const bf16*)(ws + WS_RG);
    bf16* yp = (bf16*)(ws + WS_YMIX) + (row0 + il) * 1024 + h * 128;
    u32x2 rgv[2][4];
#pragma unroll
    for (int dvb = 0; dvb < 2; ++dvb)
#pragma unroll
        for (int q = 0; q < 4; ++q) rgv[dvb][q] = *(const u32x2*)(rgp + CM(h * 128 + 32 * (2 * dh + dvb) + 8 * q + 4 * hi, row0 + il));
#pragma unroll
    for (int dvb = 0; dvb < 2; ++dvb)
#pragma unroll
        for (int q = 0; q < 4; ++q) {
            const int dv = 32 * (2 * dh + dvb) + 8 * q + 4 * hi;
            const f32x4 g4 = *(const f32x4*)(gg + dv), b4 = *(const f32x4*)(gb + dv);
            const u32x2 rg = rgv[dvb][q];
            const float y0 = ((oacc[dvb][4 * q] - mu) * rstd * g4.x + b4.x) * bflo(rg.x), y1 = ((oacc[dvb][4 * q + 1] - mu) * rstd * g4.y + b4.y) * bfhi(rg.x);
            const float y2 = ((oacc[dvb][4 * q + 2] - mu) * rstd * g4.z + b4.z) * bflo(rg.y), y3 = ((oacc[dvb][4 * q + 3] - mu) * rstd * g4.w + b4.w) * bfhi(rg.y);
            u32x2 o; o.x = pk2(y0, y1); o.y = pk2(y2, y3); *(u32x2*)(yp + dv) = o;
        }
}

__device__ __forceinline__ void ret_decode_unit(const Args& A, LAS unsigned char* lds, int unit, int tid, int lane, int wave) {
    unsigned char* ws = A.ws;
    const int b = unit >> 2, h = unit & 3;
    LAS float* qL = (LAS float*)lds; LAS float* kL = qL + 1024; LAS float* vL = kL + 1024; LAS float* sL = vL + 1024;
    LAS float* red = sL + 64;
    const float lg = log2g(h);
    __syncthreads();
    { bf16 t6[6];
#pragma unroll
      for (int u = 0; u < 6; ++u) { const int i = tid + 512 * u, w = i >> 10, q = i & 1023, j = q >> 7, d = q & 127;
          t6[u] = *((const bf16*)(ws + (w == 0 ? WS_QR : w == 1 ? WS_KR : WS_VR)) + CM(h * 128 + d, NP + b * 8 + j)); }
#pragma unroll
      for (int u = 0; u < 6; ++u) qL[tid + 512 * u] = bf2f(t6[u]); }
    __syncthreads();
    {
        const int i = wave, j = lane & 7, sl = lane >> 3; float a = 0.f;
#pragma unroll
        for (int d = 0; d < 16; ++d) a += qL[i * 128 + sl * 16 + d] * kL[j * 128 + sl * 16 + d];
        a += __shfl_xor(a, 8); a += __shfl_xor(a, 16); a += __shfl_xor(a, 32);
        if (lane < 8) sL[i * 8 + j] = (j <= i) ? a * exp2f((float)(i - j) * lg) : 0.f;
    }
    const int dv = tid & 127, dkq = tid >> 7;
    float vj[8], cr[8];
#pragma unroll
    for (int j = 0; j < 8; ++j) { vj[j] = vL[j * 128 + dv] * exp2f((float)(7 - j) * lg); cr[j] = 0.f; }
    const float g8 = exp2f(8.f * lg);
    const float* stp = (const float*)A.in[I_SRET] + (size_t)unit * 16384 + dv;
    float* nsp = A.out + O_RETS + (size_t)unit * 16384 + dv;
    float stv[32];
#pragma unroll
    for (int k = 0; k < 32; ++k) stv[k] = stp[(32 * dkq + k) * 128];
#pragma unroll
    for (int k = 0; k < 32; ++k) { const int dk = 32 * dkq + k;
        const float st = stv[k]; float ns = g8 * st;
#pragma unroll
        for (int j = 0; j < 8; ++j) { cr[j] += qL[j * 128 + dk] * st; ns += kL[j * 128 + dk] * vj[j]; }
        nsp[dk * 128] = ns;
    }
#pragma unroll
    for (int j = 0; j < 8; ++j) red[(dkq * 8 + j) * 128 + dv] = cr[j];
    __syncthreads();
    {
        const int i = wave; const float qd = exp2f((float)(i + 1) * lg);
        float o[2], s1 = 0.f, s2 = 0.f;
#pragma unroll
        for (int k = 0; k < 2; ++k) { const int d = lane + 64 * k;
            float x = (red[(0 * 8 + i) * 128 + d] + red[(1 * 8 + i) * 128 + d]) + (red[(2 * 8 + i) * 128 + d] + red[(3 * 8 + i) * 128 + d]);
            x *= qd;
#pragma unroll
            for (int j = 0; j < 8; ++j) x += sL[i * 8 + j] * vL[j * 128 + d];
            o[k] = x; s1 += x; s2 += x * x; }
        s1 = wave_sum(s1); s2 = wave_sum(s2);
        const float mu = s1 * (1.f / 128.f), var = fmaxf(s2 * (1.f / 128.f) - mu * mu, 0.f), rstd = 1.f / sqrtf(var + GN_EPS);
        const size_t row = (size_t)NP + b * 8 + i;
#pragma unroll
        for (int k = 0; k < 2; ++k) { const int d = lane + 64 * k;
            const float y = ((o[k] - mu) * rstd * ((const float*)A.in[I_GNG])[h * 128 + d] + ((const float*)A.in[I_GNB])[h * 128 + d]) * bf2f(((const bf16*)(ws + WS_RG))[CM(h * 128 + d, row)]);
            ((bf16*)(ws + WS_YMIX))[row * 1024 + h * 128 + d] = (bf16)f2bf(y); }
    }
}

constexpr int NSA_KP = 144, NSA_VP = 192;
constexpr int NSA_SLOT = 8192;
constexpr int NSA_KT = 0, NSA_VT = 3 * NSA_SLOT, NSA_IMP = NSA_VT + 4 * NSA_SLOT,
     NSA_SEL = NSA_IMP + 4 * 64 * 65 * 4, NSA_IMPF = NSA_SEL + 64 * 8, NSA_GLS = NSA_IMPF + 4 * 64 * 4, NSA_END = NSA_GLS + 3 * 512 * 4;
static_assert(NSA_END <= MISC_OFF && 128 * NSA_KP <= 3 * NSA_SLOT && 128 * NSA_VP <= 4 * NSA_SLOT, "nsa lds");
__device__ __forceinline__ void glds16(const void* g, unsigned lds_base) {
    unsigned sv; asm volatile("s_mov_b32 %0, m0\n\ts_mov_b32 m0, %2\n\ts_nop 0\n\tglobal_load_lds_dwordx4 %1, off\n\ts_mov_b32 m0, %0" : "=&s"(sv) : "v"(g), "s"(lds_base) : "memory"); }

__device__ __forceinline__ float max3f(float a, float b, float c) { float r; asm("v_max3_f32 %0, %1, %2, %3" : "=v"(r) : "v"(a), "v"(b), "v"(c)); return r; }
__device__ __forceinline__ float max2f(float a, float b) { float r; asm("v_max_f32_e32 %0, %1, %2" : "=v"(r) : "v"(a), "v"(b)); return r; }
constexpr float NSA_THR = 8.f;
__device__ __forceinline__ void nsa_qk(f32x16& p0, f32x16& p1, const f32x16& negm, const bf16x8 (&q)[4], LAS const unsigned char* Kt, int r32, int hi, int tl, bool on, int mode) {
    f32x16 c0;
#pragma unroll
    for (int r = 0; r < 16; ++r) c0[r] = on ? negm[r] : NEGBIG;
    bf16x8 kf[8];
#pragma unroll
    for (int d0 = 0; d0 < 4; ++d0) { kf[2 * d0] = *(LAS const bf16x8*)(Kt + d0 * 2048 + hi * 1024 + r32 * 16); kf[2 * d0 + 1] = *(LAS const bf16x8*)(Kt + d0 * 2048 + hi * 1024 + 512 + r32 * 16); }
    __builtin_amdgcn_sched_barrier(0);
#pragma unroll
    for (int d0 = 0; d0 < 4; ++d0) {
        if (d0 == 0) { p0 = MFMA32(kf[0], q[0], c0); p1 = MFMA32(kf[1], q[0], c0); } else { p0 = MFMA32(kf[2 * d0], q[d0], p0); p1 = MFMA32(kf[2 * d0 + 1], q[d0], p1); }
    }
    if (mode != 0) {
        asm volatile("" : "+v"(tl));
        const int lo = (mode == 2) ? tl : 0, hb = (mode == 1) ? tl : 63;
#pragma unroll
        for (int r = 0; r < 16; ++r) { const int kk = crow(r, hi);
            p0[r] = (kk >= lo && kk <= hb) ? p0[r] : NEGBIG; p1[r] = (kk + 32 >= lo && kk + 32 <= hb) ? p1[r] : NEGBIG; }
    }
}
__device__ __forceinline__ void nsa_sv(f32x16 (&o)[2], f32x16& negm, float& m, float& l, f32x16& p0, f32x16& p1, LAS const unsigned char* Vt, int hi, int vb) {
    float mx = max3f(p0[0], p0[1], p1[0]), mb = max3f(p0[2], p0[3], p1[1]); mx = max3f(mx, p1[2], p1[3]);
#pragma unroll
    for (int r = 4; r < 16; r += 4) { mx = max3f(mx, p0[r], p0[r + 1]); mb = max3f(mb, p0[r + 2], p0[r + 3]); mx = max3f(mx, p1[r], p1[r + 1]); mb = max3f(mb, p1[r + 2], p1[r + 3]); }
    mx = xor32_max(max2f(mx, mb));
    if (__any(mx > NSA_THR)) {
        const float d = fmaxf(mx, 0.f), alpha = __builtin_amdgcn_exp2f(-d);
        m += d; l *= alpha;
#pragma unroll
        for (int r = 0; r < 16; ++r) { p0[r] -= d; p1[r] -= d; o[0][r] *= alpha; o[1][r] *= alpha; negm[r] = -m; }
    }
    f32x2 rs0 = {0.f, 0.f}, rs1 = {0.f, 0.f};
#pragma unroll
    for (int r = 0; r < 16; r += 2) {
        p0[r] = __builtin_amdgcn_exp2f(p0[r]); p0[r + 1] = __builtin_amdgcn_exp2f(p0[r + 1]); p1[r] = __builtin_amdgcn_exp2f(p1[r]); p1[r + 1] = __builtin_amdgcn_exp2f(p1[r + 1]);
        rs0 += (f32x2){p0[r], p0[r + 1]}; rs1 += (f32x2){p1[r], p1[r + 1]};
    }
    l += (rs0.x + rs0.y) + (rs1.x + rs1.y);
#pragma unroll
    for (int s = 0; s < 4; ++s) {
        const bf16x8 pb = pack_frag(s < 2 ? p0 : p1, 8 * (s & 1));
#pragma unroll
        for (int db = 0; db < 2; ++db) {
            const bf16x8 vf = cat8(ds_tr(Vt + db * 4096 + s * 1024 + vb), ds_tr(Vt + db * 4096 + s * 1024 + 512 + vb));
            o[db] = MFMA32(vf, pb, o[db]);
        }
    }
}

__device__ __forceinline__ void nsa_prompt_unit(const Args& A, LAS unsigned char* lds, int b, int kvh, int qb, int tid, int lane, int wave) {
    unsigned char* ws = A.ws;
    asm volatile("" : "+v"(tid), "+v"(lane));
    const int r32 = lane & 31, hi = lane >> 5, g = wave & 3, qs = wave >> 2, hq = kvh * 4 + g, tl = 32 * qs + r32, q0 = 64 * qb, t = q0 + tl;
    const size_t rowb = (size_t)b * SEQ, row = rowb + t;
    const int tro = tr_off(lane, NSA_VP);
    LAS unsigned char* KT = lds + NSA_KT; LAS unsigned char* VT = lds + NSA_VT;
    LAS float* IMP = (LAS float*)(lds + NSA_IMP); LAS unsigned long long* SEL = (LAS unsigned long long*)(lds + NSA_SEL); LAS float* IMPF = (LAS float*)(lds + NSA_IMPF); LAS float* GLS = (LAS float*)(lds + NSA_GLS);
    const int lrow = tid & 63, lch = tid >> 6;
    __syncthreads();
    {
        const bf16* kc = (const bf16*)(ws + WS_KCP) + ((size_t)b * 128) * 128 + kvh * 64 + lch * 8; const bf16* vc = (const bf16*)(ws + WS_VCP) + ((size_t)b * 128) * 128 + kvh * 64 + lch * 8;
#pragma unroll
        for (int i = 0; i < 2; ++i) { const int rr = lrow + 64 * i;
            *(LAS u32x4*)(KT + rr * NSA_KP + lch * 16) = *(const u32x4*)(kc + (size_t)rr * 128);
            *(LAS u32x4*)(VT + rr * NSA_VP + lch * 16) = *(const u32x4*)(vc + (size_t)rr * 128); }
    }
    bf16x8 qr[4];
    f32x16 otot[2];
    const float* glp = (const float*)(ws + WS_GL) + row * 32 + hq;
    {
        bf16x8 qn[4];
        const bf16* qp = (const bf16*)(ws + WS_QN) + CM(hq * 64 + 8 * hi, row);
#pragma unroll
        for (int d0 = 0; d0 < 4; ++d0) qn[d0] = *(const bf16x8*)(qp + (size_t)d0 * (2 * NTOK * 8));
        { const float ga = glp[0], gb = glp[8], gc = glp[16]; GLS[tid] = ga; GLS[512 + tid] = gb; GLS[1024 + tid] = gc; }
        __syncthreads();
        const int ntile = (qb >= 31) ? 2 : 1, nvalid = (t + 1) >> 5;
        float mx = MINIT;
#pragma unroll 1
        for (int pt = 0; pt < 2 * ntile; ++pt) {
            f32x16 p = f32x16{};
#pragma unroll
            for (int d0 = 0; d0 < 4; ++d0) { const bf16x8 kf = *(LAS const bf16x8*)(KT + (32 * pt + r32) * NSA_KP + (16 * d0 + 8 * hi) * 2); p = MFMA32(kf, qn[d0], p); }
#pragma unroll
            for (int r = 0; r < 16; ++r) { const int cidx = 32 * pt + crow(r, hi); mx = fmaxf(mx, (cidx < nvalid) ? p[r] : NEGBIG); }
        }
        mx = xor32_max(mx);
        float ls = 0.f;
        f32x16 oc[2]; oc[0] = f32x16{}; oc[1] = f32x16{};
        LAS float* ip = IMP + (g * 64 + tl) * 65;
#pragma unroll 1
        for (int pt = 0; pt < 4; ++pt) {
            f32x16 p = f32x16{};
            if (pt < 2 * ntile) {
#pragma unroll
                for (int d0 = 0; d0 < 4; ++d0) { const bf16x8 kf = *(LAS const bf16x8*)(KT + (32 * pt + r32) * NSA_KP + (16 * d0 + 8 * hi) * 2); p = MFMA32(kf, qn[d0], p); }
            }
#pragma unroll
            for (int r = 0; r < 16; ++r) { const int cidx = 32 * pt + crow(r, hi); p[r] = (cidx < nvalid) ? __builtin_amdgcn_exp2f(p[r] - mx) : 0.f; ls += p[r]; }
#pragma unroll
            for (int r = 1; r < 16; r += 2) ip[16 * pt + (crow(r - 1, hi) >> 1)] = p[r - 1] + p[r];
            if (pt < 2 * ntile) {
#pragma unroll
                for (int s2 = 0; s2 < 2; ++s2) {
                    const bf16x8 pb = pack_frag(p, 8 * s2);
                    const int j0 = 32 * pt + 16 * s2 + 4 * hi;
#pragma unroll
                    for (int db = 0; db < 2; ++db) { const bf16x8 vf = cat8(ds_tr(VT + j0 * NSA_VP + 64 * db + tro), ds_tr(VT + (j0 + 8) * NSA_VP + 64 * db + tro)); oc[db] = MFMA32(vf, pb, oc[db]); }
                }
            }
        }
        ls = xor32_sum(ls);
        const float inv = ls > 0.f ? 1.f / ls : 0.f;
        if (hi == 0) IMPF[g * 64 + tl] = inv;
#pragma unroll
        for (int r = 0; r < 16; ++r) { oc[0][r] *= inv; oc[1][r] *= inv; }
        const float g0 = GLS[tid];
#pragma unroll
        for (int r = 0; r < 16; ++r) { otot[0][r] = g0 * oc[0][r]; otot[1][r] = g0 * oc[1][r]; }
    }
    __syncthreads();
#pragma unroll 1
    for (int q4 = 0; q4 < 8; q4 += 4) {
        unsigned key[4], thr[4];
#pragma unroll
        for (int u = 0; u < 4; ++u) {
            const int tq = 8 * wave + q4 + u;
            const float imp = (IMP[(0 * 64 + tq) * 65 + lane] * IMPF[tq] + IMP[(1 * 64 + tq) * 65 + lane] * IMPF[64 + tq]) + (IMP[(2 * 64 + tq) * 65 + lane] * IMPF[128 + tq] + IMP[(3 * 64 + tq) * 65 + lane] * IMPF[192 + tq]);
            const bool forced = (lane == 0) || (lane == qb), valid = lane <= qb;
            key[u] = forced ? 0xFFFFFFFFu : (valid ? (__builtin_bit_cast(unsigned, imp) | 0x80000000u) : 0u);
            thr[u] = 0u;
        }
#pragma unroll 2
        for (int bit = 31; bit >= 0; --bit) {
#pragma unroll
            for (int u = 0; u < 4; ++u) { const unsigned cand = thr[u] | (1u << bit); if (__popcll(__ballot(key[u] >= cand)) >= 16) thr[u] = cand; }
        }
#pragma unroll
        for (int u = 0; u < 4; ++u) {
            const int tq = 8 * wave + q4 + u;
            const unsigned long long mgt = __ballot(key[u] > thr[u]), meq = __ballot(key[u] == thr[u]);
            const int need = 16 - __popcll(mgt);
            const int below = __builtin_amdgcn_mbcnt_hi((unsigned)(meq >> 32), __builtin_amdgcn_mbcnt_lo((unsigned)meq, 0u));
            const unsigned long long mask = mgt | __ballot(key[u] == thr[u] && below < need);
            if (lane == 0) SEL[tq] = mask;
        }
    }
    __syncthreads();
    LAS float* park = IMP + tid;
#pragma unroll
    for (int r = 0; r < 16; ++r) { park[r * 512] = otot[0][r]; park[(16 + r) * 512] = otot[1][r]; }
    { const bf16* qp2 = (const bf16*)(ws + WS_QROT) + CM(hq * 64 + 8 * hi, row);
#pragma unroll
      for (int d0 = 0; d0 < 4; ++d0) qr[d0] = *(const bf16x8*)(qp2 + (size_t)d0 * (2 * NTOK * 8)); }
    const unsigned long long sel = SEL[tl];
    const int jw0 = qb > 8 ? qb - 8 : 0, nB = qb + 1, NT = nB + (qb - jw0 + 1);
    const int wv = __builtin_amdgcn_readfirstlane(wave);
    const size_t kso = CM(kvh * 64 + wv * 8, rowb + lane), vso = CM(kvh * 64 + (wv >> 2) * 32 + (lane & 3) * 8, rowb + 16 * (wv & 3) + (lane >> 2));
    const bf16* ksb = (const bf16*)(ws + WS_KS) + kso; const bf16* vsb = (const bf16*)(ws + WS_VS) + vso;
    const bf16* kwb = (const bf16*)(ws + WS_KW) + kso; const bf16* vwb = (const bf16*)(ws + WS_VW) + vso;
    const unsigned kdst = (unsigned)(size_t)(lds + NSA_KT) + wv * 1024, vdst = (unsigned)(size_t)(lds + NSA_VT) + wv * 1024;
    const int vb = ((lane >> 4) & 1) * 32 + (lane & 3) * 8 + (4 * hi + ((lane & 15) >> 2)) * 64;
    f32x16 o[2]; o[0] = f32x16{}; o[1] = f32x16{};
    f32x16 negm = f32x16{};
    float m = 0.f, l = 0.f;
    const bool trail = qs != 0;
    f32x16 p0, p1; bool pend = false; int pend_v = 0, ks = 0;
#define NSA_DMA(T, KSL) do { const int t_ = ((T) < NT) ? (T) : NT - 1; const bool sl_ = t_ < nB; const int j_ = sl_ ? t_ : jw0 + (t_ - nB); \
        glds16((sl_ ? ksb : kwb) + (size_t)j_ * 512, (unsigned)__builtin_amdgcn_readfirstlane(kdst + (KSL) * NSA_SLOT)); \
        glds16((sl_ ? vsb : vwb) + (size_t)j_ * 512, (unsigned)__builtin_amdgcn_readfirstlane(vdst + ((T) & 3) * NSA_SLOT)); } while (0)
    asm volatile("" : "+v"(qr[0]), "+v"(qr[1]), "+v"(qr[2]), "+v"(qr[3]));
    NSA_DMA(0, 0); NSA_DMA(1, 1);
    if (trail) __builtin_amdgcn_s_setprio(1);
#pragma unroll 1
    for (int n = 0; n < NT; ++n) {
        asm volatile("s_waitcnt vmcnt(2) lgkmcnt(0)\n\ts_barrier" ::: "memory");
        const int ks2 = (ks == 0) ? 2 : ks - 1;
        NSA_DMA(n + 2, ks2);
        LAS unsigned char* kt = KT + ks * NSA_SLOT; LAS unsigned char* vt = VT + (n & 3) * NSA_SLOT;
        if (pend) { nsa_sv(o, negm, m, l, p0, p1, VT + pend_v, hi, vb); pend = false; }
        if (n == nB) {
            const float lt = xor32_sum(l), sc = GLS[512 + tid] / lt;
#pragma unroll
            for (int r = 0; r < 16; ++r) { park[r * 512] += sc * o[0][r]; park[(16 + r) * 512] += sc * o[1][r]; }
            o[0] = f32x16{}; o[1] = f32x16{}; negm = f32x16{}; m = 0.f; l = 0.f;
        }
        const bool slc = n < nB; const int j = slc ? n : jw0 + (n - nB);
        const bool on = slc ? (bool)((sel >> n) & 1ull) : true;
        const bool act = __any(on);
        const int mode = (j == qb) ? 1 : ((!slc && j == qb - 8) ? 2 : 0);
        if (act) nsa_qk(p0, p1, negm, qr, kt, r32, hi, tl, on, mode);
        if (trail) { pend = act; pend_v = (n & 3) * NSA_SLOT; }
        else if (act) nsa_sv(o, negm, m, l, p0, p1, vt, hi, vb);
        ks = (ks == 2) ? 0 : ks + 1;
    }
#undef NSA_DMA
    __builtin_amdgcn_s_setprio(0);
    asm volatile("s_waitcnt vmcnt(0)" ::: "memory");
    if (pend) nsa_sv(o, negm, m, l, p0, p1, VT + pend_v, hi, vb);
    {
        const float lt = xor32_sum(l), sc = GLS[1024 + tid] / lt;
#pragma unroll
        for (int r = 0; r < 16; ++r) { otot[0][r] = park[r * 512] + sc * o[0][r]; otot[1][r] = park[(16 + r) * 512] + sc * o[1][r]; }
    }
    const bf16* ngp = (const bf16*)(ws + WS_NG); bf16* yp = (bf16*)(ws + WS_YMIX) + row * 1024 + 512 + hq * 64;
    u32x2 ngv[2][4];
#pragma unroll
    for (int db = 0; db < 2; ++db)
#pragma unroll
        for (int q = 0; q < 4; ++q) ngv[db][q] = *(const u32x2*)(ngp + CM(hq * 64 + 32 * db + 8 * q + 4 * hi, row));
#pragma unroll
    for (int db = 0; db < 2; ++db)
#pragma unroll
        for (int q = 0; q < 4; ++q) {
            const int d = 32 * db + 8 * q + 4 * hi;
            const u32x2 ng = ngv[db][q];
            u32x2 ov; ov.x = pk2(otot[db][4 * q] * bflo(ng.x), otot[db][4 * q + 1] * bfhi(ng.x)); ov.y = pk2(otot[db][4 * q + 2] * bflo(ng.y), otot[db][4 * q + 3] * bfhi(ng.y));
            *(u32x2*)(yp + d) = ov;
        }
}

template <int CTRL> __device__ __forceinline__ float dpp_add(float v) { return v + __builtin_bit_cast(float, __builtin_amdgcn_update_dpp(0, __builtin_bit_cast(int, v), CTRL, 0xf, 0xf, true)); }
__device__ __forceinline__ float red16(float v) { v = dpp_add<0xB1>(v); v = dpp_add<0x4E>(v); v = dpp_add<0x141>(v); v = dpp_add<0x140>(v); return v; }
__device__ __forceinline__ float dot4(const f32x4 a, const f32x4 b) { return (a.x * b.x + a.y * b.y) + (a.z * b.z + a.w * b.w); }

__device__ __forceinline__ void dec_block(float (&m)[4], float (&l)[4], f32x4 (&o)[4], const f32x4 (&q)[4], const float* Kb, const float* Vb, int lo, int hi_, int kk) {
#pragma unroll 1
    for (int hb = 0; hb < 2; ++hb) {
        if (32 * hb >= hi_ || 32 * hb + 32 <= lo) continue;
        f32x4 kr[8], vr[8]; float s[8][4];
#pragma unroll
        for (int it = 0; it < 8; ++it) { const int key = 32 * hb + 4 * it + kk; const int kc = (key >= lo && key < hi_) ? key : lo; kr[it] = *(const f32x4*)(Kb + (size_t)kc * 128); }
#pragma unroll
        for (int it = 0; it < 8; ++it) { const int key = 32 * hb + 4 * it + kk; const bool valid = key >= lo && key < hi_; const int kc = valid ? key : lo;
            vr[it] = *(const f32x4*)(Vb + (size_t)kc * 128);
#pragma unroll
            for (int g = 0; g < 4; ++g) { const float d = red16(dot4(q[g], kr[it])); s[it][g] = valid ? d : NEGBIG; } }
#pragma unroll
        for (int g = 0; g < 4; ++g) {
            float mx = s[0][g];
#pragma unroll
            for (int it = 1; it < 8; ++it) mx = fmaxf(mx, s[it][g]);
            mx = fmaxf(mx, __shfl_xor(mx, 16)); mx = fmaxf(mx, __shfl_xor(mx, 32));
            const float mn = fmaxf(m[g], mx), alpha = __builtin_amdgcn_exp2f(m[g] - mn);
            m[g] = mn; l[g] *= alpha; o[g] = o[g] * alpha;
#pragma unroll
            for (int it = 0; it < 8; ++it) { const float p = __builtin_amdgcn_exp2f(s[it][g] - mn); l[g] += p; o[g] = o[g] + vr[it] * p; }
        }
    }
}
__device__ __forceinline__ void dec_publish(const float (&m)[4], float (&l)[4], f32x4 (&o)[4], LAS float* st, LAS float* ob, int wave, int lane) {
#pragma unroll
    for (int g = 0; g < 4; ++g) {
        l[g] += __shfl_xor(l[g], 16); l[g] += __shfl_xor(l[g], 32);
#pragma unroll
        for (int e = 0; e < 4; ++e) { float x = o[g][e]; x += __shfl_xor(x, 16); x += __shfl_xor(x, 32); o[g][e] = x; }
        if (lane < 16) *(LAS f32x4*)(ob + (wave * 4 + g) * 64 + 4 * lane) = o[g];
        if (lane == 0) { st[(wave * 4 + g) * 2] = m[g]; st[(wave * 4 + g) * 2 + 1] = l[g]; }
    }
}
__device__ __forceinline__ float dec_combine(LAS const float* st, LAS const float* ob, int g, int d) {
    float M = NEGBIG;
#pragma unroll
    for (int w = 0; w < 8; ++w) M = fmaxf(M, st[(w * 4 + g) * 2]);
    float L = 0.f, O = 0.f;
#pragma unroll
    for (int w = 0; w < 8; ++w) { const float f = exp2f(st[(w * 4 + g) * 2] - M); L += f * st[(w * 4 + g) * 2 + 1]; O += f * ob[(w * 4 + g) * 64 + d]; }
    return L > 0.f ? O / L : 0.f;
}

__device__ __forceinline__ void nsa_decode_unit(const Args& A, LAS unsigned char* lds, int unit, int tid, int lane, int wave) {
    unsigned char* ws = A.ws;
    const int b = unit >> 4, kvh = (unit >> 3) & 1, t = unit & 7, kk = lane >> 4, dq = lane & 15;
    const size_t row = (size_t)NP + b * 8 + t;
    LAS float* sc = (LAS float*)lds;
    LAS float* scr = sc + 2048;
    LAS int* selL = (LAS int*)(scr + 260);
    LAS float* ocmp = (LAS float*)(selL + 16);
    LAS float* st1 = ocmp + 2048; LAS float* ob1 = st1 + 64;
    LAS float* st2 = ob1 + 2048; LAS float* ob2 = st2 + 64;
    f32x4 qn[4], qr[4];
#pragma unroll
    for (int g = 0; g < 4; ++g) {
        const u32x2 a = *(const u32x2*)((const bf16*)(ws + WS_QN) + CM((kvh * 4 + g) * 64 + 4 * dq, row)), c = *(const u32x2*)((const bf16*)(ws + WS_QROT) + CM((kvh * 4 + g) * 64 + 4 * dq, row));
        qn[g] = (f32x4){bflo(a.x), bfhi(a.x), bflo(a.y), bfhi(a.y)}; qr[g] = (f32x4){bflo(c.x), bfhi(c.x), bflo(c.y), bfhi(c.y)};
    }
    __syncthreads();
    const float* kcs = (const float*)(ws + WS_KCS) + ((size_t)b * 512 * 2 + kvh) * 64 + 4 * dq; const float* vcs = (const float*)(ws + WS_VCS) + ((size_t)b * 512 * 2 + kvh) * 64 + 4 * dq;
    f32x4 krr[16];
#pragma unroll
    for (int it = 0; it < 16; ++it) krr[it] = *(const f32x4*)(kcs + (size_t)(64 * wave + 4 * it + kk) * 128);
#pragma unroll
    for (int it = 0; it < 16; ++it) {
        const int key = 64 * wave + 4 * it + kk;
        const f32x4 kr = krr[it];
        const float s0 = red16(dot4(qn[0], kr)), s1 = red16(dot4(qn[1], kr)), s2 = red16(dot4(qn[2], kr)), s3 = red16(dot4(qn[3], kr));
        if (dq < 4) sc[dq * 512 + key] = dq == 0 ? s0 : dq == 1 ? s1 : dq == 2 ? s2 : s3;
    }
    __syncthreads();
    if (wave < 4) {
        float v[8], mx = NEGBIG;
#pragma unroll
        for (int i = 0; i < 8; ++i) { v[i] = sc[wave * 512 + lane + 64 * i]; mx = fmaxf(mx, v[i]); }
        mx = wave_max(mx); float sm = 0.f;
#pragma unroll
        for (int i = 0; i < 8; ++i) { v[i] = __builtin_amdgcn_exp2f(v[i] - mx); sm += v[i]; }
        sm = wave_sum(sm); const float inv = 1.f / sm;
#pragma unroll
        for (int i = 0; i < 8; ++i) sc[wave * 512 + lane + 64 * i] = v[i] * inv;
    }
    __syncthreads();
    if (tid < 256) { float s = -1.f; if (tid > 0) s = (sc[2 * tid] + sc[2 * tid + 1]) + (sc[512 + 2 * tid] + sc[512 + 2 * tid + 1]) + ((sc[1024 + 2 * tid] + sc[1024 + 2 * tid + 1]) + (sc[1536 + 2 * tid] + sc[1536 + 2 * tid + 1])); scr[tid] = s; }
    {
        f32x4 oc[4]; oc[0] = oc[1] = oc[2] = oc[3] = (f32x4){0.f, 0.f, 0.f, 0.f};
        f32x4 vrr[16];
#pragma unroll
        for (int it = 0; it < 16; ++it) vrr[it] = *(const f32x4*)(vcs + (size_t)(64 * wave + 4 * it + kk) * 128);
#pragma unroll
        for (int it = 0; it < 16; ++it) {
            const int key = 64 * wave + 4 * it + kk;
            const f32x4 vr = vrr[it];
#pragma unroll
            for (int g = 0; g < 4; ++g) oc[g] = oc[g] + vr * sc[g * 512 + key];
        }
#pragma unroll
        for (int g = 0; g < 4; ++g) {
#pragma unroll
            for (int e = 0; e < 4; ++e) { float x = oc[g][e]; x += __shfl_xor(x, 16); x += __shfl_xor(x, 32); oc[g][e] = x; }
            if (lane < 16) *(LAS f32x4*)(ocmp + (wave * 4 + g) * 64 + 4 * lane) = oc[g];
        }
    }
    __syncthreads();
    {
        LAS int* rk = (LAS int*)ob1;
        const int c = tid & 255, half = tid >> 8; const float s = scr[c]; int rank = 0;
#pragma unroll 8
        for (int j4 = 0; j4 < 32; ++j4) { const f32x4 v = *(LAS const f32x4*)(scr + 128 * half + 4 * j4);
#pragma unroll
            for (int e = 0; e < 4; ++e) { const int j = 128 * half + 4 * j4 + e; rank += (v[e] > s || (v[e] == s && j < c)) ? 1 : 0; } }
        rk[tid] = rank;
        __syncthreads();
        if (tid > 0 && tid < 256) { const int r2 = rk[tid] + rk[tid + 256]; if (r2 < 14) selL[2 + r2] = tid; }
        if (tid == 0) { selL[0] = 0; selL[1] = 256; }
    }
    __syncthreads();
    {
        float m[4], l[4]; f32x4 o[4];
#pragma unroll
        for (int g = 0; g < 4; ++g) { m[g] = MINIT; l[g] = 0.f; o[g] = (f32x4){0.f, 0.f, 0.f, 0.f}; }
        const int bb0 = selL[2 * wave], bb1 = selL[2 * wave + 1];
        const int pg0 = ((const int*)A.in[I_PT])[b * 128 + ((bb0 < 256 ? bb0 : 0) >> 1)], pg1 = ((const int*)A.in[I_PT])[b * 128 + ((bb1 < 256 ? bb1 : 0) >> 1)];
#pragma unroll 1
        for (int i = 0; i < 2; ++i) {
            const int bb = i ? bb1 : bb0, pg = i ? pg1 : pg0;
            const bool past = bb < 256;
            const size_t base = past ? ((size_t)pg * 128 + (bb & 1) * 64) * 128 + kvh * 64 + 4 * dq : ((size_t)b * 8) * 128 + kvh * 64 + 4 * dq;
            const float* Kb = (past ? (const float*)A.in[I_CSK] : (const float*)(A.out + O_SLCK_S)) + base;
            const float* Vb = (past ? (const float*)A.in[I_CSV] : (const float*)(A.out + O_SLCV_S)) + base;
            dec_block(m, l, o, qr, Kb, Vb, 0, past ? 64 : t + 1, kk);
        }
        dec_publish(m, l, o, st1, ob1, wave, lane);
    }
    {
        float m[4], l[4]; f32x4 o[4];
#pragma unroll
        for (int g = 0; g < 4; ++g) { m[g] = MINIT; l[g] = 0.f; o[g] = (f32x4){0.f, 0.f, 0.f, 0.f}; }
#pragma unroll 1
        for (int i = 0; i < ((wave == 0) ? 2 : 1); ++i) {
            const size_t base = ((size_t)b * 512 + (i ? 504 : 64 * wave)) * 128 + kvh * 64 + 4 * dq;
            const float* Kb = (i ? (const float*)(A.out + O_WINK_S) : (const float*)A.in[I_SWK]) + base;
            const float* Vb = (i ? (const float*)(A.out + O_WINV_S) : (const float*)A.in[I_SWV]) + base;
            const int lo = i ? 0 : ((t > 64 * wave) ? (t - 64 * wave) : 0);
            dec_block(m, l, o, qr, Kb, Vb, lo, i ? t + 1 : 64, kk);
        }
        dec_publish(m, l, o, st2, ob2, wave, lane);
    }
    __syncthreads();
    if (tid < 256) {
        const int g = tid >> 6, d = tid & 63, hq = kvh * 4 + g;
        float oc = 0.f;
#pragma unroll
        for (int w = 0; w < 8; ++w) oc += ocmp[(w * 4 + g) * 64 + d];
        const float os = dec_combine(st1, ob1, g, d), ow = dec_combine(st2, ob2, g, d);
        const float* glp = (const float*)(ws + WS_GL) + row * 32 + hq;
        const float y = (glp[0] * oc + glp[8] * os + glp[16] * ow) * bf2f(((const bf16*)(ws + WS_NG))[CM(hq * 64 + d, row)]);
        ((bf16*)(ws + WS_YMIX))[row * 1024 + 512 + hq * 64 + d] = (bf16)f2bf(y);
    }
    __syncthreads();
}

struct EpiPle {
    static constexpr bool PERM = true, AFTER_DRAIN = false;
    unsigned char* ws;
    __device__ __forceinline__ void operator()(const pg8::f32x4 (&acc)[2][2][4][2], const pg8::Unit& u, int wr, int wc, int fr, int fq) const {
        asm volatile("" : "+v"(fr), "+v"(fq));
#pragma unroll
        for (int ai = 0; ai < 2; ++ai)
#pragma unroll
            for (int m = 0; m < 4; ++m) {
                const size_t row = (size_t)u.pm * 256 + ai * 128 + wr * 64 + m * 16 + fr;
#pragma unroll
                for (int bj = 0; bj < 2; ++bj) { bf16* d = (bf16*)(ws + WS_PPO) + row * 1024 + u.pn * 256 + bj * 128 + wc * 32 + 8 * fq;
                    const f32x4 a = acc[ai][bj][m][0], c = acc[ai][bj][m][1];
                    u32x4 w; w.x = pk2(a.x, a.y); w.y = pk2(a.z, a.w); w.z = pk2(c.x, c.y); w.w = pk2(c.z, c.w); *(u32x4*)d = w; }
            }
    }
};
struct EpiOut {
    static constexpr bool PERM = true, AFTER_DRAIN = false;
    unsigned char* ws; const float* xp; const float* xs;
    __device__ __forceinline__ void operator()(const pg8::f32x4 (&acc)[2][2][4][2], const pg8::Unit& u, int wr, int wc, int fr, int fq) const {
        asm volatile("" : "+v"(fr), "+v"(fq));
#pragma unroll
        for (int ai = 0; ai < 2; ++ai)
#pragma unroll
            for (int m = 0; m < 4; ++m) {
                const size_t row = (size_t)u.pm * 256 + ai * 128 + wr * 64 + m * 16 + fr;
                const float* xrow = (row < NP) ? xp + row * 1024 : xs + (row - NP) * 1024;
                float ss = 0.f;
#pragma unroll
                for (int bj = 0; bj < 2; ++bj) { const int col = u.pn * 256 + bj * 128 + wc * 32 + 8 * fq;
                    const f32x4 a = *(const f32x4*)(xrow + col) + acc[ai][bj][m][0], c = *(const f32x4*)(xrow + col + 4) + acc[ai][bj][m][1];
                    u32x4 w; w.x = pk2(a.x, a.y); w.y = pk2(a.z, a.w); w.z = pk2(c.x, c.y); w.w = pk2(c.z, c.w);
                    *(u32x4*)((bf16*)(ws + WS_X1B) + row * 1024 + col) = w;
                    ss += (a.x * a.x + a.y * a.y) + (a.z * a.z + a.w * a.w) + (c.x * c.x + c.y * c.y) + (c.z * c.z + c.w * c.w); }
                ss += __shfl_xor(ss, 16); ss += __shfl_xor(ss, 32);
                if (fq == 0) ((float*)(ws + WS_SS1))[row * 16 + u.pn * 4 + wc] = ss;
            }
    }
};
__device__ __forceinline__ void panel_meet(unsigned* cnt, unsigned expect, int tid) {
    asm volatile("s_waitcnt vmcnt(0)" ::: "memory");
    __syncthreads();
    if (tid == 0) {
        __hip_atomic_fetch_add(cnt, 1u, __ATOMIC_RELAXED, __HIP_MEMORY_SCOPE_AGENT);
        unsigned sp = 0;
        while (__hip_atomic_load(cnt, __ATOMIC_RELAXED, __HIP_MEMORY_SCOPE_AGENT) < expect) { __builtin_amdgcn_s_sleep(1); if (++sp > (1u << 22)) break; }
    }
    __syncthreads();
}
struct EpiGateNorm {
    static constexpr bool PERM = true, AFTER_DRAIN = false;
    unsigned char* ws; float* out; const float* nf;
    __device__ __forceinline__ void operator()(const pg8::f32x4 (&acc_)[2][2][4][2], const pg8::Unit& u, int wr, int wc, int fr, int fq) const {
        pg8::f32x4 (&acc)[2][2][4][2] = const_cast<pg8::f32x4 (&)[2][2][4][2]>(acc_);
        asm volatile("" : "+v"(fr), "+v"(fq));
#pragma unroll
        for (int ai = 0; ai < 2; ++ai)
#pragma unroll
            for (int m = 0; m < 4; ++m) {
                const size_t row = (size_t)u.pm * 256 + ai * 128 + wr * 64 + m * 16 + fr;
                const f32x4* sp = (const f32x4*)((const float*)(ws + WS_SS1) + row * 16);
                const f32x4 s0 = sp[0], s1 = sp[1], s2 = sp[2], s3 = sp[3];
                const float tot = ((s0.x + s0.y) + (s0.z + s0.w)) + ((s1.x + s1.y) + (s1.z + s1.w)) + (((s2.x + s2.y) + (s2.z + s2.w)) + ((s3.x + s3.y) + (s3.z + s3.w)));
                const float rstd = 1.f / sqrtf(tot * (1.f / 1024.f) + RMS_EPS);
                float ss = 0.f;
#pragma unroll
                for (int bj = 0; bj < 2; ++bj) { const int col = u.pn * 256 + bj * 128 + wc * 32 + 8 * fq;
                    const u32x4 xb = *(const u32x4*)((const bf16*)(ws + WS_X1B) + row * 1024 + col), pb = *(const u32x4*)((const bf16*)(ws + WS_PPO) + row * 1024 + col);
                    f32x4 a = {bflo(xb.x), bfhi(xb.x), bflo(xb.y), bfhi(xb.y)}, c = {bflo(xb.z), bfhi(xb.z), bflo(xb.w), bfhi(xb.w)};
                    const f32x4 pa = {bflo(pb.x), bfhi(pb.x), bflo(pb.y), bfhi(pb.y)}, pc = {bflo(pb.z), bfhi(pb.z), bflo(pb.w), bfhi(pb.w)};
#pragma unroll
                    for (int e = 0; e < 4; ++e) { a[e] += sigmoidf_(rstd * acc[ai][bj][m][0][e]) * pa[e]; c[e] += sigmoidf_(rstd * acc[ai][bj][m][1][e]) * pc[e]; }
                    acc[ai][bj][m][0] = a; acc[ai][bj][m][1] = c;
                    ss += (a.x * a.x + a.y * a.y) + (a.z * a.z + a.w * a.w) + (c.x * c.x + c.y * c.y) + (c.z * c.z + c.w * c.w); }
                ss += __shfl_xor(ss, 16); ss += __shfl_xor(ss, 32);
                if (fq == 0) __hip_atomic_store((float*)(ws + WS_SS2) + row * 16 + u.pn * 4 + wc, ss, __ATOMIC_RELAXED, __HIP_MEMORY_SCOPE_AGENT);
            }
        panel_meet((unsigned*)(ws + WS_CTL) + 16384 + 64 * u.pm, 4u, (int)threadIdx.x);
#pragma unroll
        for (int ai = 0; ai < 2; ++ai)
#pragma unroll
            for (int m = 0; m < 4; ++m) {
                const size_t row = (size_t)u.pm * 256 + ai * 128 + wr * 64 + m * 16 + fr;
                float* sp = (float*)(ws + WS_SS2) + row * 16 + 4 * fq;
                float tot = (__hip_atomic_load(sp, __ATOMIC_RELAXED, __HIP_MEMORY_SCOPE_AGENT) + __hip_atomic_load(sp + 1, __ATOMIC_RELAXED, __HIP_MEMORY_SCOPE_AGENT))
                          + (__hip_atomic_load(sp + 2, __ATOMIC_RELAXED, __HIP_MEMORY_SCOPE_AGENT) + __hip_atomic_load(sp + 3, __ATOMIC_RELAXED, __HIP_MEMORY_SCOPE_AGENT));
                tot += __shfl_xor(tot, 16); tot += __shfl_xor(tot, 32);
                const float rstd2 = 1.f / sqrtf(tot * (1.f / 1024.f) + RMS_EPS);
#pragma unroll
                for (int bj = 0; bj < 2; ++bj) { const int col = u.pn * 256 + bj * 128 + wc * 32 + 8 * fq;
                    const f32x4 g0 = *(const f32x4*)(nf + col), g1 = *(const f32x4*)(nf + col + 4);
                    float* d = out + O_Y + row * 1024 + col; *(f32x4*)d = acc[ai][bj][m][0] * rstd2 * g0; *(f32x4*)(d + 4) = acc[ai][bj][m][1] * rstd2 * g1; }
            }
    }
};
__device__ __forceinline__ void final_norm(const Args& A, int lane, int wave) {
    const int gw = blockIdx.x * 8 + wave, NGW = gridDim.x * 8;
    const f32x4* nf = (const f32x4*)A.in[I_NF];
    f32x4 g[4];
#pragma unroll
    for (int j = 0; j < 4; ++j) g[j] = nf[64 * j + lane];
    for (int row = gw; row < NTOK; row += NGW) {
        float tot = 0.f;
        if (row < NP) { const float* sp = (const float*)(A.ws + WS_SS2) + (size_t)row * 16;
#pragma unroll
            for (int i = 0; i < 16; ++i) tot += sp[i]; }
        else tot = wave_sum(lane < 32 ? ((const float*)(A.ws + WS_SS2D))[(size_t)(row - NP) * 32 + lane] : 0.f);
        const float rstd = 1.f / sqrtf(tot * (1.f / 1024.f) + RMS_EPS);
        f32x4* y = (f32x4*)(A.out + O_Y + (size_t)row * 1024) + lane;
#pragma unroll
        for (int j = 0; j < 4; ++j) { f32x4 v = y[64 * j]; v = v * rstd * g[j]; y[64 * j] = v; }
    }
}

template <int K, class Epi>
__device__ __forceinline__ void mini_gemm_unit(LAS unsigned char* lds, const bf16* A, int lda, const bf16* Bt, int rowblk, int colblk, const Epi& E, int tid, int lane, int wave) {
    const int row0 = rowblk * 128 + wave * 16, fr = lane & 15, fq = lane >> 4, col0 = colblk * 32;
    constexpr int BP = K * 2 + 16, CPR = K / 8;
    __syncthreads();
#pragma unroll
    for (int i = 0; i < 32 * CPR / 512; ++i) { const int q = tid + 512 * i, c = q / CPR, ch = q % CPR;
        *(LAS u32x4*)(lds + c * BP + ch * 16) = *(const u32x4*)(Bt + (size_t)(col0 + c) * K + ch * 8); }
    const bf16* a = A + (size_t)(row0 + fr) * lda + 8 * fq;
    LAS const unsigned char* b0 = lds + fr * BP + 16 * fq;
    __syncthreads();
    f32x4 c0 = {0.f, 0.f, 0.f, 0.f}, c1 = {0.f, 0.f, 0.f, 0.f};
#pragma unroll 8
    for (int s = 0; s < K / 32; ++s) {
        const bf16x8 av = *(const bf16x8*)(a + 32 * s), bv0 = *(LAS const bf16x8*)(b0 + 64 * s), bv1 = *(LAS const bf16x8*)(b0 + 16 * BP + 64 * s);
        c0 = __builtin_amdgcn_mfma_f32_16x16x32_bf16(av, bv0, c0, 0, 0, 0);
        c1 = __builtin_amdgcn_mfma_f32_16x16x32_bf16(av, bv1, c1, 0, 0, 0);
    }
    E(row0 + 4 * fq, col0 + fr, colblk, c0, c1, fr);
}
struct EpiNgl { unsigned char* ws;
    __device__ __forceinline__ void operator()(int r0, int col, int cb, const f32x4& c0, const f32x4& c1, int fr) const {
        float* gl = (float*)(ws + WS_GL);
#pragma unroll
        for (int i = 0; i < 4; ++i) { gl[(size_t)(r0 + i) * 32 + col] = sigmoidf_(c0[i]); gl[(size_t)(r0 + i) * 32 + col + 16] = sigmoidf_(c1[i]); } } };
struct DEpiPle { unsigned char* ws;
    __device__ __forceinline__ void operator()(int r0, int col, int cb, const f32x4& c0, const f32x4& c1, int fr) const {
#pragma unroll
        for (int i = 0; i < 4; ++i) { bf16* d = (bf16*)(ws + WS_PPO) + (size_t)(NP + r0 + i) * 1024 + col; d[0] = (bf16)f2bf(c0[i]); d[16] = (bf16)f2bf(c1[i]); } } };
struct DEpiOut { unsigned char* ws; const float* xs;
    __device__ __forceinline__ void operator()(int r0, int col, int cb, const f32x4& c0, const f32x4& c1, int fr) const {
#pragma unroll
        for (int i = 0; i < 4; ++i) { const size_t rd = r0 + i, row = NP + rd;
            const float a = xs[rd * 1024 + col] + c0[i], c = xs[rd * 1024 + col + 16] + c1[i];
            bf16* db = (bf16*)(ws + WS_X1B) + row * 1024 + col; db[0] = (bf16)f2bf(a); db[16] = (bf16)f2bf(c);
            const float ss = red16(a * a + c * c);
            if (fr == 0) ((float*)(ws + WS_SS1D))[rd * 32 + cb] = ss; } } };
struct DEpiGate { unsigned char* ws; float* out; const float* nf;
    __device__ __forceinline__ void operator()(int r0, int col, int cb, const f32x4& c0, const f32x4& c1, int fr) const {
        float va[4], vc[4];
#pragma unroll
        for (int i = 0; i < 4; ++i) { const size_t rd = r0 + i, row = NP + rd;
            const float* sp = (const float*)(ws + WS_SS1D) + rd * 32;
            const float tot = red16(sp[fr] + sp[16 + fr]), rstd = 1.f / sqrtf(tot * (1.f / 1024.f) + RMS_EPS);
            const bf16* x1 = (const bf16*)(ws + WS_X1B) + row * 1024 + col; const bf16* pp = (const bf16*)(ws + WS_PPO) + row * 1024 + col;
            va[i] = bf2f(x1[0]) + sigmoidf_(rstd * c0[i]) * bf2f(pp[0]); vc[i] = bf2f(x1[16]) + sigmoidf_(rstd * c1[i]) * bf2f(pp[16]);
            const float ss = red16(va[i] * va[i] + vc[i] * vc[i]);
            if (fr == 0) __hip_atomic_store((float*)(ws + WS_SS2D) + rd * 32 + cb, ss, __ATOMIC_RELAXED, __HIP_MEMORY_SCOPE_AGENT); }
        panel_meet((unsigned*)(ws + WS_CTL) + 32768 + 64 * (r0 >> 7), 32u, (int)threadIdx.x);
#pragma unroll
        for (int i = 0; i < 4; ++i) { const size_t rd = r0 + i, row = NP + rd;
            float* sp = (float*)(ws + WS_SS2D) + rd * 32;
            const float tot = red16(__hip_atomic_load(sp + fr, __ATOMIC_RELAXED, __HIP_MEMORY_SCOPE_AGENT) + __hip_atomic_load(sp + 16 + fr, __ATOMIC_RELAXED, __HIP_MEMORY_SCOPE_AGENT));
            const float rstd2 = 1.f / sqrtf(tot * (1.f / 1024.f) + RMS_EPS);
            float* d = out + O_Y + row * 1024 + col; d[0] = va[i] * rstd2 * nf[col]; d[16] = vc[i] * rstd2 * nf[col + 16]; } } };

constexpr int N_PHASES = 7;
#ifndef REP_PHASE
#define REP_PHASE -1
#endif
#ifndef MK_SINGLE
#define MK_SINGLE 1
#endif
__global__ void __launch_bounds__(512, 2) mega_fwd(Args args) {
    extern __shared__ __attribute__((aligned(16))) unsigned char lds_raw[];
    LAS unsigned char* lds = (LAS unsigned char*)lds_raw;
    const int tid = threadIdx.x, lane = tid & 63, wave = __builtin_amdgcn_readfirstlane(tid >> 6);
    volatile LAS unsigned* MISC = (volatile LAS unsigned*)(lds + MISC_OFF);
    if (tid < 64) MISC[tid] = 0u;
    __syncthreads();
    const int lo = args.ph_lo, hi = args.ph_hi;
    XcdBarrier bar; bar.bar = (unsigned*)(args.ws + WS_CTL) + CW_BAR; bar.x = 0; bar.st = nullptr;
    if (hi - lo > 1) bar = xcd_barrier_post((unsigned*)(args.ws + WS_CTL) + CW_BAR, MISC + 8);
#ifndef PH_MASK
#define PH_MASK 0xFF
#endif
#define IN(k) (((PH_MASK >> (k)) & 1) && lo <= (k) && (k) < hi)
#define SEAM(k) do { if (IN(k) && IN((k) + 1)) xcd_barrier(bar); } while (0)
    unsigned char* ws = args.ws;
    const int G = gridDim.x, bx = blockIdx.x;
#ifndef STAMP_A
#define STAMP_A -1
#define STAMP_B -1
#endif
#define STAMP(k) do { if (STAMP_A >= 0 && tid == 0) { const unsigned long long t_ = __builtin_amdgcn_s_memrealtime(); MISC[16 + 2 * (k)] = (unsigned)t_; MISC[17 + 2 * (k)] = (unsigned)(t_ >> 32); } } while (0)
    STAMP(0);

    if (IN(0)) { phase0(args, lds, tid, lane, wave); }
    SEAM(0); STAMP(1);
    if (IN(1)) {
#ifndef P1_REP_PARTS
#define P1_REP_PARTS 7
#endif
        const int p1m = args.rep ? P1_REP_PARTS : 7;
        const bool cfirst = (bx & 1) != 0;
        if (cfirst) { if (p1m & 4) for (int u = bx; u < 512; u += G) compress_unit<true>(args, lds, u, tid, lane, wave); }
        __syncthreads();
        if (p1m & 1) { pg8::Gemm g{(const pg8::bf16_t*)(ws + WS_H), (const pg8::bf16_t*)(ws + WS_WINT), NTOK, NPR, DM}; pg8::StaticOrder S; S.init(NTOK, NPR, G, bx);
          EpiInProj E{ws, args.out};
          pg8::gemm_phase<EpiInProj, pg8::StaticOrder, true, true>(lds, g, S, E); }
        if (p1m & 2) {
            const int nun = (NTOK / 256) * (NPR / 256), fl = (nun % G) ? (nun % G) : 0, nl = G - fl;
            if (bx >= fl) for (int u = bx - fl; u < NTOK / 128; u += nl) { EpiNgl E{ws}; mini_gemm_unit<1024>(lds, (const bf16*)(ws + WS_H), 1024, (const bf16*)(ws + WS_WNGLT), u, 0, E, tid, lane, wave); } }
        if (!cfirst) { if (p1m & 4) for (int u = bx; u < 512; u += G) compress_unit<true>(args, lds, u, tid, lane, wave); }
    }
    SEAM(1); STAMP(2);
    if (IN(2)) {
#ifndef P2_REP_PARTS
#define P2_REP_PARTS 15
#endif
        const int p2m = args.rep ? P2_REP_PARTS : 15;
        const int GW = (G > 32) ? G - 16 : G; const bool worker = bx < GW;
        if ((p2m & 1) && worker) { int kple = 256; asm volatile("" : "+s"(kple));
          pg8::Gemm g{(const pg8::bf16_t*)(ws + WS_PB), (const pg8::bf16_t*)(ws + WS_WPLET), NP, 1024, kple}; pg8::StaticOrder S; S.init(NP, 1024, GW, (bx + GW - 128) % GW);
          EpiPle E{ws};
          pg8::gemm_phase<EpiPle, pg8::StaticOrder, true, true>(lds, g, S, E); }
        for (int u = G - 17 - bx; u >= 0 && u < 64; u += G) { DEpiPle E{ws}; mini_gemm_unit<256>(lds, (const bf16*)(ws + WS_PB) + (size_t)NP * 256, 256, (const bf16*)(ws + WS_WPLET), u >> 5, u & 31, E, tid, lane, wave); }
        if (p2m & 2) for (int u = G - 1 - bx; u < 16; u += G) compress_unit<false>(args, lds, u, tid, lane, wave);
        if ((p2m & 4) && worker) for (int u = (bx + GW - 144) % GW; u < 512; u += GW) ret_pass1_unit(ws, lds, u, tid, lane, wave);
        if (p2m & 8) for (int u = bx; u < 128; u += G) ret_decode_unit(args, lds, u, tid, lane, wave);
        if (worker) win_shift(args, bx * 512 + tid, GW * 512);
    }
    SEAM(2); STAMP(3);
    if (IN(3)) {
#ifndef P3_REP_PARTS
#define P3_REP_PARTS 7
#endif
        const int p3m = args.rep ? P3_REP_PARTS : 7;
        if (p3m & 1) ret_pass2(args, tid);
        const bool dfirst = ((bx >> 5) & 1) != 0;
        if (dfirst && (p3m & 4)) for (int u = bx; u < 512; u += G) { const int w = u & 255, grp = (w & 7) + 8 * (w >> 5), tt = 2 * ((w >> 3) & 3) + (u >> 8);
            nsa_decode_unit(args, lds, grp * 8 + tt, tid, lane, wave); }
        if (p3m & 2) for (int pi = bx; pi < 512; pi += G) { const int pr = pi & 255, b = (pr & 7) >> 1, kvh = pr & 1, s = pr >> 3;
            nsa_prompt_unit(args, lds, b, kvh, (pi >= 256) ? s : 63 - s, tid, lane, wave); }
        if (!dfirst && (p3m & 4)) for (int u = bx; u < 512; u += G) { const int w = u & 255, grp = (w & 7) + 8 * (w >> 5), tt = 2 * ((w >> 3) & 3) + (u >> 8);
            nsa_decode_unit(args, lds, grp * 8 + tt, tid, lane, wave); }
    }
    SEAM(3); STAMP(4);
    if (IN(4)) {
        for (int u = bx; u < 512; u += G) ret_pass3_unit(args, lds, u, tid, lane, wave);
        for (int u = G - 1 - bx; u < 64; u += G) { DEpiOut E{ws, (const float*)args.in[I_XS]}; mini_gemm_unit<1024>(lds, (const bf16*)(ws + WS_YMIX) + (size_t)NP * 1024, 1024, (const bf16*)(ws + WS_WOUTT), u >> 5, u & 31, E, tid, lane, wave); }
    }
    SEAM(4); STAMP(5);
    if (IN(5)) {
        pg8::Gemm g{(const pg8::bf16_t*)(ws + WS_YMIX), (const pg8::bf16_t*)(ws + WS_WOUTT), NP, 1024, 1024}; pg8::StaticOrder S; S.init(NP, 1024, G, bx);
        EpiOut E{ws, (const float*)args.in[I_XP], (const float*)args.in[I_XS]};
        pg8::gemm_phase<EpiOut, pg8::StaticOrder, true, true>(lds, g, S, E);
        for (int u = G - 1 - bx; u < 64; u += G) { DEpiGate E2{ws, args.out, (const float*)args.in[I_NF]}; mini_gemm_unit<1024>(lds, (const bf16*)(ws + WS_X1B) + (size_t)NP * 1024, 1024, (const bf16*)(ws + WS_WGT), u >> 5, u & 31, E2, tid, lane, wave); }
    }
    SEAM(5); STAMP(6);
    if (IN(6)) {
        pg8::Gemm g{(const pg8::bf16_t*)(ws + WS_X1B), (const pg8::bf16_t*)(ws + WS_WGT), NP, 1024, 1024}; pg8::StaticOrder S; S.init(NP, 1024, G, bx);
        EpiGateNorm E{ws, args.out, (const float*)args.in[I_NF]};
        pg8::gemm_phase<EpiGateNorm, pg8::StaticOrder, true, true>(lds, g, S, E);
    }
    if (STAMP_A >= 0) { STAMP(8); if (bx == 0 && tid == 0) {
        const unsigned a0 = MISC[16 + 2 * STAMP_A], a1 = MISC[16 + 2 * (STAMP_A + 1)], b0 = MISC[16 + 2 * STAMP_B], b1 = MISC[16 + 2 * (STAMP_B + 1)];
        __builtin_amdgcn_s_waitcnt(0);
        args.out[O_Y] = 10.f * (float)(a1 - a0); args.out[O_Y + (size_t)NP * 1024] = 10.f * (float)(b1 - b0); } }
#undef IN
#undef SEAM
}

extern "C" void kernel_launch(void* const* d_in, const int* in_sizes, int n_in, void* d_out, int out_size, void* d_ws, size_t ws_size, hipStream_t stream) {
    static int grid = 0;
    if (grid == 0) {
        if (n_in != N_IN || out_size != (int)O_END || ws_size < WS_END) { fprintf(stderr, "kernel_launch: unexpected shapes (n_in %d, out %d, ws %zu); nothing launched\n", n_in, out_size, ws_size); grid = -1; return; }
        int dev = 0, cus = 0, per_cu = 0;
        if (hipGetDevice(&dev) != hipSuccess || hipDeviceGetAttribute(&cus, hipDeviceAttributeMultiprocessorCount, dev) != hipSuccess) { grid = -1; return; }
        if (hipFuncSetAttribute((const void*)mega_fwd, hipFuncAttributeMaxDynamicSharedMemorySize, LDS_BYTES) != hipSuccess) { fprintf(stderr, "kernel_launch: hipFuncSetAttribute failed\n"); grid = -1; return; }
        if (hipOccupancyMaxActiveBlocksPerMultiprocessor(&per_cu, (const void*)mega_fwd, 512, LDS_BYTES) != hipSuccess || per_cu < 1) { fprintf(stderr, "kernel_launch: occupancy query says %d blocks per CU\n", per_cu); }
        (void)hipGetLastError();
        grid = cus;
    }
    if (grid < 0) return;
    (void)hipMemsetAsync((char*)d_ws + WS_CTL, 0, CTL_ZERO_BYTES, stream);
    Args a{};
    for (int i = 0; i < N_IN; ++i) a.in[i] = d_in[i];
    a.out = (float*)d_out; a.ws = (unsigned char*)d_ws;
    a.rep = 0; a.pad = 0;
#if MK_SINGLE
    a.ph_lo = 0; a.ph_hi = N_PHASES;
    hipLaunchKernelGGL(mega_fwd, dim3(grid), dim3(512), LDS_BYTES, stream, a);
#else
    for (int p = 0; p < N_PHASES; ++p) { a.ph_lo = p; a.ph_hi = p + 1;
        for (int r = 0; r < ((p == REP_PHASE) ? 2 : 1); ++r) { a.rep = r; hipLaunchKernelGGL(mega_fwd, dim3(grid), dim3(512), LDS_BYTES, stream, a); } }
#endif
}
```

```cpp
#include <hip/hip_runtime.h>
#include <cstdio>
#include <cstdint>
namespace pg8 {
#define PG8_LAS __attribute__((address_space(3)))
typedef unsigned short bf16_t;
typedef short bf16x8 __attribute__((ext_vector_type(8)));
typedef float f32x4 __attribute__((ext_vector_type(4)));
typedef unsigned u32x4 __attribute__((ext_vector_type(4)));
constexpr int BM = 256, BK = 64, HALF = 128, HTB = HALF * BK * 2  , STAGE_BYTES = 8 * HTB, NXCD = 8, WGM = 8;

__host__ __device__ __forceinline__ int lds_byte(int r, int c) { const int st = (r >> 4) * 2 + (c >> 5), rr = r & 15, cc = c & 31, ob = rr * 64 + cc * 2; return st * 1024 + (ob ^ (((ob >> 9) & 1) << 5)); }
__host__ __device__ __forceinline__ void stage_rc(int b, int& R, int& C) { const int st = b / 1024, sb = b % 1024, swz = sb ^ (((sb >> 9) & 1) << 5); R = (st >> 1) * 16 + swz / 64; C = (st & 1) * 32 + (swz % 64) / 2; }
__host__ __device__ __forceinline__ int perm32(int rho) { const int n = rho >> 4, i = rho & 15; return 8 * (i >> 2) + 4 * n + (i & 3); }

struct Unit { int pm, pn; };
struct Gemm { const bf16_t* A; const bf16_t* Bt; int M, N, K; };

struct StaticOrder {
    int nM, nN, nwg, G, c;
    __host__ __device__ void init(int M, int N, int G_, int c_) { nM = M / BM; nN = N / BM; nwg = nM * nN; G = G_; c = c_; }
    __host__ __device__ bool next(int i, Unit& u) const {
        const long L = (long)i * G + c; if (L >= nwg) return false;
        int wgid = (int)L; { const int q = nwg / NXCD, r = nwg % NXCD, xcd = wgid % NXCD, off = wgid / NXCD; wgid = (xcd < r ? xcd * (q + 1) : r * (q + 1) + (xcd - r) * q) + off; }
        const int nig = WGM * nN, gid = wgid / nig, fm = gid * WGM, gsz = (nM - fm) < WGM ? (nM - fm) : WGM;
        u.pm = fm + ((wgid % nig) % gsz); u.pn = (wgid % nig) / gsz; return true;
    }
    __device__ __forceinline__ void a_ready(const Unit&) const {}
    __device__ __forceinline__ void done(const Unit&) const {}
};
template <class Epi, class Sched, bool ALIGN_EPI = false, bool SP2 = false>
__device__ __forceinline__ void gemm_phase(PG8_LAS unsigned char* lds, const Gemm g, const Sched& S, const Epi& E) {
    const int tid = threadIdx.x, wid = __builtin_amdgcn_readfirstlane(tid >> 6), lane = tid & 63, wr = wid >> 2, wc = wid & 3, fr = lane & 15, fq = lane >> 4;
    const int K = g.K, nt = K / BK;
    unsigned voffA[2], voffB[2];
#pragma unroll
    for (int i = 0; i < 2; ++i) { int R, C; stage_rc(tid * 16 + i * 8192, R, C); const int Rb = Epi::PERM ? ((R & ~31) + perm32(R & 31)) : R;
        voffA[i] = (unsigned)(R * K + C) * 2u; voffB[i] = (unsigned)(Rb * K + C) * 2u; }
    const size_t kstep = (size_t)(BK * 2);
    const size_t hstep = (size_t)HALF * K * 2;
    const size_t tstep = 2 * hstep;
    const unsigned ldsw = (unsigned)wid * 1024u;
    const int aoff = lds_byte(wr * 64 + fr, fq * 8), boff = lds_byte(wc * 32 + fr, fq * 8);
#define PG8_SA(b, h) (((b) * 2 + (h)) * HTB)
#define PG8_SB(b, h) ((4 + (b) * 2 + (h)) * HTB)
#define PG8_STAGE(bufoff, gbase, voff) do { _Pragma("unroll") for (int _i = 0; _i < 2; ++_i) \
        __builtin_amdgcn_global_load_lds((const unsigned*)((const char*)(gbase) + (voff)[_i]), (PG8_LAS unsigned*)(lds + (bufoff) + ldsw + _i * 8192), 16, 0, 0); } while (0)
#define PG8_LDA(dst, b, h) do { _Pragma("unroll") for (int m = 0; m < 4; ++m) _Pragma("unroll") for (int k = 0; k < 2; ++k) dst[m][k] = *(const PG8_LAS bf16x8*)(lds + PG8_SA(b, h) + aoff + m * 2048 + k * 1024); } while (0)
#define PG8_LDB(dst, b, h) do { _Pragma("unroll") for (int n = 0; n < 2; ++n) _Pragma("unroll") for (int k = 0; k < 2; ++k) dst[n][k] = *(const PG8_LAS bf16x8*)(lds + PG8_SB(b, h) + boff + n * 2048 + k * 1024); } while (0)
#define PG8_MMA(ai, bj, At, Bt) do { __builtin_amdgcn_s_setprio(1); _Pragma("unroll") for (int m = 0; m < 4; ++m) _Pragma("unroll") for (int n = 0; n < 2; ++n) _Pragma("unroll") for (int k = 0; k < 2; ++k) \
        acc[ai][bj][m][n] = __builtin_amdgcn_mfma_f32_16x16x32_bf16(Bt[n][k], At[m][k], acc[ai][bj][m][n], 0, 0, 0); __builtin_amdgcn_s_setprio(0); } while (0)
#define PG8_WAIT_V(n) asm volatile("s_waitcnt vmcnt(" #n ")" ::: "memory")
#define PG8_WAIT_L(n) asm volatile("s_waitcnt lgkmcnt(" #n ")" ::: "memory")
#define PG8_BAR __builtin_amdgcn_s_barrier()
#define PG8_SCHED __builtin_amdgcn_sched_barrier(0)
    Unit cur, nxt; int ui = 0;
    if (!S.next(0, cur)) return;
    f32x4 acc[2][2][4][2];
#pragma unroll
    for (int a = 0; a < 2; ++a)
#pragma unroll
        for (int b = 0; b < 2; ++b)
#pragma unroll
            for (int m = 0; m < 4; ++m)
#pragma unroll
                for (int n = 0; n < 2; ++n) acc[a][b][m][n] = (f32x4){0.f, 0.f, 0.f, 0.f};
    bf16x8 At[4][2], B0[2][2], B1[2][2];
    const char* cA = (const char*)g.A + (size_t)cur.pm * tstep; const char* cB = (const char*)g.Bt + (size_t)cur.pn * tstep;
    S.a_ready(cur);
    if constexpr (SP2) {
        PG8_STAGE(PG8_SB(0, 0), cB, voffB); PG8_STAGE(PG8_SB(0, 1), cB + hstep, voffB); PG8_STAGE(PG8_SA(0, 0), cA, voffA); PG8_STAGE(PG8_SA(0, 1), cA + hstep, voffA);
        if (wr == 1) PG8_BAR;
        PG8_WAIT_V(2); PG8_BAR;
        PG8_STAGE(PG8_SB(1, 0), cB + kstep, voffB); PG8_STAGE(PG8_SA(1, 0), cA + kstep, voffA); PG8_STAGE(PG8_SB(1, 1), cB + hstep + kstep, voffB);
        PG8_WAIT_V(6); PG8_BAR;
    } else {
        PG8_STAGE(PG8_SB(0, 0), cB, voffB); PG8_STAGE(PG8_SA(0, 0), cA, voffA); PG8_STAGE(PG8_SB(0, 1), cB + hstep, voffB); PG8_STAGE(PG8_SA(0, 1), cA + hstep, voffA);
        if (wr == 1) PG8_BAR;
        PG8_WAIT_V(4); PG8_BAR;
        PG8_STAGE(PG8_SB(1, 0), cB + kstep, voffB); PG8_STAGE(PG8_SA(1, 0), cA + kstep, voffA); PG8_STAGE(PG8_SB(1, 1), cB + hstep + kstep, voffB);
        PG8_WAIT_V(6); PG8_BAR;
    }
    for (;;) {
        const bool has_next = S.next(ui + 1, nxt);
        const char* nA = has_next ? (const char*)g.A + (size_t)nxt.pm * tstep : cA; const char* nB = has_next ? (const char*)g.Bt + (size_t)nxt.pn * tstep : cB;
        for (int t = 0; t < nt; t += 2) {
            const bool last = (t == nt - 2);
            const char* a1 = cA + (size_t)(t + 1) * kstep;
            const char* a2 = last ? nA : cA + (size_t)(t + 2) * kstep; const char* b2 = last ? nB : cB + (size_t)(t + 2) * kstep;
            const char* a3 = a2 + kstep; const char* b3 = b2 + kstep;
            if (last && has_next) S.a_ready(nxt);
            if constexpr (SP2) {
            PG8_LDB(B0, 0, 0); PG8_LDB(B1, 0, 1); PG8_SCHED; PG8_LDA(At, 0, 0); PG8_STAGE(PG8_SA(1, 1), a1 + hstep, voffA);
            PG8_WAIT_V(8); PG8_WAIT_L(0); PG8_BAR; PG8_MMA(0, 0, At, B0); PG8_MMA(0, 1, At, B1); PG8_BAR; PG8_SCHED;
            PG8_LDA(At, 0, 1); PG8_STAGE(PG8_SB(0, 0), b2, voffB); PG8_STAGE(PG8_SB(0, 1), b2 + hstep, voffB); PG8_STAGE(PG8_SA(0, 0), a2, voffA);
            PG8_WAIT_V(8); PG8_WAIT_L(0); PG8_BAR; PG8_MMA(1, 0, At, B0); PG8_MMA(1, 1, At, B1); PG8_BAR; PG8_SCHED;
            PG8_LDB(B0, 1, 0); PG8_LDB(B1, 1, 1); PG8_SCHED; PG8_LDA(At, 1, 0); PG8_STAGE(PG8_SA(0, 1), a2 + hstep, voffA);
            PG8_WAIT_V(8); PG8_WAIT_L(0); PG8_BAR; PG8_MMA(0, 0, At, B0); PG8_MMA(0, 1, At, B1); PG8_BAR; PG8_SCHED;
            PG8_LDA(At, 1, 1); PG8_STAGE(PG8_SB(1, 0), b3, voffB); PG8_STAGE(PG8_SB(1, 1), b3 + hstep, voffB); PG8_STAGE(PG8_SA(1, 0), a3, voffA);
            PG8_WAIT_V(8); PG8_WAIT_L(0); PG8_BAR; PG8_MMA(1, 0, At, B0); PG8_MMA(1, 1, At, B1); PG8_BAR; PG8_SCHED;
            } else {
            PG8_LDB(B0, 0, 0); PG8_SCHED; PG8_LDA(At, 0, 0); PG8_STAGE(PG8_SA(1, 1), a1 + hstep, voffA);
            PG8_WAIT_L(8); PG8_BAR; PG8_WAIT_L(0); PG8_MMA(0, 0, At, B0); PG8_BAR; PG8_SCHED;
            PG8_LDB(B1, 0, 1); PG8_STAGE(PG8_SB(0, 0), b2, voffB);
            PG8_BAR; PG8_WAIT_L(0); PG8_MMA(0, 1, At, B1); PG8_BAR;
            PG8_LDA(At, 0, 1); PG8_STAGE(PG8_SA(0, 0), a2, voffA);
            PG8_BAR; PG8_WAIT_L(0); PG8_MMA(1, 0, At, B0); PG8_BAR; PG8_SCHED;
            PG8_STAGE(PG8_SB(0, 1), b2 + hstep, voffB);
            PG8_WAIT_V(6); PG8_BAR; PG8_MMA(1, 1, At, B1); PG8_BAR;
            PG8_LDB(B0, 1, 0); PG8_SCHED; PG8_LDA(At, 1, 0); PG8_STAGE(PG8_SA(0, 1), a2 + hstep, voffA);
            PG8_WAIT_L(8); PG8_BAR; PG8_WAIT_L(0); PG8_MMA(0, 0, At, B0); PG8_BAR; PG8_SCHED;
            PG8_LDB(B1, 1, 1); PG8_STAGE(PG8_SB(1, 0), b3, voffB);
            PG8_BAR; PG8_WAIT_L(0); PG8_MMA(0, 1, At, B1); PG8_BAR;
            PG8_LDA(At, 1, 1); PG8_STAGE(PG8_SA(1, 0), a3, voffA);
            PG8_BAR; PG8_WAIT_L(0); PG8_MMA(1, 0, At, B0); PG8_BAR; PG8_SCHED;
            PG8_STAGE(PG8_SB(1, 1), b3 + hstep, voffB);
            PG8_WAIT_V(6); PG8_BAR; PG8_MMA(1, 1, At, B1); PG8_BAR;
            }
        }
        if constexpr (ALIGN_EPI) { if (wr == 0) PG8_BAR; }
        if constexpr (!Epi::AFTER_DRAIN) { E(acc, cur, wr, wc, fr, fq); S.done(cur); }
        if (!has_next) break;
#pragma unroll
        for (int a = 0; a < 2; ++a)
#pragma unroll
            for (int b = 0; b < 2; ++b)
#pragma unroll
                for (int m = 0; m < 4; ++m)
#pragma unroll
                    for (int n = 0; n < 2; ++n) acc[a][b][m][n] = (f32x4){0.f, 0.f, 0.f, 0.f};
        cur = nxt; cA = nA; cB = nB; ++ui;
        if constexpr (ALIGN_EPI) { if (wr == 1) PG8_BAR; }
    }
    PG8_WAIT_V(0);
    if constexpr (!ALIGN_EPI) { if (wr == 0) PG8_BAR; }
    PG8_BAR;
    if constexpr (Epi::AFTER_DRAIN) { E.fused(acc, cur, wr, wc, fr, fq, lds, wid, lane); S.done(cur); }
#undef PG8_SA
#undef PG8_SB
#undef PG8_STAGE
#undef PG8_LDA
#undef PG8_LDB
#undef PG8_MMA
#undef PG8_WAIT_V
#undef PG8_WAIT_L
#undef PG8_BAR
#undef PG8_SCHED
}
}

#define GAS __attribute__((address_space(1)))
#define LAS __attribute__((address_space(3)))
typedef unsigned short bf16;
typedef short bf16x8 __attribute__((ext_vector_type(8)));
typedef short s16x4 __attribute__((ext_vector_type(4)));
typedef float f32x2 __attribute__((ext_vector_type(2)));
typedef float f32x4 __attribute__((ext_vector_type(4)));
typedef float f32x16 __attribute__((ext_vector_type(16)));
typedef unsigned u32x2 __attribute__((ext_vector_type(2)));
typedef unsigned u32x4 __attribute__((ext_vector_type(4)));
typedef __bf16 bf16x2_t __attribute__((ext_vector_type(2)));

constexpr int NP = 16384, ND = 256, NTOK = NP + ND;
constexpr int SEQ = 4096, NBATCH = 4, DBATCH = 32, DSEQ = 8, PAST = 16384;
constexpr int DM = 1024, NPR = 3840, PROJW = 3864;
constexpr int NPOS = SEQ + DSEQ;
constexpr float C2 = 0.125f * 1.4426950408889634f;
constexpr float RMS_EPS = 1e-6f, GN_EPS = 1e-5f;
constexpr float NEGBIG = -1e30f, MINIT = -1e4f;

constexpr size_t O_Y = 0;
constexpr size_t O_RETP = (size_t)NTOK * 1024;
constexpr size_t O_CMPK_P = O_RETP + 4 * 4 * 128 * 128;
constexpr size_t O_CMPV_P = O_CMPK_P + (size_t)NP * 128;
constexpr size_t O_SLCK_P = O_CMPV_P + (size_t)NP * 128;
constexpr size_t O_SLCV_P = O_SLCK_P + (size_t)NP * 128;
constexpr size_t O_WINK_P = O_SLCV_P + (size_t)NP * 128;
constexpr size_t O_WINV_P = O_WINK_P + 4 * 512 * 128;
constexpr size_t O_RETS = O_WINV_P + 4 * 512 * 128;
constexpr size_t O_CMPK_S = O_RETS + (size_t)32 * 4 * 128 * 128;
constexpr size_t O_CMPV_S = O_CMPK_S + ND * 128;
constexpr size_t O_SLCK_S = O_CMPV_S + ND * 128;
constexpr size_t O_SLCV_S = O_SLCK_S + ND * 128;
constexpr size_t O_WINK_S = O_SLCV_S + ND * 128;
constexpr size_t O_WINV_S = O_WINK_S + (size_t)32 * 512 * 128;
constexpr size_t O_END = O_WINV_S + (size_t)32 * 512 * 128;
static_assert(O_END == 32636928, "output size");

enum { I_XP = 0, I_XS, I_CCK, I_CCV, I_CSK, I_CSV, I_SWK, I_SWV, I_SRET, I_PT, I_PP, I_PS, I_NMIX, I_WIN, I_GNG, I_GNB, I_PEK, I_W1K, I_W2K, I_PEV, I_W1V, I_W2V, I_WOUT, I_NPLE, I_WG, I_WPLE, I_NF, N_IN };

constexpr size_t MiB = 1u << 20;
constexpr size_t WS_CTL = 0, CTL_ZERO_BYTES = 1 * MiB;
constexpr size_t WS_COSR = 1 * MiB;
constexpr size_t WS_SINR = WS_COSR + (size_t)NPOS * 64 * 4;
constexpr size_t WS_COSN = WS_SINR + (size_t)NPOS * 64 * 4;
constexpr size_t WS_SINN = WS_COSN + (size_t)NPOS * 32 * 4;
constexpr size_t WS_CBIAS = 5 * MiB;
constexpr size_t WS_W2T = WS_CBIAS + 65536;
constexpr size_t WS_W1T = 6 * MiB;
constexpr size_t WS_WINT = 8 * MiB;
constexpr size_t WS_WNGLT = 16 * MiB;
constexpr size_t WS_WOUTT = 17 * MiB;
constexpr size_t WS_WGT = 19 * MiB;
constexpr size_t WS_WPLET = 21 * MiB;
constexpr size_t WS_H = 24 * MiB;
constexpr size_t WS_PB = 57 * MiB;
constexpr size_t WS_QR = 66 * MiB, WS_KR = 83 * MiB, WS_VR = 100 * MiB, WS_RG = 117 * MiB, WS_QN = 134 * MiB, WS_QROT = 151 * MiB, WS_NG = 168 * MiB;
constexpr size_t WS_KS = 185 * MiB, WS_VS = 190 * MiB, WS_KW = 195 * MiB, WS_VW = 200 * MiB;
constexpr size_t WS_GL = 205 * MiB;
constexpr size_t WS_KCP = 208 * MiB, WS_VCP = WS_KCP + 131072;
constexpr size_t WS_KCS = 209 * MiB, WS_VCS = 217 * MiB;
constexpr size_t WS_KVT = 225 * MiB;
constexpr size_t WS_ST = 257 * MiB;
constexpr size_t WS_YMIX = 273 * MiB;
constexpr size_t WS_X1 = 306 * MiB;
constexpr size_t WS_X1B = 371 * MiB;
constexpr size_t WS_PPO = 404 * MiB;
constexpr size_t WS_SS1 = 469 * MiB;
constexpr size_t WS_SS2 = 471 * MiB;
constexpr size_t WS_SS1D = 473 * MiB, WS_SS2D = WS_SS1D + 65536;
constexpr size_t WS_END = 474 * MiB;
constexpr int CW_BAR = 4096;

constexpr int LDS_BYTES = 147456;
constexpr int MISC_OFF = LDS_BYTES - 256;

#define CM(col, row) (((size_t)((col) >> 3) * NTOK + (size_t)(row)) * 8 + ((col) & 7))
struct Args { const void* in[N_IN]; float* out; unsigned char* ws; int ph_lo, ph_hi, rep, pad; };

__device__ __forceinline__ unsigned f2bf(float f) { unsigned u = __builtin_bit_cast(unsigned, f); return (u + 0x7fffu + ((u >> 16) & 1u)) >> 16; }
__device__ __forceinline__ unsigned pk2(float lo, float hi) { f32x2 v = {lo, hi}; bf16x2_t b = __builtin_convertvector(v, bf16x2_t); return __builtin_bit_cast(unsigned, b); }
__device__ __forceinline__ float bflo(unsigned u) { return __builtin_bit_cast(float, u << 16); }
__device__ __forceinline__ float bfhi(unsigned u) { return __builtin_bit_cast(float, u & 0xffff0000u); }
__device__ __forceinline__ float bf2f(bf16 h) { return __builtin_bit_cast(float, (unsigned)h << 16); }
__device__ __forceinline__ u32x4 pack8(const float* v) { u32x4 w; w.x = pk2(v[0], v[1]); w.y = pk2(v[2], v[3]); w.z = pk2(v[4], v[5]); w.w = pk2(v[6], v[7]); return w; }
__device__ __forceinline__ float wave_sum(float v) {
#pragma unroll
    for (int o = 1; o < 64; o <<= 1) v += __shfl_xor(v, o);
    return v;
}
__device__ __forceinline__ float wave_max(float v) {
#pragma unroll
    for (int o = 1; o < 64; o <<= 1) v = fmaxf(v, __shfl_xor(v, o));
    return v;
}
__device__ __forceinline__ void swap32(float& a, float& b) { asm volatile("s_nop 1\n\tv_permlane32_swap_b32 %0, %1\n\ts_nop 1" : "+v"(a), "+v"(b)); }
__device__ __forceinline__ float xor32_sum(float x) { float a = x, b = x; swap32(a, b); return a + b; }
__device__ __forceinline__ float xor32_max(float x) { float a = x, b = x; swap32(a, b); return fmaxf(a, b); }
__device__ __forceinline__ float sigmoidf_(float x) { return __builtin_amdgcn_rcpf(1.f + __builtin_amdgcn_exp2f(-1.4426950408889634f * x)); }
__device__ __forceinline__ float siluf_(float x) { return x * __builtin_amdgcn_rcpf(1.f + __builtin_amdgcn_exp2f(-1.4426950408889634f * x)); }
__device__ __forceinline__ float gelu_tanh(float x) { const float u = 0.7978845608028654f * (x + 0.044715f * x * x * x); const float e = __expf(2.f * u); const float t = 1.f - 2.f / (e + 1.f); return 0.5f * x * (1.f + t); }
__device__ __forceinline__ int crow(int r, int hi) { return (r & 3) + 8 * (r >> 2) + 4 * hi; }
#define LDS_WAIT() asm volatile("s_waitcnt lgkmcnt(0)" ::: "memory")
#define MFMA32(a, b, c) __builtin_amdgcn_mfma_f32_32x32x16_bf16((a), (b), (c), 0, 0, 0)
typedef short v4i16_t __attribute__((ext_vector_type(4)));
__device__ __forceinline__ s16x4 ds_tr(LAS const unsigned char* p) { return __builtin_bit_cast(s16x4, __builtin_amdgcn_ds_read_tr16_b64_v4i16((LAS v4i16_t*)p)); }
__device__ __forceinline__ bf16x8 cat8(s16x4 a, s16x4 b) { return (bf16x8){a[0], a[1], a[2], a[3], b[0], b[1], b[2], b[3]}; }
__device__ __forceinline__ bf16x8 pack_frag(const f32x16& p, int base) {
    u32x4 w; w.x = pk2(p[base + 0], p[base + 1]); w.y = pk2(p[base + 2], p[base + 3]); w.z = pk2(p[base + 4], p[base + 5]); w.w = pk2(p[base + 6], p[base + 7]);
    return __builtin_bit_cast(bf16x8, w);
}
__device__ __forceinline__ float log2g(int h) { return h == 0 ? -0.04580368961312479f : h == 1 ? -0.02272007650008353f : h == 2 ? -0.011315313227834146f : -0.005646563141142063f; }

__device__ __forceinline__ void sincos_d(double a, double& s, double& c) {
    const double q = __builtin_rint(a * 0.63661977236758134308);
    double y = __builtin_fma(-q, 1.57079632679489655800e+00, a); y = __builtin_fma(-q, 6.12323399573676603587e-17, y);
    const int quad = ((int)q) & 3; const double y2 = y * y;
    double sp = -1.0 / 1307674368000.0; sp = sp * y2 + 1.0 / 6227020800.0; sp = sp * y2 - 1.0 / 39916800.0; sp = sp * y2 + 1.0 / 362880.0; sp = sp * y2 - 1.0 / 5040.0; sp = sp * y2 + 1.0 / 120.0; sp = sp * y2 - 1.0 / 6.0; sp = sp * y2 + 1.0; sp *= y;
    double cp = 1.0 / 20922789888000.0; cp = cp * y2 - 1.0 / 87178291200.0; cp = cp * y2 + 1.0 / 479001600.0; cp = cp * y2 - 1.0 / 3628800.0; cp = cp * y2 + 1.0 / 40320.0; cp = cp * y2 - 1.0 / 720.0; cp = cp * y2 + 1.0 / 24.0; cp = cp * y2 - 0.5; cp = cp * y2 + 1.0;
    s = (quad == 0) ? sp : (quad == 1) ? cp : (quad == 2) ? -sp : -cp;
    c = (quad == 0) ? cp : (quad == 1) ? -sp : (quad == 2) ? -cp : sp;
}
__device__ __forceinline__ double ipow_d(double r, int n) { double acc = 1.0;
#pragma unroll
    for (int b = 0; b < 6; ++b) { if (n & (1 << b)) acc *= r; r *= r; } return acc; }

__device__ __forceinline__ int orig_base32(int g32) {
    const int tile = g32 >> 3, gi = g32 & 7, bj = gi >> 2, wq = gi & 3;
    if (tile < 2)  return (2 * tile + (wq >> 1)) * 128 + (wq & 1) * 32 + 64 * bj;
    if (tile < 4)  return 512 + (2 * (tile - 2) + (wq >> 1)) * 128 + (wq & 1) * 32 + 64 * bj;
    if (tile < 6)  return 1024 + (tile - 4) * 256 + gi * 32;
    if (tile < 8)  return 1536 + (tile - 6) * 256 + gi * 32;
    if (tile < 10) return 2048 + (4 * (tile - 8) + wq) * 64 + 32 * bj;
    if (tile == 10) return 2560 + gi * 32;
    if (tile == 11) return ((wq >> 1) ? 3072 : 2816) + (wq & 1) * 64 + 32 * bj;
    if (tile == 12) return (bj ? 3200 : 2944) + wq * 32;
    return 3352 + (tile - 13) * 256 + gi * 32;
}
#define XB_TMO      128
#define XB_XCNT(j)  (256  + 64 * (j))
#define XB_XSUB(j)  (1280 + 64 * (j))
#define XB_XGEN(j)  (2304 + 64 * (j))
#define XB_TOP      3328
#define XB_TOPGEN   3392
#define XCD_BAR_WORDS 3456
#define XB_SPIN_CAP (1u << 18)
#define LAS __attribute__((address_space(3)))

__device__ __forceinline__ unsigned xb_ld(unsigned* p)              { return __hip_atomic_load(p, __ATOMIC_RELAXED, __HIP_MEMORY_SCOPE_AGENT); }
__device__ __forceinline__ unsigned xb_add(unsigned* p, unsigned v) { return __hip_atomic_fetch_add(p, v, __ATOMIC_RELAXED, __HIP_MEMORY_SCOPE_AGENT); }
__device__ __forceinline__ unsigned xb_xcc_id() { return (unsigned)__builtin_amdgcn_s_getreg((3 << 11) | 20) & 0xFu; }
#define XB_SPIN(cond, bar) do { unsigned _sp = 0; while (cond) { __builtin_amdgcn_s_sleep(1); \
    if ((++_sp & 255u) == 0u) { if (xb_ld(&(bar)[XB_TMO])) break; if (_sp > XB_SPIN_CAP) { atomicAdd(&(bar)[XB_TMO], 1u); break; } } } } while (0)

struct XcdBarrier {
    unsigned* bar; unsigned x;
    volatile LAS unsigned* st;
};

__device__ __forceinline__ XcdBarrier xcd_barrier_post(unsigned* bar, volatile LAS unsigned* st) {
    XcdBarrier b; b.bar = bar; b.x = xb_xcc_id(); b.st = st;
    if (threadIdx.x == 0) (void)xb_add(&bar[XB_XCNT(b.x)], 1u);
    return b;
}
__device__ __forceinline__ void xcd_barrier_complete(unsigned* bar, unsigned x, unsigned& nloc, unsigned& nx) {
    const unsigned G = gridDim.x * gridDim.y * gridDim.z;
    unsigned sum, cnt, mine, sp = 0u;
    for (;;) {
        sum = 0u; cnt = 0u; mine = 0u;
#pragma unroll
        for (unsigned j = 0; j < 16; ++j) { const unsigned c = xb_ld(&bar[XB_XCNT(j)]); sum += c; cnt += (c > 0u) ? 1u : 0u; mine = (j == x) ? c : mine; }
        if (sum == G) break;
        __builtin_amdgcn_s_sleep(1);
        if ((++sp & 255u) == 0u) { if (xb_ld(&bar[XB_TMO])) break; if (sp > XB_SPIN_CAP) { atomicAdd(&bar[XB_TMO], 1u); break; } }
    }
    nloc = mine > 0u ? mine : 1u; nx = cnt > 0u ? cnt : 1u;
}

__device__ __forceinline__ void xcd_barrier(const XcdBarrier& b) {
    asm volatile("s_waitcnt vmcnt(0)" ::: "memory");
    __syncthreads();
    if (threadIdx.x == 0) {
        unsigned* bar = b.bar;
        __builtin_amdgcn_s_waitcnt(0);
        unsigned nloc = b.st[0], nx = b.st[1];
        if (nloc == 0u) { xcd_barrier_complete(bar, b.x, nloc, nx); b.st[0] = nloc; b.st[1] = nx; }
        const unsigned old = xb_add(&bar[XB_XSUB(b.x)], 1u);
        const unsigned gen = old / nloc;
        if (old + 1u == (gen + 1u) * nloc) {
            __builtin_amdgcn_fence(__ATOMIC_RELEASE, "agent");
            asm volatile("s_waitcnt vmcnt(0)" ::: "memory");
            const unsigned og = xb_add(&bar[XB_TOP], 1u);
            const unsigned tg = og / nx;
            if (og + 1u == (tg + 1u) * nx) xb_add(&bar[XB_TOPGEN], 1u);
            else XB_SPIN(xb_ld(&bar[XB_TOPGEN]) == tg, bar);
            __builtin_amdgcn_fence(__ATOMIC_ACQUIRE, "agent");
            xb_add(&bar[XB_XGEN(b.x)], 1u);
            asm volatile("s_waitcnt vmcnt(0)" ::: "memory");
        } else {
            XB_SPIN(xb_ld(&bar[XB_XGEN(b.x)]) == gen, bar);
            __builtin_amdgcn_fence(__ATOMIC_ACQUIRE, "agent");
            asm volatile("s_waitcnt vmcnt(0)" ::: "memory");
        }
    }
    __syncthreads();
}

template <bool FRAG = false>
__device__ __forceinline__ void transpose_item(const float* W, int ldw, int k0, int n0, int nvalid, const float* kscale, bf16* WT, int ldt, int drow0, LAS float* scr, int lane) {
    float tv[32];
#pragma unroll
    for (int i = 0; i < 32; ++i) { const int kk = 2 * i + (lane >> 5), c = lane & 31; tv[i] = W[(size_t)(k0 + kk) * ldw + n0 + ((c < nvalid) ? c : 0)]; }
#pragma unroll
    for (int i = 0; i < 32; ++i) { const int kk = 2 * i + (lane >> 5), c = lane & 31; float v = (c < nvalid) ? tv[i] : 0.f; if (kscale) v *= kscale[k0 + kk]; scr[kk * 33 + c] = v; }
    LDS_WAIT(); asm volatile("" ::: "memory");
    const int c8 = lane & 7;
#pragma unroll
    for (int j = 0; j < 4; ++j) { const int n = (lane >> 3) + 8 * j; const LAS float* s = scr + (8 * c8) * 33 + n;
        u32x4 o; o.x = pk2(s[0 * 33], s[1 * 33]); o.y = pk2(s[2 * 33], s[3 * 33]); o.z = pk2(s[4 * 33], s[5 * 33]); o.w = pk2(s[6 * 33], s[7 * 33]);
        if (FRAG) { const int e = drow0 + n, k8 = (k0 >> 3) + c8;
            *(u32x4*)(WT + (size_t)((((k8 >> 4) * 2 + (e >> 5)) * 8 + ((k8 >> 1) & 7)) * 64 + (e & 31) + 32 * (k8 & 1)) * 8) = o; }
        else *(u32x4*)(WT + (size_t)(drow0 + n) * ldt + k0 + 8 * c8) = o; }
    LDS_WAIT(); asm volatile("" ::: "memory");
}

__device__ __forceinline__ void phase0(const Args& A, LAS unsigned char* lds, int tid, int lane, int wave) {
    unsigned char* ws = A.ws;
    const int gw = blockIdx.x * 8 + wave, NGW = gridDim.x * 8;
    const int gt = blockIdx.x * 512 + tid, NGT = gridDim.x * 512;
    LAS float* scr = (LAS float*)(lds + wave * 16384);
    constexpr int I_IN = 16 * 120, I_NGL = 16, I_OUT = 16 * 32, I_G = 16 * 32, I_PLE = 4 * 32, I_W1 = 4 * 64, I_W2 = 4 * 2;
    constexpr int NITEMS = I_IN + I_NGL + I_OUT + I_G + I_PLE + I_W1 + I_W2;
    for (int it = gw; it < NITEMS; it += NGW) {
        int r = it;
        if (r < I_IN) { const int kb = r / 120, g32 = r % 120; transpose_item((const float*)A.in[I_WIN], PROJW, 64 * kb, orig_base32(g32), 32, nullptr, (bf16*)(ws + WS_WINT), 1024, 32 * g32, scr, lane); continue; } r -= I_IN;
        if (r < I_NGL) { transpose_item((const float*)A.in[I_WIN], PROJW, 64 * r, 3328, 24, nullptr, (bf16*)(ws + WS_WNGLT), 1024, 0, scr, lane); continue; } r -= I_NGL;
        if (r < I_OUT + I_G) continue;
        r -= I_OUT + I_G;
        if (r < I_PLE) { const int kb = r / 32, nb = r % 32; transpose_item((const float*)A.in[I_WPLE], 1024, 64 * kb, 32 * nb, 32, nullptr, (bf16*)(ws + WS_WPLET), 256, 32 * nb, scr, lane); continue; } r -= I_PLE;
        if (r < I_W1) { const int m = r >> 6, q = r & 63, kb = q >> 1, nb = q & 1;
            const float* W = (const float*)A.in[(m >> 1) ? I_W1V : I_W1K] + (size_t)(m & 1) * 2048 * 64;
            transpose_item<true>(W, 64, 64 * kb, 32 * nb, 32, nullptr, (bf16*)(ws + WS_W1T) + (size_t)m * 64 * 2048, 2048, 32 * nb, scr, lane); continue; } r -= I_W1;
        { const int m = r >> 1, nb = r & 1;
            const float* W = (const float*)A.in[(m >> 1) ? I_W2V : I_W2K] + (size_t)(m & 1) * 64 * 64;
            transpose_item(W, 64, 0, 32 * nb, 32, nullptr, (bf16*)(ws + WS_W2T) + (size_t)m * 64 * 64, 64, 32 * nb, scr, lane); }
    }
    {
        const f32x4* gm = (const f32x4*)A.in[I_NMIX];
        f32x4 g[4];
#pragma unroll
        for (int j = 0; j < 4; ++j) g[j] = gm[64 * j + lane];
        for (int m0 = gw; m0 < NTOK; m0 += 4 * NGW) {
            f32x4 v[4][4];
#pragma unroll
            for (int r = 0; r < 4; ++r) { const int mm = m0 + r * NGW, m = (mm < NTOK) ? mm : m0;
                const float* xrow = (m < NP) ? (const float*)A.in[I_XP] + (size_t)m * DM : (const float*)A.in[I_XS] + (size_t)(m - NP) * DM;
                const f32x4* xr = (const f32x4*)xrow + lane;
#pragma unroll
                for (int j = 0; j < 4; ++j) v[r][j] = xr[64 * j]; }
#pragma unroll
            for (int r = 0; r < 4; ++r) { const int m = m0 + r * NGW;
                float s = 0.f;
#pragma unroll
                for (int j = 0; j < 4; ++j) s += (v[r][j].x * v[r][j].x + v[r][j].y * v[r][j].y) + (v[r][j].z * v[r][j].z + v[r][j].w * v[r][j].w);
                const float rstd = 1.f / sqrtf(wave_sum(s) * (1.f / DM) + RMS_EPS);
                if (m < NTOK) {
                    u32x2* o8 = (u32x2*)((bf16*)(ws + WS_H) + (size_t)m * DM) + lane;
#pragma unroll
                    for (int j = 0; j < 4; ++j) { u32x2 o; o.x = pk2(v[r][j].x * rstd * g[j].x, v[r][j].y * rstd * g[j].y); o.y = pk2(v[r][j].z * rstd * g[j].z, v[r][j].w * rstd * g[j].w); o8[64 * j] = o; }
                } }
        }
    }
    for (int i0 = gt; i0 < NTOK * 64; i0 += 8 * NGT) {
        f32x4 v[8];
#pragma unroll
        for (int u = 0; u < 8; ++u) { const int ii = i0 + u * NGT, i = (ii < NTOK * 64) ? ii : i0; const int row = i >> 6, c4 = i & 63;
            v[u] = (row < NP) ? ((const f32x4*)A.in[I_PP])[(size_t)row * 64 + c4] : ((const f32x4*)A.in[I_PS])[(size_t)(row - NP) * 64 + c4]; }
#pragma unroll
        for (int u = 0; u < 8; ++u) { const int i = i0 + u * NGT;
            if (i < NTOK * 64) { u32x2 o; o.x = pk2(v[u].x, v[u].y); o.y = pk2(v[u].z, v[u].w); ((u32x2*)(ws + WS_PB))[i] = o; } }
    }
    for (int i = gt; i < NPOS * 96; i += NGT) {
        const int pi = i / 96, k = i % 96;
        const double pos = (pi < SEQ) ? (double)pi : (double)(PAST + pi - SEQ);
        double s, c;
        if (k < 64) { sincos_d(pos * ipow_d(0.86596432336006535235, k), s, c); ((float*)(ws + WS_COSR))[pi * 64 + k] = (float)c; ((float*)(ws + WS_SINR))[pi * 64 + k] = (float)s; }
        else { const int kk = k - 64; sincos_d(pos * ipow_d(0.74989420933245582730, kk), s, c); ((float*)(ws + WS_COSN))[pi * 32 + kk] = (float)c; ((float*)(ws + WS_SINN))[pi * 32 + kk] = (float)s; }
    }
    for (int it = blockIdx.x; it < 4 * 32; it += gridDim.x) {
        const int m = it >> 5, part = it & 31, kv = m >> 1, kvh = m & 1;
        const float* pe = (const float*)A.in[kv ? I_PEV : I_PEK];
        const float* w1 = (const float*)A.in[kv ? I_W1V : I_W1K] + (size_t)kvh * 2048 * 64;
        float pv[8], wv8[8];
#pragma unroll
        for (int q = 0; q < 8; ++q) { const int jd = part * 64 + 8 * wave + q, j = jd >> 6, d = jd & 63; pv[q] = pe[(j * 2 + kvh) * 64 + d]; wv8[q] = w1[(size_t)jd * 64 + lane]; }
        float acc = 0.f;
#pragma unroll
        for (int q = 0; q < 8; ++q) acc += pv[q] * wv8[q];
        LAS float* cb = (LAS float*)lds;
        __syncthreads();
        cb[wave * 64 + lane] = acc;
        __syncthreads();
        if (wave == 0) { float t = 0.f;
#pragma unroll
            for (int w = 0; w < 8; ++w) t += cb[w * 64 + lane];
            ((float*)(ws + WS_CBIAS))[(m * 32 + part) * 64 + lane] = t; }
    }
}

__device__ __forceinline__ void late_transposes(const Args& A, LAS unsigned char* lds, int gw, int NGW, int lane, int wave) {
    unsigned char* ws = A.ws;
    LAS float* scr = (LAS float*)(lds + wave * 16384);
    __syncthreads();
    for (int it = gw; it < 2 * 16 * 32; it += NGW) {
        const int r = it & 511, kb = r / 32, nb = r % 32;
        if (it < 512) transpose_item((const float*)A.in[I_WOUT], 1024, 64 * kb, 32 * nb, 32, nullptr, (bf16*)(ws + WS_WOUTT), 1024, 32 * nb, scr, lane);
        else transpose_item((const float*)A.in[I_WG], 1024, 64 * kb, 32 * nb, 32, (const float*)A.in[I_NPLE], (bf16*)(ws + WS_WGT), 1024, 32 * nb, scr, lane);
    }
}

__device__ __forceinline__ void win_shift(const Args& A, int gt, int NGT) {
    for (int i0 = gt; i0 < 2 * 32 * 504 * 32; i0 += 8 * NGT) {
        f32x4 v[8];
#pragma unroll
        for (int u = 0; u < 8; ++u) { const int ii = i0 + u * NGT, i = (ii < 2 * 32 * 504 * 32) ? ii : i0;
            const int kv = i / (32 * 504 * 32), r = i % (32 * 504 * 32), b = r / (504 * 32), q = r % (504 * 32);
            v[u] = ((const f32x4*)A.in[kv ? I_SWV : I_SWK])[(size_t)b * 512 * 32 + 8 * 32 + q]; }
#pragma unroll
        for (int u = 0; u < 8; ++u) { const int i = i0 + u * NGT;
            if (i < 2 * 32 * 504 * 32) { const int kv = i / (32 * 504 * 32), r = i % (32 * 504 * 32), b = r / (504 * 32), q = r % (504 * 32);
                ((f32x4*)(A.out + (kv ? O_WINV_S : O_WINK_S)))[(size_t)b * 512 * 32 + q] = v[u]; } }
    }
}

struct EpiInProj {
    static constexpr bool PERM = true, AFTER_DRAIN = false;
    unsigned char* ws; float* out;
    __device__ __forceinline__ void operator()(const pg8::f32x4 (&acc)[2][2][4][2], const pg8::Unit& u, int wr, int wc, int fr, int fq) const {
        const int pn = u.pn;
        asm volatile("" : "+v"(fr), "+v"(fq));
        const int lc = wc * 32 + 8 * fq;
        const bool rope = pn < 4 || pn == 8 || pn == 9 || pn == 11;
        f32x4 tb[2][4];
        auto ldtab = [&](int ai_, int m_, f32x4 (&t)[4]) {
            const int row_ = u.pm * 256 + ai_ * 128 + wr * 64 + m_ * 16 + fr;
            const int pidx_ = (row_ >= NP) ? (SEQ + ((row_ - NP) & 7)) : (row_ & (SEQ - 1));
            const bool big = pn < 4; const int nd = big ? 64 : 32, dl = big ? ((wc & 1) * 32 + 8 * fq) : 8 * fq;
            const float* ct = (const float*)(ws + (big ? WS_COSR : WS_COSN)) + pidx_ * nd + dl; const float* st = (const float*)(ws + (big ? WS_SINR : WS_SINN)) + pidx_ * nd + dl;
            t[0] = *(const f32x4*)ct; t[1] = *(const f32x4*)(ct + 4); t[2] = *(const f32x4*)st; t[3] = *(const f32x4*)(st + 4); };
        if (rope) ldtab(0, 0, tb[0]);
#pragma unroll
        for (int ai = 0; ai < 2; ++ai)
#pragma unroll
            for (int m = 0; m < 4; ++m) {
                const int row = u.pm * 256 + ai * 128 + wr * 64 + m * 16 + fr;
                const bool dec = row >= NP;
                const int pidx = dec ? (SEQ + ((row - NP) & 7)) : (row & (SEQ - 1));
                float cc[8], ss[8];
                if (rope) {
                    const int idx = ai * 4 + m;
                    if (idx + 1 < 8) ldtab((idx + 1) >> 2, (idx + 1) & 3, tb[(idx + 1) & 1]);
#pragma unroll
                    for (int e = 0; e < 8; ++e) { cc[e] = e < 4 ? tb[idx & 1][0][e & 3] : tb[idx & 1][1][e & 3]; ss[e] = e < 4 ? tb[idx & 1][2][e & 3] : tb[idx & 1][3][e & 3]; }
                }
                float v0[8], v1[8];
#pragma unroll
                for (int e = 0; e < 4; ++e) { v0[e] = acc[ai][0][m][0][e]; v0[4 + e] = acc[ai][0][m][1][e]; v1[e] = acc[ai][1][m][0][e]; v1[4 + e] = acc[ai][1][m][1][e]; }
                if (pn < 4) {
                    const int t2 = pn & 1, head = 2 * t2 + (wc >> 1), dlo = (wc & 1) * 32 + 8 * fq;
                    const float sc = (pn >= 2) ? 0.08838834764831845f : 1.f;
                    float o0[8], o1[8];
#pragma unroll
                    for (int e = 0; e < 8; ++e) { const float c = cc[e], s = ss[e]; o0[e] = (v0[e] * c - v1[e] * s) * sc; o1[e] = (v1[e] * c + v0[e] * s) * sc; }
                    bf16* dst = (bf16*)(ws + (pn >= 2 ? WS_KR : WS_QR));
                    *(u32x4*)(dst + CM(head * 128 + dlo, row)) = pack8(o0); *(u32x4*)(dst + CM(head * 128 + 64 + dlo, row)) = pack8(o1);
                } else if (pn < 8) {
                    const int cb = ((pn - 4) & 1) * 256 + lc;
                    if (pn >= 6) {
#pragma unroll
                        for (int e = 0; e < 8; ++e) { v0[e] = siluf_(v0[e]); v1[e] = siluf_(v1[e]); } }
                    bf16* dst = (bf16*)(ws + (pn >= 6 ? WS_RG : WS_VR));
                    *(u32x4*)(dst + CM(cb, row)) = pack8(v0); *(u32x4*)(dst + CM(cb + 128, row)) = pack8(v1);
                } else if (pn < 10) {
                    const int head = 4 * (pn - 8) + wc, dlo = 8 * fq;
                    float o0[8], o1[8], r0[8], r1[8];
#pragma unroll
                    for (int e = 0; e < 8; ++e) { const float c = cc[e], s = ss[e]; o0[e] = (v0[e] * c - v1[e] * s) * C2; o1[e] = (v1[e] * c + v0[e] * s) * C2; r0[e] = v0[e] * C2; r1[e] = v1[e] * C2; }
                    bf16* dq = (bf16*)(ws + WS_QN); bf16* dr = (bf16*)(ws + WS_QROT); const size_t c0_ = CM(head * 64 + dlo, row), c1_ = CM(head * 64 + 32 + dlo, row);
                    *(u32x4*)(dq + c0_) = pack8(r0); *(u32x4*)(dq + c1_) = pack8(r1); *(u32x4*)(dr + c0_) = pack8(o0); *(u32x4*)(dr + c1_) = pack8(o1);
                } else if (pn == 10) {
                    float* dk = out + (dec ? O_CMPK_S + (size_t)(row - NP) * 128 : O_CMPK_P + (size_t)row * 128) + lc;
                    float* dv = out + (dec ? O_CMPV_S + (size_t)(row - NP) * 128 : O_CMPV_P + (size_t)row * 128) + lc;
                    *(f32x4*)dk = (f32x4){v0[0], v0[1], v0[2], v0[3]}; *(f32x4*)(dk + 4) = (f32x4){v0[4], v0[5], v0[6], v0[7]};
                    *(f32x4*)dv = (f32x4){v1[0], v1[1], v1[2], v1[3]}; *(f32x4*)(dv + 4) = (f32x4){v1[4], v1[5], v1[6], v1[7]};
                } else if (pn == 11) {
                    const int which = wc >> 1, kvh = wc & 1, dlo = 8 * fq, col = kvh * 64 + dlo;
                    float o0[8], o1[8];
#pragma unroll
                    for (int e = 0; e < 8; ++e) { const float c = cc[e], s = ss[e]; o0[e] = v0[e] * c - v1[e] * s; o1[e] = v1[e] * c + v0[e] * s; }
                    bf16* db = (bf16*)(ws + (which ? WS_KW : WS_KS));
                    *(u32x4*)(db + CM(col, row)) = pack8(o0); *(u32x4*)(db + CM(col + 32, row)) = pack8(o1);
                    float* df = nullptr;
                    if (which == 0) df = out + (dec ? O_SLCK_S + (size_t)(row - NP) * 128 : O_SLCK_P + (size_t)row * 128) + col;
                    else if (dec) { const int b = (row - NP) >> 3, tt = (row - NP) & 7; df = out + O_WINK_S + ((size_t)b * 512 + 504 + tt) * 128 + col; }
                    else { const int b = row >> 12, t = row & 4095; if (t >= SEQ - 512) df = out + O_WINK_P + ((size_t)b * 512 + (t - (SEQ - 512))) * 128 + col; }
                    if (df) { *(f32x4*)df = (f32x4){o0[0], o0[1], o0[2], o0[3]}; *(f32x4*)(df + 4) = (f32x4){o0[4], o0[5], o0[6], o0[7]};
                              *(f32x4*)(df + 32) = (f32x4){o1[0], o1[1], o1[2], o1[3]}; *(f32x4*)(df + 36) = (f32x4){o1[4], o1[5], o1[6], o1[7]}; }
                } else if (pn == 12) {
                    *(u32x4*)((bf16*)(ws + WS_VS) + CM(lc, row)) = pack8(v0); *(u32x4*)((bf16*)(ws + WS_VW) + CM(lc, row)) = pack8(v1);
                    float* fs = out + (dec ? O_SLCV_S + (size_t)(row - NP) * 128 : O_SLCV_P + (size_t)row * 128) + lc;
                    *(f32x4*)fs = (f32x4){v0[0], v0[1], v0[2], v0[3]}; *(f32x4*)(fs + 4) = (f32x4){v0[4], v0[5], v0[6], v0[7]};
                    float* fw = nullptr;
                    if (dec) { const int b = (row - NP) >> 3, tt = (row - NP) & 7; fw = out + O_WINV_S + ((size_t)b * 512 + 504 + tt) * 128 + lc; }
                    else { const int b = row >> 12, t = row & 4095; if (t >= SEQ - 512) fw = out + O_WINV_P + ((size_t)b * 512 + (t - (SEQ - 512))) * 128 + lc; }
                    if (fw) { *(f32x4*)fw = (f32x4){v1[0], v1[1], v1[2], v1[3]}; *(f32x4*)(fw + 4) = (f32x4){v1[4], v1[5], v1[6], v1[7]}; }
                } else {
                    const int cb = (pn - 13) * 256 + lc;
#pragma unroll
                    for (int e = 0; e < 8; ++e) { v0[e] = siluf_(v0[e]); v1[e] = siluf_(v1[e]); }
                    bf16* dst = (bf16*)(ws + WS_NG);
                    *(u32x4*)(dst + CM(cb, row)) = pack8(v0); *(u32x4*)(dst + CM(cb + 128, row)) = pack8(v1);
                }
            }
    }
};

__device__ __forceinline__ void ngl_unit(unsigned char* ws, int unit, int lane, int wave) {
    const int row0 = unit * 128 + wave * 16, fr = lane & 15, fq = lane >> 4;
    const bf16* a = (const bf16*)(ws + WS_H) + (size_t)(row0 + fr) * DM + 8 * fq;
    const bf16* b0 = (const bf16*)(ws + WS_WNGLT) + (size_t)fr * DM + 8 * fq;
    const bf16* b1 = b0 + 16 * DM;
    f32x4 c0 = {0.f, 0.f, 0.f, 0.f}, c1 = {0.f, 0.f, 0.f, 0.f};
#pragma unroll 8
    for (int s = 0; s < 32; ++s) {
        const bf16x8 av = *(const bf16x8*)(a + 32 * s), bv0 = *(const bf16x8*)(b0 + 32 * s), bv1 = *(const bf16x8*)(b1 + 32 * s);
        c0 = __builtin_amdgcn_mfma_f32_16x16x32_bf16(av, bv0, c0, 0, 0, 0);
        c1 = __builtin_amdgcn_mfma_f32_16x16x32_bf16(av, bv1, c1, 0, 0, 0);
    }
    float* gl = (float*)(ws + WS_GL);
#pragma unroll
    for (int i = 0; i < 4; ++i) { const int r = row0 + 4 * fq + i; gl[(size_t)r * 32 + fr] = sigmoidf_(c0[i]); gl[(size_t)r * 32 + 16 + fr] = sigmoidf_(c1[i]); }
}

template <bool DEC>
__device__ __forceinline__ void compress_unit(const Args& A, LAS unsigned char* lds, int unit, int tid, int lane, int wave) {
    unsigned char* ws = A.ws;
    asm volatile("" : "+v"(tid), "+v"(lane));
    const int kv = DEC ? (unit >> 8) : (unit >> 3), b = DEC ? ((unit >> 3) & 31) : ((unit >> 1) & 3), part = DEC ? (unit & 7) : (unit & 1);
    const int r32 = lane & 31, hi = lane >> 5, kvh = wave >> 2, bt = (wave >> 1) & 1, et = wave & 1, m = kv * 2 + kvh;
    constexpr int AP = 528;
    LAS unsigned char* bufA = lds;
    LAS float* biasL = (LAS float*)(lds + 2 * 64 * AP);
    LAS float* xch = (LAS float*)(lds + 2 * 64 * AP + 512);
    __syncthreads();
    unsigned offs[8];
    const float* src;
    if (DEC) { src = (const float*)A.in[kv ? I_CCV : I_CCK]; const int* pt = (const int*)A.in[I_PT] + b * 128 + part * 16;
#pragma unroll
        for (int i = 0; i < 8; ++i) { const int blk = (tid >> 6) + 8 * i; offs[i] = ((unsigned)pt[blk >> 2] * 128u + (unsigned)(blk & 3) * 32u) * 128u + 4u * (tid & 63); } }
    else { src = A.out + (kv ? O_CMPV_P : O_CMPK_P) + (size_t)b * SEQ * 128 + (size_t)part * 64 * 32 * 128;
#pragma unroll
        for (int i = 0; i < 8; ++i) { const int blk = (tid >> 6) + 8 * i; offs[i] = (unsigned)(blk * 32) * 128u + 4u * (tid & 63); } }
#define GLD16(dst, ptr) asm volatile("global_load_dwordx4 %0, %1, off" : "=v"(dst) : "v"(ptr) : "memory")
#define GLD16NT(dst, ptr) asm volatile("global_load_dwordx4 %0, %1, off nt" : "=v"(dst) : "v"(ptr) : "memory")
#define WAIT8(N, a) asm volatile("s_waitcnt vmcnt(" #N ")" : "+v"(a[0]), "+v"(a[1]), "+v"(a[2]), "+v"(a[3]), "+v"(a[4]), "+v"(a[5]), "+v"(a[6]), "+v"(a[7]) :: "memory")
    const unsigned rot = DEC ? (unsigned)(unit & 15) : 0u;
    f32x4 preA[8], preB[8];
    bf16x8 wA[8], wB[8];
    f32x16 acc = f32x16{};
    const bf16* w1t = (const bf16*)(ws + WS_W1T) + (size_t)m * 64 * 2048 + (size_t)(et * 512 + lane) * 8;
#define LD_ROWS(PRE, S) do { const unsigned s2_ = ((((S) < 16) ? (unsigned)(S) : 15u) + rot) & 15u; _Pragma("unroll") for (int i = 0; i < 8; ++i) { const float* p_ = src + offs[i] + s2_ * 256u; if (DEC) GLD16NT(PRE[i], p_); else GLD16(PRE[i], p_); } } while (0)
#define LD_W1(W, S) do { const int sn_ = (int)(((((S) < 16) ? (unsigned)(S) : 15u) + rot) & 15u); _Pragma("unroll") for (int q = 0; q < 8; ++q) { const bf16* p_ = w1t + sn_ * 8192 + 512 * q; GLD16(W[q], p_); } } while (0)
    LD_ROWS(preA, 0); LD_W1(wA, 0); LD_ROWS(preB, 1);
    if (tid < 128) { const int k2 = tid >> 6, e = tid & 63; const float* cb = (const float*)(ws + WS_CBIAS) + ((kv * 2 + k2) * 32) * 64 + e; float bp[32];
#pragma unroll
        for (int p = 0; p < 32; ++p) bp[p] = cb[p * 64];
        float s = 0.f;
#pragma unroll
        for (int p = 0; p < 32; ++p) s += bp[p];
        biasL[tid] = s; }
#define CMP_STEP(PRE, WC, WN, S) do { \
        LAS unsigned char* buf = bufA + ((S) & 1) * 64 * AP; \
        WAIT8(16, PRE); \
        _Pragma("unroll") for (int i = 0; i < 8; ++i) { const int blk = (tid >> 6) + 8 * i; u32x2 o; o.x = pk2(PRE[i].x, PRE[i].y); o.y = pk2(PRE[i].z, PRE[i].w); *(LAS u32x2*)(buf + blk * AP + (tid & 63) * 8) = o; } \
        LD_W1(WN, (S) + 1); LD_ROWS(PRE, (S) + 2); \
        __syncthreads(); \
        WAIT8(24, WC); \
        _Pragma("unroll") for (int q = 0; q < 8; ++q) { \
            const bf16x8 bf = *(LAS const bf16x8*)(buf + (32 * bt + r32) * AP + ((q >> 2) * 128 + kvh * 64 + 16 * (q & 3) + 8 * hi) * 2); \
            acc = MFMA32(WC[q], bf, acc); } } while (0)
#pragma unroll 1
    for (int s = 0; s < 16; s += 2) { CMP_STEP(preA, wA, wB, s); CMP_STEP(preB, wB, wA, s + 1); }
    asm volatile("s_waitcnt vmcnt(0)" ::: "memory");
#undef CMP_STEP
#undef LD_ROWS
#undef LD_W1
#undef GLD16
#undef GLD16NT
#undef WAIT8
#pragma unroll
    for (int r = 0; r < 16; ++r) acc[r] = gelu_tanh(acc[r] + biasL[kvh * 64 + 32 * et + crow(r, hi)]);
    const bf16* w2t = (const bf16*)(ws + WS_W2T) + (size_t)m * 64 * 64;
    f32x16 oacc[2]; oacc[0] = f32x16{}; oacc[1] = f32x16{};
#pragma unroll
    for (int s2 = 0; s2 < 2; ++s2) {
        const bf16x8 pb = pack_frag(acc, 8 * s2);
#pragma unroll
        for (int ft = 0; ft < 2; ++ft) {
            const bf16* wp = w2t + (32 * ft + r32) * 64 + 32 * et + 16 * s2 + 4 * hi;
            const s16x4 lo = *(const s16x4*)wp, hh = *(const s16x4*)(wp + 8);
            oacc[ft] = MFMA32(cat8(lo, hh), pb, oacc[ft]);
        }
    }
    LAS float* xp = xch + ((kvh * 2 + bt) * 32) * 64 + lane;
    if (et == 1) {
#pragma unroll
        for (int ft = 0; ft < 2; ++ft)
#pragma unroll
            for (int r = 0; r < 16; ++r) xp[(ft * 16 + r) * 64] = oacc[ft][r];
    }
    __syncthreads();
    if (et == 0) {
        const int blk = 32 * bt + r32;
#pragma unroll
        for (int ft = 0; ft < 2; ++ft)
#pragma unroll
            for (int q = 0; q < 4; ++q) {
                const int f = 32 * ft + 8 * q + 4 * hi;
                const float v0 = oacc[ft][4 * q] + xp[(ft * 16 + 4 * q) * 64], v1 = oacc[ft][4 * q + 1] + xp[(ft * 16 + 4 * q + 1) * 64];
                const float v2 = oacc[ft][4 * q + 2] + xp[(ft * 16 + 4 * q + 2) * 64], v3 = oacc[ft][4 * q + 3] + xp[(ft * 16 + 4 * q + 3) * 64];
                if (DEC) { float* d = (float*)(ws + (kv ? WS_VCS : WS_KCS)) + (((size_t)b * 512 + part * 64 + blk) * 2 + kvh) * 64 + f; *(f32x4*)d = (f32x4){v0, v1, v2, v3}; }
                else { bf16* d = (bf16*)(ws + (kv ? WS_VCP : WS_KCP)) + (((size_t)b * 128 + part * 64 + blk) * 2 + kvh) * 64 + f;
                    u32x2 o; o.x = pk2(v0, v1); o.y = pk2(v2, v3); *(u32x2*)d = o; }
            }
    }
}

__device__ __forceinline__ int tr_off(int lane, int pitch) { return ((lane & 15) >> 2) * pitch + (16 * ((lane >> 4) & 1) + 4 * (lane & 3)) * 2; }

__device__ __forceinline__ void ret_pass1_unit(unsigned char* ws, LAS unsigned char* lds, int unit, int tid, int lane, int wave) {
    const int bh = unit >> 5, c = unit & 31, b = bh >> 2, h = bh & 3;
    constexpr int TP = 320;
    LAS unsigned char* Kt = lds; LAS unsigned char* Vt = lds + 128 * TP;
    const size_t row0 = (size_t)b * SEQ + c * 128;
    const float lg = log2g(h);
    __syncthreads();
#pragma unroll
    for (int i = 0; i < 4; ++i) {
        const int row = tid & 127, ch = (tid >> 7) + 4 * i;
        const u32x4 kx = *(const u32x4*)((const bf16*)(ws + WS_KR) + CM(h * 128 + ch * 8, row0 + row));
        const u32x4 vx = *(const u32x4*)((const bf16*)(ws + WS_VR) + CM(h * 128 + ch * 8, row0 + row));
        const float dc = exp2f((float)(127 - row) * lg);
        u32x4 ko; ko.x = pk2(bflo(kx.x) * dc, bfhi(kx.x) * dc); ko.y = pk2(bflo(kx.y) * dc, bfhi(kx.y) * dc); ko.z = pk2(bflo(kx.z) * dc, bfhi(kx.z) * dc); ko.w = pk2(bflo(kx.w) * dc, bfhi(kx.w) * dc);
        *(LAS u32x4*)(Kt + row * TP + ch * 16) = ko; *(LAS u32x4*)(Vt + row * TP + ch * 16) = vx;
    }
    __syncthreads();
    const int r32 = lane & 31, hi = lane >> 5, dvb = wave & 3, dkh = wave >> 2, tro = tr_off(lane, TP);
    f32x16 acc[2]; acc[0] = f32x16{}; acc[1] = f32x16{};
#pragma unroll
    for (int s = 0; s < 8; ++s) {
        const int t0 = 16 * s + 8 * hi;
        const bf16x8 af = cat8(ds_tr(Vt + t0 * TP + 64 * dvb + tro), ds_tr(Vt + (t0 + 4) * TP + 64 * dvb + tro));
#pragma unroll
        for (int n = 0; n < 2; ++n) {
            const int cb = 64 * (2 * dkh + n);
            const bf16x8 bfr = cat8(ds_tr(Kt + t0 * TP + cb + tro), ds_tr(Kt + (t0 + 4) * TP + cb + tro));
            acc[n] = MFMA32(af, bfr, acc[n]);
        }
    }
    float* dst = (float*)(ws + WS_KVT) + (size_t)unit * 16384;
#pragma unroll
    for (int n = 0; n < 2; ++n)
#pragma unroll
        for (int r = 0; r < 16; ++r) dst[(32 * dvb + crow(r, hi)) * 128 + 32 * (2 * dkh + n) + r32] = acc[n][r];
}

__device__ __forceinline__ void ret_pass2(const Args& A, int tid) {
    unsigned char* ws = A.ws;
    for (int e = blockIdx.x * 512 + tid; e < 16 * 16384; e += gridDim.x * 512) {
        const int bh = e >> 14, q = e & 16383, dv = q >> 7, dk = q & 127;
        const float gC = exp2f(128.f * log2g(bh & 3));
        const float* kv = (const float*)(ws + WS_KVT) + (size_t)bh * 32 * 16384 + q;
        bf16* st = (bf16*)(ws + WS_ST) + (size_t)bh * 32 * 16384 + (size_t)(((((dv >> 6) * 2 + ((dv >> 5) & 1)) * 8 + (dk >> 4)) * 64 + (dv & 31) + 32 * ((dk >> 3) & 1)) * 8 + (dk & 7));
        float kvr[32];
#pragma unroll
        for (int c = 0; c < 32; ++c) kvr[c] = kv[(size_t)c * 16384];
        float S = 0.f;
#pragma unroll
        for (int c = 0; c < 32; ++c) { st[(size_t)c * 16384] = (bf16)f2bf(S); S = gC * S + kvr[c]; }
        A.out[O_RETP + (size_t)bh * 16384 + dk * 128 + dv] = S;
    }
}

__device__ __forceinline__ void ret_pass3_unit(const Args& A, LAS unsigned char* lds, int unit, int tid, int lane, int wave) {
    unsigned char* ws = A.ws;
    const int bh = unit >> 5, c = unit & 31, b = bh >> 2, h = bh & 3;
    constexpr int KP = 272, VP = 320;
    LAS unsigned char* Kt = lds; LAS unsigned char* Vt = lds + 128 * KP; LAS float* red = (LAS float*)(lds + 128 * KP + 128 * VP);
    const size_t row0 = (size_t)b * SEQ + c * 128;
    const float lg = log2g(h);
    __syncthreads();
#pragma unroll
    for (int i = 0; i < 4; ++i) {
        const int row = tid & 127, ch = (tid >> 7) + 4 * i;
        *(LAS u32x4*)(Kt + row * KP + ch * 16) = *(const u32x4*)((const bf16*)(ws + WS_KR) + CM(h * 128 + ch * 8, row0 + row));
        *(LAS u32x4*)(Vt + row * VP + ch * 16) = *(const u32x4*)((const bf16*)(ws + WS_VR) + CM(h * 128 + ch * 8, row0 + row));
    }
    const int r32 = lane & 31, hi = lane >> 5, ib = wave & 3, dh = wave >> 2, tro = tr_off(lane, VP);
    const int il = 32 * ib + r32;
    bf16x8 qf[8];
    { const bf16* qp = (const bf16*)(ws + WS_QR) + CM(h * 128 + 8 * hi, row0 + il);
#pragma unroll
      for (int s = 0; s < 8; ++s) qf[s] = *(const bf16x8*)(qp + (size_t)s * (2 * NTOK * 8)); }
    __syncthreads();
    f32x16 oacc[2]; oacc[0] = f32x16{}; oacc[1] = f32x16{};
    for (int jb = 0; jb <= ib; ++jb) {
        f32x16 sT = f32x16{};
#pragma unroll
        for (int s = 0; s < 8; ++s) { const bf16x8 kf = *(LAS const bf16x8*)(Kt + (32 * jb + r32) * KP + (16 * s + 8 * hi) * 2); sT = MFMA32(kf, qf[s], sT); }
#pragma unroll
        for (int r = 0; r < 16; ++r) { const int j = 32 * jb + crow(r, hi); const float d = exp2f((float)(il - j) * lg); sT[r] = (j <= il) ? sT[r] * d : 0.f; }
#pragma unroll
        for (int s2 = 0; s2 < 2; ++s2) {
            const bf16x8 pb = pack_frag(sT, 8 * s2);
            const int j0 = 32 * jb + 16 * s2 + 4 * hi;
#pragma unroll
            for (int dvb = 0; dvb < 2; ++dvb) {
                const int cb = 64 * (2 * dh + dvb);
                const bf16x8 vf = cat8(ds_tr(Vt + j0 * VP + cb + tro), ds_tr(Vt + (j0 + 8) * VP + cb + tro));
                oacc[dvb] = MFMA32(vf, pb, oacc[dvb]);
            }
        }
    }
    f32x16 cacc[2]; cacc[0] = f32x16{}; cacc[1] = f32x16{};
    { const bf16* sp = (const bf16*)(ws + WS_ST) + (size_t)unit * 16384 + (size_t)(dh * 2 * 8 * 64 + lane) * 8;
#pragma unroll
      for (int s = 0; s < 8; ++s) {
          const bf16x8 a0 = *(const bf16x8*)(sp + s * 512), a1 = *(const bf16x8*)(sp + 8 * 512 + s * 512);
          cacc[0] = MFMA32(a0, qf[s], cacc[0]); cacc[1] = MFMA32(a1, qf[s], cacc[1]);
      } }
    const float qd = exp2f((float)(il + 1) * lg);
    float s1 = 0.f, s2 = 0.f;
#pragma unroll
    for (int dvb = 0; dvb < 2; ++dvb)
#pragma unroll
        for (int r = 0; r < 16; ++r) { const float o = oacc[dvb][r] + qd * cacc[dvb][r]; oacc[dvb][r] = o; s1 += o; s2 += o * o; }
    s1 = xor32_sum(s1); s2 = xor32_sum(s2);
    if (hi == 0) { red[(dh * 128 + il) * 2] = s1; red[(dh * 128 + il) * 2 + 1] = s2; }
    __syncthreads();
    const float t1 = red[il * 2] + red[(128 + il) * 2], t2 = red[il * 2 + 1] + red[(128 + il) * 2 + 1];
    const float mu = t1 * (1.f / 128.f), var = fmaxf(t2 * (1.f / 128.f) - mu * mu, 0.f), rstd = 1.f / sqrtf(var + GN_EPS);
    const float* gg = (const float*)A.in[I_GNG] + h * 128; const float* gb = (const float*)A.in[I_GNB] + h * 128;
    const bf16* rgp = (const bf16*)(ws + WS_RG);
    bf16* yp = (bf16*)(ws + WS_YMIX) + (row0 + il) * 1024 + h * 128;
    u32x2 rgv[2][4];
#pragma unroll
    for (int dvb = 0; dvb < 2; ++dvb)
#pragma unroll
        for (int q = 0; q < 4; ++q) rgv[dvb][q] = *(const u32x2*)(rgp + CM(h * 128 + 32 * (2 * dh + dvb) + 8 * q + 4 * hi, row0 + il));
#pragma unroll
    for (int dvb = 0; dvb < 2; ++dvb)
#pragma unroll
        for (int q = 0; q < 4; ++q) {
            const int dv = 32 * (2 * dh + dvb) + 8 * q + 4 * hi;
            const f32x4 g4 = *(const f32x4*)(gg + dv), b4 = *(const f32x4*)(gb + dv);
            const u32x2 rg = rgv[dvb][q];
            const float y0 = ((oacc[dvb][4 * q] - mu) * rstd * g4.x + b4.x) * bflo(rg.x), y1 = ((oacc[dvb][4 * q + 1] - mu) * rstd * g4.y + b4.y) * bfhi(rg.x);
            const float y2 = ((oacc[dvb][4 * q + 2] - mu) * rstd * g4.z + b4.z) * bflo(rg.y), y3 = ((oacc[dvb][4 * q + 3] - mu) * rstd * g4.w + b4.w) * bfhi(rg.y);
            u32x2 o; o.x = pk2(y0, y1); o.y = pk2(y2, y3); *(u32x2*)(yp + dv) = o;
        }
}

__device__ __forceinline__ void ret_decode_unit(const Args& A, LAS unsigned char* lds, int unit, int tid, int lane, int wave) {
    unsigned char* ws = A.ws;
    const int b = unit >> 2, h = unit & 3;
    LAS float* qL = (LAS float*)lds; LAS float* kL = qL + 1024; LAS float* vL = kL + 1024; LAS float* sL = vL + 1024;
    LAS float* red = sL + 64;
    const float lg = log2g(h);
    __syncthreads();
    { bf16 t6[6];
#pragma unroll
      for (int u = 0; u < 6; ++u) { const int i = tid + 512 * u, w = i >> 10, q = i & 1023, j = q >> 7, d = q & 127;
          t6[u] = *((const bf16*)(ws + (w == 0 ? WS_QR : w == 1 ? WS_KR : WS_VR)) + CM(h * 128 + d, NP + b * 8 + j)); }
#pragma unroll
      for (int u = 0; u < 6; ++u) qL[tid + 512 * u] = bf2f(t6[u]); }
    __syncthreads();
    {
        const int i = wave, j = lane & 7, sl = lane >> 3; float a = 0.f;
#pragma unroll
        for (int d = 0; d < 16; ++d) a += qL[i * 128 + sl * 16 + d] * kL[j * 128 + sl * 16 + d];
        a += __shfl_xor(a, 8); a += __shfl_xor(a, 16); a += __shfl_xor(a, 32);
        if (lane < 8) sL[i * 8 + j] = (j <= i) ? a * exp2f((float)(i - j) * lg) : 0.f;
    }
    const int dv = tid & 127, dkq = tid >> 7;
    float vj[8], cr[8];
#pragma unroll
    for (int j = 0; j < 8; ++j) { vj[j] = vL[j * 128 + dv] * exp2f((float)(7 - j) * lg); cr[j] = 0.f; }
    const float g8 = exp2f(8.f * lg);
    const float* stp = (const float*)A.in[I_SRET] + (size_t)unit * 16384 + dv;
    float* nsp = A.out + O_RETS + (size_t)unit * 16384 + dv;
    float stv[32];
#pragma unroll
    for (int k = 0; k < 32; ++k) stv[k] = stp[(32 * dkq + k) * 128];
#pragma unroll
    for (int k = 0; k < 32; ++k) { const int dk = 32 * dkq + k;
        const float st = stv[k]; float ns = g8 * st;
#pragma unroll
        for (int j = 0; j < 8; ++j) { cr[j] += qL[j * 128 + dk] * st; ns += kL[j * 128 + dk] * vj[j]; }
        nsp[dk * 128] = ns;
    }
#pragma unroll
    for (int j = 0; j < 8; ++j) red[(dkq * 8 + j) * 128 + dv] = cr[j];
    __syncthreads();
    {
        const int i = wave; const float qd = exp2f((float)(i + 1) * lg);
        float o[2], s1 = 0.f, s2 = 0.f;
#pragma unroll
        for (int k = 0; k < 2; ++k) { const int d = lane + 64 * k;
            float x = (red[(0 * 8 + i) * 128 + d] + red[(1 * 8 + i) * 128 + d]) + (red[(2 * 8 + i) * 128 + d] + red[(3 * 8 + i) * 128 + d]);
            x *= qd;
#pragma unroll
            for (int j = 0; j < 8; ++j) x += sL[i * 8 + j] * vL[j * 128 + d];
            o[k] = x; s1 += x; s2 += x * x; }
        s1 = wave_sum(s1); s2 = wave_sum(s2);
        const float mu = s1 * (1.f / 128.f), var = fmaxf(s2 * (1.f / 128.f) - mu * mu, 0.f), rstd = 1.f / sqrtf(var + GN_EPS);
        const size_t row = (size_t)NP + b * 8 + i;
#pragma unroll
        for (int k = 0; k < 2; ++k) { const int d = lane + 64 * k;
            const float y = ((o[k] - mu) * rstd * ((const float*)A.in[I_GNG])[h * 128 + d] + ((const float*)A.in[I_GNB])[h * 128 + d]) * bf2f(((const bf16*)(ws + WS_RG))[CM(h * 128 + d, row)]);
            ((bf16*)(ws + WS_YMIX))[row * 1024 + h * 128 + d] = (bf16)f2bf(y); }
    }
}

constexpr int NSA_KP = 144, NSA_VP = 192;
constexpr int NSA_SLOT = 8192;
constexpr int NSA_KT = 0, NSA_VT = 3 * NSA_SLOT, NSA_IMP = NSA_VT + 4 * NSA_SLOT,
     NSA_SEL = NSA_IMP + 4 * 64 * 65 * 4, NSA_IMPF = NSA_SEL + 64 * 8, NSA_GLS = NSA_IMPF + 4 * 64 * 4, NSA_END = NSA_GLS + 3 * 512 * 4;
static_assert(NSA_END <= MISC_OFF && 128 * NSA_KP <= 3 * NSA_SLOT && 128 * NSA_VP <= 4 * NSA_SLOT, "nsa lds");
__device__ __forceinline__ void glds16(const void* g, unsigned lds_base) {
    unsigned sv; asm volatile("s_mov_b32 %0, m0\n\ts_mov_b32 m0, %2\n\ts_nop 0\n\tglobal_load_lds_dwordx4 %1, off\n\ts_mov_b32 m0, %0" : "=&s"(sv) : "v"(g), "s"(lds_base) : "memory"); }

__device__ __forceinline__ float max3f(float a, float b, float c) { float r; asm("v_max3_f32 %0, %1, %2, %3" : "=v"(r) : "v"(a), "v"(b), "v"(c)); return r; }
__device__ __forceinline__ float max2f(float a, float b) { float r; asm("v_max_f32_e32 %0, %1, %2" : "=v"(r) : "v"(a), "v"(b)); return r; }
constexpr float NSA_THR = 8.f;
__device__ __forceinline__ void nsa_qk(f32x16& p0, f32x16& p1, const f32x16& negm, const bf16x8 (&q)[4], LAS const unsigned char* Kt, int r32, int hi, int tl, bool on, int mode) {
    f32x16 c0;
#pragma unroll
    for (int r = 0; r < 16; ++r) c0[r] = on ? negm[r] : NEGBIG;
    bf16x8 kf[8];
#pragma unroll
    for (int d0 = 0; d0 < 4; ++d0) { kf[2 * d0] = *(LAS const bf16x8*)(Kt + d0 * 2048 + hi * 1024 + r32 * 16); kf[2 * d0 + 1] = *(LAS const bf16x8*)(Kt + d0 * 2048 + hi * 1024 + 512 + r32 * 16); }
    __builtin_amdgcn_sched_barrier(0);
#pragma unroll
    for (int d0 = 0; d0 < 4; ++d0) {
        if (d0 == 0) { p0 = MFMA32(kf[0], q[0], c0); p1 = MFMA32(kf[1], q[0], c0); } else { p0 = MFMA32(kf[2 * d0], q[d0], p0); p1 = MFMA32(kf[2 * d0 + 1], q[d0], p1); }
    }
    if (mode != 0) {
        asm volatile("" : "+v"(tl));
        const int lo = (mode == 2) ? tl : 0, hb = (mode == 1) ? tl : 63;
#pragma unroll
        for (int r = 0; r < 16; ++r) { const int kk = crow(r, hi);
            p0[r] = (kk >= lo && kk <= hb) ? p0[r] : NEGBIG; p1[r] = (kk + 32 >= lo && kk + 32 <= hb) ? p1[r] : NEGBIG; }
    }
}
__device__ __forceinline__ void nsa_sv(f32x16 (&o)[2], f32x16& negm, float& m, float& l, f32x16& p0, f32x16& p1, LAS const unsigned char* Vt, int hi, int vb) {
    float mx = max3f(p0[0], p0[1], p1[0]), mb = max3f(p0[2], p0[3], p1[1]); mx = max3f(mx, p1[2], p1[3]);
#pragma unroll
    for (int r = 4; r < 16; r += 4) { mx = max3f(mx, p0[r], p0[r + 1]); mb = max3f(mb, p0[r + 2], p0[r + 3]); mx = max3f(mx, p1[r], p1[r + 1]); mb = max3f(mb, p1[r + 2], p1[r + 3]); }
    mx = xor32_max(max2f(mx, mb));
    if (__any(mx > NSA_THR)) {
        const float d = fmaxf(mx, 0.f), alpha = __builtin_amdgcn_exp2f(-d);
        m += d; l *= alpha;
#pragma unroll
        for (int r = 0; r < 16; ++r) { p0[r] -= d; p1[r] -= d; o[0][r] *= alpha; o[1][r] *= alpha; negm[r] = -m; }
    }
    f32x2 rs0 = {0.f, 0.f}, rs1 = {0.f, 0.f};
#pragma unroll
    for (int r = 0; r < 16; r += 2) {
        p0[r] = __builtin_amdgcn_exp2f(p0[r]); p0[r + 1] = __builtin_amdgcn_exp2f(p0[r + 1]); p1[r] = __builtin_amdgcn_exp2f(p1[r]); p1[r + 1] = __builtin_amdgcn_exp2f(p1[r + 1]);
        rs0 += (f32x2){p0[r], p0[r + 1]}; rs1 += (f32x2){p1[r], p1[r + 1]};
    }
    l += (rs0.x + rs0.y) + (rs1.x + rs1.y);
#pragma unroll
    for (int s = 0; s < 4; ++s) {
        const bf16x8 pb = pack_frag(s < 2 ? p0 : p1, 8 * (s & 1));
#pragma unroll
        for (int db = 0; db < 2; ++db) {
            const bf16x8 vf = cat8(ds_tr(Vt + db * 4096 + s * 1024 + vb), ds_tr(Vt + db * 4096 + s * 1024 + 512 + vb));
            o[db] = MFMA32(vf, pb, o[db]);
        }
    }
}

__device__ __forceinline__ void nsa_prompt_unit(const Args& A, LAS unsigned char* lds, int b, int kvh, int qb, int tid, int lane, int wave) {
    unsigned char* ws = A.ws;
    asm volatile("" : "+v"(tid), "+v"(lane));
    const int r32 = lane & 31, hi = lane >> 5, g = wave & 3, qs = wave >> 2, hq = kvh * 4 + g, tl = 32 * qs + r32, q0 = 64 * qb, t = q0 + tl;
    const size_t rowb = (size_t)b * SEQ, row = rowb + t;
    const int tro = tr_off(lane, NSA_VP);
    LAS unsigned char* KT = lds + NSA_KT; LAS unsigned char* VT = lds + NSA_VT;
    LAS float* IMP = (LAS float*)(lds + NSA_IMP); LAS unsigned long long* SEL = (LAS unsigned long long*)(lds + NSA_SEL); LAS float* IMPF = (LAS float*)(lds + NSA_IMPF); LAS float* GLS = (LAS float*)(lds + NSA_GLS);
    const int lrow = tid & 63, lch = tid >> 6;
    __syncthreads();
    {
        const bf16* kc = (const bf16*)(ws + WS_KCP) + ((size_t)b * 128) * 128 + kvh * 64 + lch * 8; const bf16* vc = (const bf16*)(ws + WS_VCP) + ((size_t)b * 128) * 128 + kvh * 64 + lch * 8;
#pragma unroll
        for (int i = 0; i < 2; ++i) { const int rr = lrow + 64 * i;
            *(LAS u32x4*)(KT + rr * NSA_KP + lch * 16) = *(const u32x4*)(kc + (size_t)rr * 128);
            *(LAS u32x4*)(VT + rr * NSA_VP + lch * 16) = *(const u32x4*)(vc + (size_t)rr * 128); }
    }
    bf16x8 qr[4];
    f32x16 otot[2];
    const float* glp = (const float*)(ws + WS_GL) + row * 32 + hq;
    {
        bf16x8 qn[4];
        const bf16* qp = (const bf16*)(ws + WS_QN) + CM(hq * 64 + 8 * hi, row);
#pragma unroll
        for (int d0 = 0; d0 < 4; ++d0) qn[d0] = *(const bf16x8*)(qp + (size_t)d0 * (2 * NTOK * 8));
        { const float ga = glp[0], gb = glp[8], gc = glp[16]; GLS[tid] = ga; GLS[512 + tid] = gb; GLS[1024 + tid] = gc; }
        __syncthreads();
        const int ntile = (qb >= 31) ? 2 : 1, nvalid = (t + 1) >> 5;
        float mx = MINIT;
#pragma unroll 1
        for (int pt = 0; pt < 2 * ntile; ++pt) {
            f32x16 p = f32x16{};
#pragma unroll
            for (int d0 = 0; d0 < 4; ++d0) { const bf16x8 kf = *(LAS const bf16x8*)(KT + (32 * pt + r32) * NSA_KP + (16 * d0 + 8 * hi) * 2); p = MFMA32(kf, qn[d0], p); }
#pragma unroll
            for (int r = 0; r < 16; ++r) { const int cidx = 32 * pt + crow(r, hi); mx = fmaxf(mx, (cidx < nvalid) ? p[r] : NEGBIG); }
        }
        mx = xor32_max(mx);
        float ls = 0.f;
        f32x16 oc[2]; oc[0] = f32x16{}; oc[1] = f32x16{};
        LAS float* ip = IMP + (g * 64 + tl) * 65;
#pragma unroll 1
        for (int pt = 0; pt < 4; ++pt) {
            f32x16 p = f32x16{};
            if (pt < 2 * ntile) {
#pragma unroll
                for (int d0 = 0; d0 < 4; ++d0) { const bf16x8 kf = *(LAS const bf16x8*)(KT + (32 * pt + r32) * NSA_KP + (16 * d0 + 8 * hi) * 2); p = MFMA32(kf, qn[d0], p); }
            }
#pragma unroll
            for (int r = 0; r < 16; ++r) { const int cidx = 32 * pt + crow(r, hi); p[r] = (cidx < nvalid) ? __builtin_amdgcn_exp2f(p[r] - mx) : 0.f; ls += p[r]; }
#pragma unroll
            for (int r = 1; r < 16; r += 2) ip[16 * pt + (crow(r - 1, hi) >> 1)] = p[r - 1] + p[r];
            if (pt < 2 * ntile) {
#pragma unroll
                for (int s2 = 0; s2 < 2; ++s2) {
                    const bf16x8 pb = pack_frag(p, 8 * s2);
                    const int j0 = 32 * pt + 16 * s2 + 4 * hi;
#pragma unroll
                    for (int db = 0; db < 2; ++db) { const bf16x8 vf = cat8(ds_tr(VT + j0 * NSA_VP + 64 * db + tro), ds_tr(VT + (j0 + 8) * NSA_VP + 64 * db + tro)); oc[db] = MFMA32(vf, pb, oc[db]); }
                }
            }
        }
        ls = xor32_sum(ls);
        const float inv = ls > 0.f ? 1.f / ls : 0.f;
        if (hi == 0) IMPF[g * 64 + tl] = inv;
#pragma unroll
        for (int r = 0; r < 16; ++r) { oc[0][r] *= inv; oc[1][r] *= inv; }
        const float g0 = GLS[tid];
#pragma unroll
        for (int r = 0; r < 16; ++r) { otot[0][r] = g0 * oc[0][r]; otot[1][r] = g0 * oc[1][r]; }
    }
    __syncthreads();
#pragma unroll 1
    for (int q4 = 0; q4 < 8; q4 += 4) {
        unsigned key[4], thr[4];
#pragma unroll
        for (int u = 0; u < 4; ++u) {
            const int tq = 8 * wave + q4 + u;
            const float imp = (IMP[(0 * 64 + tq) * 65 + lane] * IMPF[tq] + IMP[(1 * 64 + tq) * 65 + lane] * IMPF[64 + tq]) + (IMP[(2 * 64 + tq) * 65 + lane] * IMPF[128 + tq] + IMP[(3 * 64 + tq) * 65 + lane] * IMPF[192 + tq]);
            const bool forced = (lane == 0) || (lane == qb), valid = lane <= qb;
            key[u] = forced ? 0xFFFFFFFFu : (valid ? (__builtin_bit_cast(unsigned, imp) | 0x80000000u) : 0u);
            thr[u] = 0u;
        }
#pragma unroll 2
        for (int bit = 31; bit >= 0; --bit) {
#pragma unroll
            for (int u = 0; u < 4; ++u) { const unsigned cand = thr[u] | (1u << bit); if (__popcll(__ballot(key[u] >= cand)) >= 16) thr[u] = cand; }
        }
#pragma unroll
        for (int u = 0; u < 4; ++u) {
            const int tq = 8 * wave + q4 + u;
            const unsigned long long mgt = __ballot(key[u] > thr[u]), meq = __ballot(key[u] == thr[u]);
            const int need = 16 - __popcll(mgt);
            const int below = __builtin_amdgcn_mbcnt_hi((unsigned)(meq >> 32), __builtin_amdgcn_mbcnt_lo((unsigned)meq, 0u));
            const unsigned long long mask = mgt | __ballot(key[u] == thr[u] && below < need);
            if (lane == 0) SEL[tq] = mask;
        }
    }
    __syncthreads();
    LAS float* park = IMP + tid;
#pragma unroll
    for (int r = 0; r < 16; ++r) { park[r * 512] = otot[0][r]; park[(16 + r) * 512] = otot[1][r]; }
    { const bf16* qp2 = (const bf16*)(ws + WS_QROT) + CM(hq * 64 + 8 * hi, row);
#pragma unroll
      for (int d0 = 0; d0 < 4; ++d0) qr[d0] = *(const bf16x8*)(qp2 + (size_t)d0 * (2 * NTOK * 8)); }
    const unsigned long long sel = SEL[tl];
    const int jw0 = qb > 8 ? qb - 8 : 0, nB = qb + 1, NT = nB + (qb - jw0 + 1);
    const int wv = __builtin_amdgcn_readfirstlane(wave);
    const size_t kso = CM(kvh * 64 + wv * 8, rowb + lane), vso = CM(kvh * 64 + (wv >> 2) * 32 + (lane & 3) * 8, rowb + 16 * (wv & 3) + (lane >> 2));
    const bf16* ksb = (const bf16*)(ws + WS_KS) + kso; const bf16* vsb = (const bf16*)(ws + WS_VS) + vso;
    const bf16* kwb = (const bf16*)(ws + WS_KW) + kso; const bf16* vwb = (const bf16*)(ws + WS_VW) + vso;
    const unsigned kdst = (unsigned)(size_t)(lds + NSA_KT) + wv * 1024, vdst = (unsigned)(size_t)(lds + NSA_VT) + wv * 1024;
    const int vb = ((lane >> 4) & 1) * 32 + (lane & 3) * 8 + (4 * hi + ((lane & 15) >> 2)) * 64;
    f32x16 o[2]; o[0] = f32x16{}; o[1] = f32x16{};
    f32x16 negm = f32x16{};
    float m = 0.f, l = 0.f;
    const bool trail = qs != 0;
    f32x16 p0, p1; bool pend = false; int pend_v = 0, ks = 0;
#define NSA_DMA(T, KSL) do { const int t_ = ((T) < NT) ? (T) : NT - 1; const bool sl_ = t_ < nB; const int j_ = sl_ ? t_ : jw0 + (t_ - nB); \
        glds16((sl_ ? ksb : kwb) + (size_t)j_ * 512, (unsigned)__builtin_amdgcn_readfirstlane(kdst + (KSL) * NSA_SLOT)); \
        glds16((sl_ ? vsb : vwb) + (size_t)j_ * 512, (unsigned)__builtin_amdgcn_readfirstlane(vdst + ((T) & 3) * NSA_SLOT)); } while (0)
    asm volatile("" : "+v"(qr[0]), "+v"(qr[1]), "+v"(qr[2]), "+v"(qr[3]));
    NSA_DMA(0, 0); NSA_DMA(1, 1);
    if (trail) __builtin_amdgcn_s_setprio(1);
#pragma unroll 1
    for (int n = 0; n < NT; ++n) {
        asm volatile("s_waitcnt vmcnt(2) lgkmcnt(0)\n\ts_barrier" ::: "memory");
        const int ks2 = (ks == 0) ? 2 : ks - 1;
        NSA_DMA(n + 2, ks2);
        LAS unsigned char* kt = KT + ks * NSA_SLOT; LAS unsigned char* vt = VT + (n & 3) * NSA_SLOT;
        if (pend) { nsa_sv(o, negm, m, l, p0, p1, VT + pend_v, hi, vb); pend = false; }
        if (n == nB) {
            const float lt = xor32_sum(l), sc = GLS[512 + tid] / lt;
#pragma unroll
            for (int r = 0; r < 16; ++r) { park[r * 512] += sc * o[0][r]; park[(16 + r) * 512] += sc * o[1][r]; }
            o[0] = f32x16{}; o[1] = f32x16{}; negm = f32x16{}; m = 0.f; l = 0.f;
        }
        const bool slc = n < nB; const int j = slc ? n : jw0 + (n - nB);
        const bool on = slc ? (bool)((sel >> n) & 1ull) : true;
        const bool act = __any(on);
        const int mode = (j == qb) ? 1 : ((!slc && j == qb - 8) ? 2 : 0);
        if (act) nsa_qk(p0, p1, negm, qr, kt, r32, hi, tl, on, mode);
        if (trail) { pend = act; pend_v = (n & 3) * NSA_SLOT; }
        else if (act) nsa_sv(o, negm, m, l, p0, p1, vt, hi, vb);
        ks = (ks == 2) ? 0 : ks + 1;
    }
#undef NSA_DMA
    __builtin_amdgcn_s_setprio(0);
    asm volatile("s_waitcnt vmcnt(0)" ::: "memory");
    if (pend) nsa_sv(o, negm, m, l, p0, p1, VT + pend_v, hi, vb);
    {
        const float lt = xor32_sum(l), sc = GLS[1024 + tid] / lt;
#pragma unroll
        for (int r = 0; r < 16; ++r) { otot[0][r] = park[r * 512] + sc * o[0][r]; otot[1][r] = park[(16 + r) * 512] + sc * o[1][r]; }
    }
    const bf16* ngp = (const bf16*)(ws + WS_NG); bf16* yp = (bf16*)(ws + WS_YMIX) + row * 1024 + 512 + hq * 64;
    u32x2 ngv[2][4];
#pragma unroll
    for (int db = 0; db < 2; ++db)
#pragma unroll
        for (int q = 0; q < 4; ++q) ngv[db][q] = *(const u32x2*)(ngp + CM(hq * 64 + 32 * db + 8 * q + 4 * hi, row));
#pragma unroll
    for (int db = 0; db < 2; ++db)
#pragma unroll
        for (int q = 0; q < 4; ++q) {
            const int d = 32 * db + 8 * q + 4 * hi;
            const u32x2 ng = ngv[db][q];
            u32x2 ov; ov.x = pk2(otot[db][4 * q] * bflo(ng.x), otot[db][4 * q + 1] * bfhi(ng.x)); ov.y = pk2(otot[db][4 * q + 2] * bflo(ng.y), otot[db][4 * q + 3] * bfhi(ng.y));
            *(u32x2*)(yp + d) = ov;
        }
}

template <int CTRL> __device__ __forceinline__ float dpp_add(float v) { return v + __builtin_bit_cast(float, __builtin_amdgcn_update_dpp(0, __builtin_bit_cast(int, v), CTRL, 0xf, 0xf, true)); }
__device__ __forceinline__ float red16(float v) { v = dpp_add<0xB1>(v); v = dpp_add<0x4E>(v); v = dpp_add<0x141>(v); v = dpp_add<0x140>(v); return v; }
__device__ __forceinline__ float dot4(const f32x4 a, const f32x4 b) { return (a.x * b.x + a.y * b.y) + (a.z * b.z + a.w * b.w); }

__device__ __forceinline__ void dec_block(float (&m)[4], float (&l)[4], f32x4 (&o)[4], const f32x4 (&q)[4], const float* Kb, const float* Vb, int lo, int hi_, int kk) {
#pragma unroll 1
    for (int hb = 0; hb < 2; ++hb) {
        if (32 * hb >= hi_ || 32 * hb + 32 <= lo) continue;
        f32x4 kr[8], vr[8]; float s[8][4];
#pragma unroll
        for (int it = 0; it < 8; ++it) { const int key = 32 * hb + 4 * it + kk; const int kc = (key >= lo && key < hi_) ? key : lo; kr[it] = *(const f32x4*)(Kb + (size_t)kc * 128); }
#pragma unroll
        for (int it = 0; it < 8; ++it) { const int key = 32 * hb + 4 * it + kk; const bool valid = key >= lo && key < hi_; const int kc = valid ? key : lo;
            vr[it] = *(const f32x4*)(Vb + (size_t)kc * 128);
#pragma unroll
            for (int g = 0; g < 4; ++g) { const float d = red16(dot4(q[g], kr[it])); s[it][g] = valid ? d : NEGBIG; } }
#pragma unroll
        for (int g = 0; g < 4; ++g) {
            float mx = s[0][g];
#pragma unroll
            for (int it = 1; it < 8; ++it) mx = fmaxf(mx, s[it][g]);
            mx = fmaxf(mx, __shfl_xor(mx, 16)); mx = fmaxf(mx, __shfl_xor(mx, 32));
            const float mn = fmaxf(m[g], mx), alpha = __builtin_amdgcn_exp2f(m[g] - mn);
            m[g] = mn; l[g] *= alpha; o[g] = o[g] * alpha;
#pragma unroll
            for (int it = 0; it < 8; ++it) { const float p = __builtin_amdgcn_exp2f(s[it][g] - mn); l[g] += p; o[g] = o[g] + vr[it] * p; }
        }
    }
}
__device__ __forceinline__ void dec_publish(const float (&m)[4], float (&l)[4], f32x4 (&o)[4], LAS float* st, LAS float* ob, int wave, int lane) {
#pragma unroll
    for (int g = 0; g < 4; ++g) {
        l[g] += __shfl_xor(l[g], 16); l[g] += __shfl_xor(l[g], 32);
#pragma unroll
        for (int e = 0; e < 4; ++e) { float x = o[g][e]; x += __shfl_xor(x, 16); x += __shfl_xor(x, 32); o[g][e] = x; }
        if (lane < 16) *(LAS f32x4*)(ob + (wave * 4 + g) * 64 + 4 * lane) = o[g];
        if (lane == 0) { st[(wave * 4 + g) * 2] = m[g]; st[(wave * 4 + g) * 2 + 1] = l[g]; }
    }
}
__device__ __forceinline__ float dec_combine(LAS const float* st, LAS const float* ob, int g, int d) {
    float M = NEGBIG;
#pragma unroll
    for (int w = 0; w < 8; ++w) M = fmaxf(M, st[(w * 4 + g) * 2]);
    float L = 0.f, O = 0.f;
#pragma unroll
    for (int w = 0; w < 8; ++w) { const float f = exp2f(st[(w * 4 + g) * 2] - M); L += f * st[(w * 4 + g) * 2 + 1]; O += f * ob[(w * 4 + g) * 64 + d]; }
    return L > 0.f ? O / L : 0.f;
}

__device__ __forceinline__ void nsa_decode_unit(const Args& A, LAS unsigned char* lds, int unit, int tid, int lane, int wave) {
    unsigned char* ws = A.ws;
    const int b = unit >> 4, kvh = (unit >> 3) & 1, t = unit & 7, kk = lane >> 4, dq = lane & 15;
    const size_t row = (size_t)NP + b * 8 + t;
    LAS float* sc = (LAS float*)lds;
    LAS float* scr = sc + 2048;
    LAS int* selL = (LAS int*)(scr + 260);
    LAS float* ocmp = (LAS float*)(selL + 16);
    LAS float* st1 = ocmp + 2048; LAS float* ob1 = st1 + 64;
    LAS float* st2 = ob1 + 2048; LAS float* ob2 = st2 + 64;
    f32x4 qn[4], qr[4];
#pragma unroll
    for (int g = 0; g < 4; ++g) {
        const u32x2 a = *(const u32x2*)((const bf16*)(ws + WS_QN) + CM((kvh * 4 + g) * 64 + 4 * dq, row)), c = *(const u32x2*)((const bf16*)(ws + WS_QROT) + CM((kvh * 4 + g) * 64 + 4 * dq, row));
        qn[g] = (f32x4){bflo(a.x), bfhi(a.x), bflo(a.y), bfhi(a.y)}; qr[g] = (f32x4){bflo(c.x), bfhi(c.x), bflo(c.y), bfhi(c.y)};
    }
    __syncthreads();
    const float* kcs = (const float*)(ws + WS_KCS) + ((size_t)b * 512 * 2 + kvh) * 64 + 4 * dq; const float* vcs = (const float*)(ws + WS_VCS) + ((size_t)b * 512 * 2 + kvh) * 64 + 4 * dq;
    f32x4 krr[16];
#pragma unroll
    for (int it = 0; it < 16; ++it) krr[it] = *(const f32x4*)(kcs + (size_t)(64 * wave + 4 * it + kk) * 128);
#pragma unroll
    for (int it = 0; it < 16; ++it) {
        const int key = 64 * wave + 4 * it + kk;
        const f32x4 kr = krr[it];
        const float s0 = red16(dot4(qn[0], kr)), s1 = red16(dot4(qn[1], kr)), s2 = red16(dot4(qn[2], kr)), s3 = red16(dot4(qn[3], kr));
        if (dq < 4) sc[dq * 512 + key] = dq == 0 ? s0 : dq == 1 ? s1 : dq == 2 ? s2 : s3;
    }
    __syncthreads();
    if (wave < 4) {
        float v[8], mx = NEGBIG;
#pragma unroll
        for (int i = 0; i < 8; ++i) { v[i] = sc[wave * 512 + lane + 64 * i]; mx = fmaxf(mx, v[i]); }
        mx = wave_max(mx); float sm = 0.f;
#pragma unroll
        for (int i = 0; i < 8; ++i) { v[i] = __builtin_amdgcn_exp2f(v[i] - mx); sm += v[i]; }
        sm = wave_sum(sm); const float inv = 1.f / sm;
#pragma unroll
        for (int i = 0; i < 8; ++i) sc[wave * 512 + lane + 64 * i] = v[i] * inv;
    }
    __syncthreads();
    if (tid < 256) { float s = -1.f; if (tid > 0) s = (sc[2 * tid] + sc[2 * tid + 1]) + (sc[512 + 2 * tid] + sc[512 + 2 * tid + 1]) + ((sc[1024 + 2 * tid] + sc[1024 + 2 * tid + 1]) + (sc[1536 + 2 * tid] + sc[1536 + 2 * tid + 1])); scr[tid] = s; }
    {
        f32x4 oc[4]; oc[0] = oc[1] = oc[2] = oc[3] = (f32x4){0.f, 0.f, 0.f, 0.f};
        f32x4 vrr[16];
#pragma unroll
        for (int it = 0; it < 16; ++it) vrr[it] = *(const f32x4*)(vcs + (size_t)(64 * wave + 4 * it + kk) * 128);
#pragma unroll
        for (int it = 0; it < 16; ++it) {
            const int key = 64 * wave + 4 * it + kk;
            const f32x4 vr = vrr[it];
#pragma unroll
            for (int g = 0; g < 4; ++g) oc[g] = oc[g] + vr * sc[g * 512 + key];
        }
#pragma unroll
        for (int g = 0; g < 4; ++g) {
#pragma unroll
            for (int e = 0; e < 4; ++e) { float x = oc[g][e]; x += __shfl_xor(x, 16); x += __shfl_xor(x, 32); oc[g][e] = x; }
            if (lane < 16) *(LAS f32x4*)(ocmp + (wave * 4 + g) * 64 + 4 * lane) = oc[g];
        }
    }
    __syncthreads();
    {
        LAS int* rk = (LAS int*)ob1;
        const int c = tid & 255, half = tid >> 8; const float s = scr[c]; int rank = 0;
#pragma unroll 8
        for (int j4 = 0; j4 < 32; ++j4) { const f32x4 v = *(LAS const f32x4*)(scr + 128 * half + 4 * j4);
#pragma unroll
            for (int e = 0; e < 4; ++e) { const int j = 128 * half + 4 * j4 + e; rank += (v[e] > s || (v[e] == s && j < c)) ? 1 : 0; } }
        rk[tid] = rank;
        __syncthreads();
        if (tid > 0 && tid < 256) { const int r2 = rk[tid] + rk[tid + 256]; if (r2 < 14) selL[2 + r2] = tid; }
        if (tid == 0) { selL[0] = 0; selL[1] = 256; }
    }
    __syncthreads();
    {
        float m[4], l[4]; f32x4 o[4];
#pragma unroll
        for (int g = 0; g < 4; ++g) { m[g] = MINIT; l[g] = 0.f; o[g] = (f32x4){0.f, 0.f, 0.f, 0.f}; }
        const int bb0 = selL[2 * wave], bb1 = selL[2 * wave + 1];
        const int pg0 = ((const int*)A.in[I_PT])[b * 128 + ((bb0 < 256 ? bb0 : 0) >> 1)], pg1 = ((const int*)A.in[I_PT])[b * 128 + ((bb1 < 256 ? bb1 : 0) >> 1)];
#pragma unroll 1
        for (int i = 0; i < 2; ++i) {
            const int bb = i ? bb1 : bb0, pg = i ? pg1 : pg0;
            const bool past = bb < 256;
            const size_t base = past ? ((size_t)pg * 128 + (bb & 1) * 64) * 128 + kvh * 64 + 4 * dq : ((size_t)b * 8) * 128 + kvh * 64 + 4 * dq;
            const float* Kb = (past ? (const float*)A.in[I_CSK] : (const float*)(A.out + O_SLCK_S)) + base;
            const float* Vb = (past ? (const float*)A.in[I_CSV] : (const float*)(A.out + O_SLCV_S)) + base;
            dec_block(m, l, o, qr, Kb, Vb, 0, past ? 64 : t + 1, kk);
        }
        dec_publish(m, l, o, st1, ob1, wave, lane);
    }
    {
        float m[4], l[4]; f32x4 o[4];
#pragma unroll
        for (int g = 0; g < 4; ++g) { m[g] = MINIT; l[g] = 0.f; o[g] = (f32x4){0.f, 0.f, 0.f, 0.f}; }
#pragma unroll 1
        for (int i = 0; i < ((wave == 0) ? 2 : 1); ++i) {
            const size_t base = ((size_t)b * 512 + (i ? 504 : 64 * wave)) * 128 + kvh * 64 + 4 * dq;
            const float* Kb = (i ? (const float*)(A.out + O_WINK_S) : (const float*)A.in[I_SWK]) + base;
            const float* Vb = (i ? (const float*)(A.out + O_WINV_S) : (const float*)A.in[I_SWV]) + base;
            const int lo = i ? 0 : ((t > 64 * wave) ? (t - 64 * wave) : 0);
            dec_block(m, l, o, qr, Kb, Vb, lo, i ? t + 1 : 64, kk);
        }
        dec_publish(m, l, o, st2, ob2, wave, lane);
    }
    __syncthreads();
    if (tid < 256) {
        const int g = tid >> 6, d = tid & 63, hq = kvh * 4 + g;
        float oc = 0.f;
#pragma unroll
        for (int w = 0; w < 8; ++w) oc += ocmp[(w * 4 + g) * 64 + d];
        const float os = dec_combine(st1, ob1, g, d), ow = dec_combine(st2, ob2, g, d);
        const float* glp = (const float*)(ws + WS_GL) + row * 32 + hq;
        const float y = (glp[0] * oc + glp[8] * os + glp[16] * ow) * bf2f(((const bf16*)(ws + WS_NG))[CM(hq * 64 + d, row)]);
        ((bf16*)(ws + WS_YMIX))[row * 1024 + 512 + hq * 64 + d] = (bf16)f2bf(y);
    }
    __syncthreads();
}

struct EpiPle {
    static constexpr bool PERM = true, AFTER_DRAIN = false;
    unsigned char* ws;
    __device__ __forceinline__ void operator()(const pg8::f32x4 (&acc)[2][2][4][2], const pg8::Unit& u, int wr, int wc, int fr, int fq) const {
        asm volatile("" : "+v"(fr), "+v"(fq));
#pragma unroll
        for (int ai = 0; ai < 2; ++ai)
#pragma unroll
            for (int m = 0; m < 4; ++m) {
                const size_t row = (size_t)u.pm * 256 + ai * 128 + wr * 64 + m * 16 + fr;
#pragma unroll
                for (int bj = 0; bj < 2; ++bj) { bf16* d = (bf16*)(ws + WS_PPO) + row * 1024 + u.pn * 256 + bj * 128 + wc * 32 + 8 * fq;
                    const f32x4 a = acc[ai][bj][m][0], c = acc[ai][bj][m][1];
                    u32x4 w; w.x = pk2(a.x, a.y); w.y = pk2(a.z, a.w); w.z = pk2(c.x, c.y); w.w = pk2(c.z, c.w); *(u32x4*)d = w; }
            }
    }
};
struct EpiOut {
    static constexpr bool PERM = true, AFTER_DRAIN = false;
    unsigned char* ws; const float* xp; const float* xs;
    __device__ __forceinline__ void operator()(const pg8::f32x4 (&acc)[2][2][4][2], const pg8::Unit& u, int wr, int wc, int fr, int fq) const {
        asm volatile("" : "+v"(fr), "+v"(fq));
#pragma unroll
        for (int ai = 0; ai < 2; ++ai)
#pragma unroll
            for (int m = 0; m < 4; ++m) {
                const size_t row = (size_t)u.pm * 256 + ai * 128 + wr * 64 + m * 16 + fr;
                const float* xrow = (row < NP) ? xp + row * 1024 : xs + (row - NP) * 1024;
                float ss = 0.f;
#pragma unroll
                for (int bj = 0; bj < 2; ++bj) { const int col = u.pn * 256 + bj * 128 + wc * 32 + 8 * fq;
                    const f32x4 a = *(const f32x4*)(xrow + col) + acc[ai][bj][m][0], c = *(const f32x4*)(xrow + col + 4) + acc[ai][bj][m][1];
                    u32x4 w; w.x = pk2(a.x, a.y); w.y = pk2(a.z, a.w); w.z = pk2(c.x, c.y); w.w = pk2(c.z, c.w);
                    *(u32x4*)((bf16*)(ws + WS_X1B) + row * 1024 + col) = w;
                    ss += (a.x * a.x + a.y * a.y) + (a.z * a.z + a.w * a.w) + (c.x * c.x + c.y * c.y) + (c.z * c.z + c.w * c.w); }
                ss += __shfl_xor(ss, 16); ss += __shfl_xor(ss, 32);
                if (fq == 0) ((float*)(ws + WS_SS1))[row * 16 + u.pn * 4 + wc] = ss;
            }
    }
};
__device__ __forceinline__ void panel_meet(unsigned* cnt, unsigned expect, int tid) {
    asm volatile("s_waitcnt vmcnt(0)" ::: "memory");
    __syncthreads();
    if (tid == 0) {
        __hip_atomic_fetch_add(cnt, 1u, __ATOMIC_RELAXED, __HIP_MEMORY_SCOPE_AGENT);
        unsigned sp = 0;
        while (__hip_atomic_load(cnt, __ATOMIC_RELAXED, __HIP_MEMORY_SCOPE_AGENT) < expect) { __builtin_amdgcn_s_sleep(1); if (++sp > (1u << 22)) break; }
    }
    __syncthreads();
}
struct EpiGateNorm {
    static constexpr bool PERM = true, AFTER_DRAIN = false;
    unsigned char* ws; float* out; const float* nf;
    __device__ __forceinline__ void operator()(const pg8::f32x4 (&acc_)[2][2][4][2], const pg8::Unit& u, int wr, int wc, int fr, int fq) const {
        pg8::f32x4 (&acc)[2][2][4][2] = const_cast<pg8::f32x4 (&)[2][2][4][2]>(acc_);
        asm volatile("" : "+v"(fr), "+v"(fq));
#pragma unroll
        for (int ai = 0; ai < 2; ++ai)
#pragma unroll
            for (int m = 0; m < 4; ++m) {
                const size_t row = (size_t)u.pm * 256 + ai * 128 + wr * 64 + m * 16 + fr;
                const f32x4* sp = (const f32x4*)((const float*)(ws + WS_SS1) + row * 16);
                const f32x4 s0 = sp[0], s1 = sp[1], s2 = sp[2], s3 = sp[3];
                const float tot = ((s0.x + s0.y) + (s0.z + s0.w)) + ((s1.x + s1.y) + (s1.z + s1.w)) + (((s2.x + s2.y) + (s2.z + s2.w)) + ((s3.x + s3.y) + (s3.z + s3.w)));
                const float rstd = 1.f / sqrtf(tot * (1.f / 1024.f) + RMS_EPS);
                float ss = 0.f;
#pragma unroll
                for (int bj = 0; bj < 2; ++bj) { const int col = u.pn * 256 + bj * 128 + wc * 32 + 8 * fq;
                    const u32x4 xb = *(const u32x4*)((const bf16*)(ws + WS_X1B) + row * 1024 + col), pb = *(const u32x4*)((const bf16*)(ws + WS_PPO) + row * 1024 + col);
                    f32x4 a = {bflo(xb.x), bfhi(xb.x), bflo(xb.y), bfhi(xb.y)}, c = {bflo(xb.z), bfhi(xb.z), bflo(xb.w), bfhi(xb.w)};
                    const f32x4 pa = {bflo(pb.x), bfhi(pb.x), bflo(pb.y), bfhi(pb.y)}, pc = {bflo(pb.z), bfhi(pb.z), bflo(pb.w), bfhi(pb.w)};
#pragma unroll
                    for (int e = 0; e < 4; ++e) { a[e] += sigmoidf_(rstd * acc[ai][bj][m][0][e]) * pa[e]; c[e] += sigmoidf_(rstd * acc[ai][bj][m][1][e]) * pc[e]; }
                    acc[ai][bj][m][0] = a; acc[ai][bj][m][1] = c;
                    ss += (a.x * a.x + a.y * a.y) + (a.z * a.z + a.w * a.w) + (c.x * c.x + c.y * c.y) + (c.z * c.z + c.w * c.w); }
                ss += __shfl_xor(ss, 16); ss += __shfl_xor(ss, 32);
                if (fq == 0) __hip_atomic_store((float*)(ws + WS_SS2) + row * 16 + u.pn * 4 + wc, ss, __ATOMIC_RELAXED, __HIP_MEMORY_SCOPE_AGENT);
            }
        panel_meet((unsigned*)(ws + WS_CTL) + 16384 + 64 * u.pm, 4u, (int)threadIdx.x);
#pragma unroll
        for (int ai = 0; ai < 2; ++ai)
#pragma unroll
            for (int m = 0; m < 4; ++m) {
                const size_t row = (size_t)u.pm * 256 + ai * 128 + wr * 64 + m * 16 + fr;
                float* sp = (float*)(ws + WS_SS2) + row * 16 + 4 * fq;
                float tot = (__hip_atomic_load(sp, __ATOMIC_RELAXED, __HIP_MEMORY_SCOPE_AGENT) + __hip_atomic_load(sp + 1, __ATOMIC_RELAXED, __HIP_MEMORY_SCOPE_AGENT))
                          + (__hip_atomic_load(sp + 2, __ATOMIC_RELAXED, __HIP_MEMORY_SCOPE_AGENT) + __hip_atomic_load(sp + 3, __ATOMIC_RELAXED, __HIP_MEMORY_SCOPE_AGENT));
                tot += __shfl_xor(tot, 16); tot += __shfl_xor(tot, 32);
                const float rstd2 = 1.f / sqrtf(tot * (1.f / 1024.f) + RMS_EPS);
#pragma unroll
                for (int bj = 0; bj < 2; ++bj) { const int col = u.pn * 256 + bj * 128 + wc * 32 + 8 * fq;
                    const f32x4 g0 = *(const f32x4*)(nf + col), g1 = *(const f32x4*)(nf + col + 4);
                    float* d = out + O_Y + row * 1024 + col; *(f32x4*)d = acc[ai][bj][m][0] * rstd2 * g0; *(f32x4*)(d + 4) = acc[ai][bj][m][1] * rstd2 * g1; }
            }
    }
};
__device__ __forceinline__ void final_norm(const Args& A, int lane, int wave) {
    const int gw = blockIdx.x * 8 + wave, NGW = gridDim.x * 8;
    const f32x4* nf = (const f32x4*)A.in[I_NF];
    f32x4 g[4];
#pragma unroll
    for (int j = 0; j < 4; ++j) g[j] = nf[64 * j + lane];
    for (int row = gw; row < NTOK; row += NGW) {
        float tot = 0.f;
        if (row < NP) { const float* sp = (const float*)(A.ws + WS_SS2) + (size_t)row * 16;
#pragma unroll
            for (int i = 0; i < 16; ++i) tot += sp[i]; }
        else tot = wave_sum(lane < 32 ? ((const float*)(A.ws + WS_SS2D))[(size_t)(row - NP) * 32 + lane] : 0.f);
        const float rstd = 1.f / sqrtf(tot * (1.f / 1024.f) + RMS_EPS);
        f32x4* y = (f32x4*)(A.out + O_Y + (size_t)row * 1024) + lane;
#pragma unroll
        for (int j = 0; j < 4; ++j) { f32x4 v = y[64 * j]; v = v * rstd * g[j]; y[64 * j] = v; }
    }
}

template <int K, class Epi>
__device__ __forceinline__ void mini_gemm_unit(LAS unsigned char* lds, const bf16* A, int lda, const bf16* Bt, int rowblk, int colblk, const Epi& E, int tid, int lane, int wave) {
    const int row0 = rowblk * 128 + wave * 16, fr = lane & 15, fq = lane >> 4, col0 = colblk * 32;
    constexpr int BP = K * 2 + 16, CPR = K / 8;
    __syncthreads();
#pragma unroll
    for (int i = 0; i < 32 * CPR / 512; ++i) { const int q = tid + 512 * i, c = q / CPR, ch = q % CPR;
        *(LAS u32x4*)(lds + c * BP + ch * 16) = *(const u32x4*)(Bt + (size_t)(col0 + c) * K + ch * 8); }
    const bf16* a = A + (size_t)(row0 + fr) * lda + 8 * fq;
    LAS const unsigned char* b0 = lds + fr * BP + 16 * fq;
    __syncthreads();
    f32x4 c0 = {0.f, 0.f, 0.f, 0.f}, c1 = {0.f, 0.f, 0.f, 0.f};
#pragma unroll 8
    for (int s = 0; s < K / 32; ++s) {
        const bf16x8 av = *(const bf16x8*)(a + 32 * s), bv0 = *(LAS const bf16x8*)(b0 + 64 * s), bv1 = *(LAS const bf16x8*)(b0 + 16 * BP + 64 * s);
        c0 = __builtin_amdgcn_mfma_f32_16x16x32_bf16(av, bv0, c0, 0, 0, 0);
        c1 = __builtin_amdgcn_mfma_f32_16x16x32_bf16(av, bv1, c1, 0, 0, 0);
    }
    E(row0 + 4 * fq, col0 + fr, colblk, c0, c1, fr);
}
struct EpiNgl { unsigned char* ws;
    __device__ __forceinline__ void operator()(int r0, int col, int cb, const f32x4& c0, const f32x4& c1, int fr) const {
        float* gl = (float*)(ws + WS_GL);
#pragma unroll
        for (int i = 0; i < 4; ++i) { gl[(size_t)(r0 + i) * 32 + col] = sigmoidf_(c0[i]); gl[(size_t)(r0 + i) * 32 + col + 16] = sigmoidf_(c1[i]); } } };
struct DEpiPle { unsigned char* ws;
    __device__ __forceinline__ void operator()(int r0, int col, int cb, const f32x4& c0, const f32x4& c1, int fr) const {
#pragma unroll
        for (int i = 0; i < 4; ++i) { bf16* d = (bf16*)(ws + WS_PPO) + (size_t)(NP + r0 + i) * 1024 + col; d[0] = (bf16)f2bf(c0[i]); d[16] = (bf16)f2bf(c1[i]); } } };
struct DEpiOut { unsigned char* ws; const float* xs;
    __device__ __forceinline__ void operator()(int r0, int col, int cb, const f32x4& c0, const f32x4& c1, int fr) const {
#pragma unroll
        for (int i = 0; i < 4; ++i) { const size_t rd = r0 + i, row = NP + rd;
            const float a = xs[rd * 1024 + col] + c0[i], c = xs[rd * 1024 + col + 16] + c1[i];
            bf16* db = (bf16*)(ws + WS_X1B) + row * 1024 + col; db[0] = (bf16)f2bf(a); db[16] = (bf16)f2bf(c);
            const float ss = red16(a * a + c * c);
            if (fr == 0) ((float*)(ws + WS_SS1D))[rd * 32 + cb] = ss; } } };
struct DEpiGate { unsigned char* ws; float* out; const float* nf;
    __device__ __forceinline__ void operator()(int r0, int col, int cb, const f32x4& c0, const f32x4& c1, int fr) const {
        float va[4], vc[4];
#pragma unroll
        for (int i = 0; i < 4; ++i) { const size_t rd = r0 + i, row = NP + rd;
            const float* sp = (const float*)(ws + WS_SS1D) + rd * 32;
            const float tot = red16(sp[fr] + sp[16 + fr]), rstd = 1.f / sqrtf(tot * (1.f / 1024.f) + RMS_EPS);
            const bf16* x1 = (const bf16*)(ws + WS_X1B) + row * 1024 + col; const bf16* pp = (const bf16*)(ws + WS_PPO) + row * 1024 + col;
            va[i] = bf2f(x1[0]) + sigmoidf_(rstd * c0[i]) * bf2f(pp[0]); vc[i] = bf2f(x1[16]) + sigmoidf_(rstd * c1[i]) * bf2f(pp[16]);
            const float ss = red16(va[i] * va[i] + vc[i] * vc[i]);
            if (fr == 0) __hip_atomic_store((float*)(ws + WS_SS2D) + rd * 32 + cb, ss, __ATOMIC_RELAXED, __HIP_MEMORY_SCOPE_AGENT); }
        panel_meet((unsigned*)(ws + WS_CTL) + 32768 + 64 * (r0 >> 7), 32u, (int)threadIdx.x);
#pragma unroll
        for (int i = 0; i < 4; ++i) { const size_t rd = r0 + i, row = NP + rd;
            float* sp = (float*)(ws + WS_SS2D) + rd * 32;
            const float tot = red16(__hip_atomic_load(sp + fr, __ATOMIC_RELAXED, __HIP_MEMORY_SCOPE_AGENT) + __hip_atomic_load(sp + 16 + fr, __ATOMIC_RELAXED, __HIP_MEMORY_SCOPE_AGENT));
            const float rstd2 = 1.f / sqrtf(tot * (1.f / 1024.f) + RMS_EPS);
            float* d = out + O_Y + row * 1024 + col; d[0] = va[i] * rstd2 * nf[col]; d[16] = vc[i] * rstd2 * nf[col + 16]; } } };

constexpr int N_PHASES = 7;
#ifndef REP_PHASE
#define REP_PHASE -1
#endif
#ifndef MK_SINGLE
#define MK_SINGLE 1
#endif
__global__ void __launch_bounds__(512, 2) mega_fwd(Args args) {
    extern __shared__ __attribute__((aligned(16))) unsigned char lds_raw[];
    LAS unsigned char* lds = (LAS unsigned char*)lds_raw;
    const int tid = threadIdx.x, lane = tid & 63, wave = __builtin_amdgcn_readfirstlane(tid >> 6);
    volatile LAS unsigned* MISC = (volatile LAS unsigned*)(lds + MISC_OFF);
    if (tid < 64) MISC[tid] = 0u;
    __syncthreads();
    const int lo = args.ph_lo, hi = args.ph_hi;
    XcdBarrier bar; bar.bar = (unsigned*)(args.ws + WS_CTL) + CW_BAR; bar.x = 0; bar.st = nullptr;
    if (hi - lo > 1) bar = xcd_barrier_post((unsigned*)(args.ws + WS_CTL) + CW_BAR, MISC + 8);
#ifndef PH_MASK
#define PH_MASK 0xFF
#endif
#define IN(k) (((PH_MASK >> (k)) & 1) && lo <= (k) && (k) < hi)
#define SEAM(k) do { if (IN(k) && IN((k) + 1)) xcd_barrier(bar); } while (0)
    unsigned char* ws = args.ws;
    const int G = gridDim.x, bx = blockIdx.x;
#ifndef STAMP_A
#define STAMP_A -1
#define STAMP_B -1
#endif
#define STAMP(k) do { if (STAMP_A >= 0 && tid == 0) { const unsigned long long t_ = __builtin_amdgcn_s_memrealtime(); MISC[16 + 2 * (k)] = (unsigned)t_; MISC[17 + 2 * (k)] = (unsigned)(t_ >> 32); } } while (0)
    STAMP(0);

    if (IN(0)) { phase0(args, lds, tid, lane, wave); }
    SEAM(0); STAMP(1);
    if (IN(1)) {
#ifndef P1_REP_PARTS
#define P1_REP_PARTS 7
#endif
        const int p1m = args.rep ? P1_REP_PARTS : 7;
        const bool cfirst = (bx & 1) != 0;
        if (cfirst) { if (p1m & 4) for (int u = bx; u < 512; u += G) compress_unit<true>(args, lds, u, tid, lane, wave); }
        __syncthreads();
        if (p1m & 1) { pg8::Gemm g{(const pg8::bf16_t*)(ws + WS_H), (const pg8::bf16_t*)(ws + WS_WINT), NTOK, NPR, DM}; pg8::StaticOrder S; S.init(NTOK, NPR, G, bx);
          EpiInProj E{ws, args.out};
          pg8::gemm_phase<EpiInProj, pg8::StaticOrder, true, true>(lds, g, S, E); }
        if (p1m & 2) {
            const int nun = (NTOK / 256) * (NPR / 256), fl = (nun % G) ? (nun % G) : 0, nl = G - fl;
            if (bx >= fl) for (int u = bx - fl; u < NTOK / 128; u += nl) { EpiNgl E{ws}; mini_gemm_unit<1024>(lds, (const bf16*)(ws + WS_H), 1024, (const bf16*)(ws + WS_WNGLT), u, 0, E, tid, lane, wave); } }
        if (!cfirst) { if (p1m & 4) for (int u = bx; u < 512; u += G) compress_unit<true>(args, lds, u, tid, lane, wave); }
    }
    SEAM(1); STAMP(2);
    if (IN(2)) {
#ifndef P2_REP_PARTS
#define P2_REP_PARTS 15
#endif
        const int p2m = args.rep ? P2_REP_PARTS : 15;
        const int GW = (G > 32) ? G - 16 : G; const bool worker = bx < GW;
        if ((p2m & 1) && worker) { int kple = 256; asm volatile("" : "+s"(kple));
          pg8::Gemm g{(const pg8::bf16_t*)(ws + WS_PB), (const pg8::bf16_t*)(ws + WS_WPLET), NP, 1024, kple}; pg8::StaticOrder S; S.init(NP, 1024, GW, (bx + GW - 128) % GW);
          EpiPle E{ws};
          pg8::gemm_phase<EpiPle, pg8::StaticOrder, true, true>(lds, g, S, E); }
        for (int u = G - 17 - bx; u >= 0 && u < 64; u += G) { DEpiPle E{ws}; mini_gemm_unit<256>(lds, (const bf16*)(ws + WS_PB) + (size_t)NP * 256, 256, (const bf16*)(ws + WS_WPLET), u >> 5, u & 31, E, tid, lane, wave); }
        if (p2m & 2) for (int u = G - 1 - bx; u < 16; u += G) compress_unit<false>(args, lds, u, tid, lane, wave);
        if ((p2m & 4) && worker) for (int u = (bx + GW - 144) % GW; u < 512; u += GW) ret_pass1_unit(ws, lds, u, tid, lane, wave);
        if (p2m & 8) for (int u = bx; u < 128; u += G) ret_decode_unit(args, lds, u, tid, lane, wave);
        if (worker) late_transposes(args, lds, bx * 8 + wave, GW * 8, lane, wave);
        if (worker) win_shift(args, bx * 512 + tid, GW * 512);
    }
    SEAM(2); STAMP(3);
    if (IN(3)) {
#ifndef P3_REP_PARTS
#define P3_REP_PARTS 7
#endif
        const int p3m = args.rep ? P3_REP_PARTS : 7;
        if (p3m & 1) ret_pass2(args, tid);
        const bool dfirst = ((bx >> 5) & 1) != 0;
        if (dfirst && (p3m & 4)) for (int u = bx; u < 512; u += G) { const int w = u & 255, grp = (w & 7) + 8 * (w >> 5), tt = 2 * ((w >> 3) & 3) + (u >> 8);
            nsa_decode_unit(args, lds, grp * 8 + tt, tid, lane, wave); }
        if (p3m & 2) for (int pi = bx; pi < 512; pi += G) { const int pr = pi & 255, b = (pr & 7) >> 1, kvh = pr & 1, s = pr >> 3;
            nsa_prompt_unit(args, lds, b, kvh, (pi >= 256) ? s : 63 - s, tid, lane, wave); }
        if (!dfirst && (p3m & 4)) for (int u = bx; u < 512; u += G) { const int w = u & 255, grp = (w & 7) + 8 * (w >> 5), tt = 2 * ((w >> 3) & 3) + (u >> 8);
            nsa_decode_unit(args, lds, grp * 8 + tt, tid, lane, wave); }
    }
    SEAM(3); STAMP(4);
    if (IN(4)) {
        for (int u = bx; u < 512; u += G) ret_pass3_unit(args, lds, u, tid, lane, wave);
        for (int u = G - 1 - bx; u < 64; u += G) { DEpiOut E{ws, (const float*)args.in[I_XS]}; mini_gemm_unit<1024>(lds, (const bf16*)(ws + WS_YMIX) + (size_t)NP * 1024, 1024, (const bf16*)(ws + WS_WOUTT), u >> 5, u & 31, E, tid, lane, wave); }
    }
    SEAM(4); STAMP(5);
    if (IN(5)) {
        pg8::Gemm g{(const pg8::bf16_t*)(ws + WS_YMIX), (const pg8::bf16_t*)(ws + WS_WOUTT), NP, 1024, 1024}; pg8::StaticOrder S; S.init(NP, 1024, G, bx);
        EpiOut E{ws, (const float*)args.in[I_XP], (const float*)args.in[I_XS]};
        pg8::gemm_phase<EpiOut, pg8::StaticOrder, true, true>(lds, g, S, E);
        for (int u = G - 1 - bx; u < 64; u += G) { DEpiGate E2{ws, args.out, (const float*)args.in[I_NF]}; mini_gemm_unit<1024>(lds, (const bf16*)(ws + WS_X1B) + (size_t)NP * 1024, 1024, (const bf16*)(ws + WS_WGT), u >> 5, u & 31, E2, tid, lane, wave); }
    }
    SEAM(5); STAMP(6);
    if (IN(6)) {
        pg8::Gemm g{(const pg8::bf16_t*)(ws + WS_X1B), (const pg8::bf16_t*)(ws + WS_WGT), NP, 1024, 1024}; pg8::StaticOrder S; S.init(NP, 1024, G, bx);
        EpiGateNorm E{ws, args.out, (const float*)args.in[I_NF]};
        pg8::gemm_phase<EpiGateNorm, pg8::StaticOrder, true, true>(lds, g, S, E);
    }
    if (STAMP_A >= 0) { STAMP(8); if (bx == 0 && tid == 0) {
        const unsigned a0 = MISC[16 + 2 * STAMP_A], a1 = MISC[16 + 2 * (STAMP_A + 1)], b0 = MISC[16 + 2 * STAMP_B], b1 = MISC[16 + 2 * (STAMP_B + 1)];
        __builtin_amdgcn_s_waitcnt(0);
        args.out[O_Y] = 10.f * (float)(a1 - a0); args.out[O_Y + (size_t)NP * 1024] = 10.f * (float)(b1 - b0); } }
#undef IN
#undef SEAM
}

extern "C" void kernel_launch(void* const* d_in, const int* in_sizes, int n_in, void* d_out, int out_size, void* d_ws, size_t ws_size, hipStream_t stream) {
    static int grid = 0;
    if (grid == 0) {
        if (n_in != N_IN || out_size != (int)O_END || ws_size < WS_END) { fprintf(stderr, "kernel_launch: unexpected shapes (n_in %d, out %d, ws %zu); nothing launched\n", n_in, out_size, ws_size); grid = -1; return; }
        int dev = 0, cus = 0, per_cu = 0;
        if (hipGetDevice(&dev) != hipSuccess || hipDeviceGetAttribute(&cus, hipDeviceAttributeMultiprocessorCount, dev) != hipSuccess) { grid = -1; return; }
        if (hipFuncSetAttribute((const void*)mega_fwd, hipFuncAttributeMaxDynamicSharedMemorySize, LDS_BYTES) != hipSuccess) { fprintf(stderr, "kernel_launch: hipFuncSetAttribute failed\n"); grid = -1; return; }
        if (hipOccupancyMaxActiveBlocksPerMultiprocessor(&per_cu, (const void*)mega_fwd, 512, LDS_BYTES) != hipSuccess || per_cu < 1) { fprintf(stderr, "kernel_launch: occupancy query says %d blocks per CU\n", per_cu); }
        (void)hipGetLastError();
        grid = cus;
    }
    if (grid < 0) return;
    (void)hipMemsetAsync((char*)d_ws + WS_CTL, 0, CTL_ZERO_BYTES, stream);
    Args a{};
    for (int i = 0; i < N_IN; ++i) a.in[i] = d_in[i];
    a.out = (float*)d_out; a.ws = (unsigned char*)d_ws;
    a.rep = 0; a.pad = 0;
#if MK_SINGLE
    a.ph_lo = 0; a.ph_hi = N_PHASES;
    hipLaunchKernelGGL(mega_fwd, dim3(grid), dim3(512), LDS_BYTES, stream, a);
#else
    for (int p = 0; p < N_PHASES; ++p) { a.ph_lo = p; a.ph_hi = p + 1;
        for (int r = 0; r < ((p == REP_PHASE) ? 2 : 1); ++r) { a.rep = r; hipLaunchKernelGGL(mega_fwd, dim3(grid), dim3(512), LDS_BYTES, stream, a); } }
#endif
}
```
